# Optimizing an MI355X kernel written in HIP

```python
import math
import jax
import jax.numpy as jnp
from jax import lax
import numpy as np

D_MODEL = 1024
BATCH = 8
SEQ = 4096
DEPTH = 4

N_MIXERS = 4
HEAD_DIM = 64
ROPE_THETA = 10000.0
Q_BLOCK = 128
EPS = 1e-6
NEG_INF = -1e30
TINY = 1e-30

FOX_HEADS = D_MODEL // HEAD_DIM
FOX_IN = 3 * FOX_HEADS * HEAD_DIM + FOX_HEADS

NSA_HEADS = D_MODEL // HEAD_DIM
NSA_KV_GROUPS = 4
NSA_HPG = NSA_HEADS // NSA_KV_GROUPS
NSA_BLOCK = 64
NSA_TOPN = 16
NSA_WINDOW = 512
NSA_CMP_HIDDEN = 2 * HEAD_DIM
NSA_SEL_CHUNK = 32
NSA_IN = NSA_HEADS * HEAD_DIM + 6 * NSA_KV_GROUPS * HEAD_DIM + 3 * NSA_HEADS

DIL_PAIRS = ((128, 1), (512, 4), (2048, 16))
DIL_HEADS = D_MODEL // HEAD_DIM
DIL_CHUNK = 64
DIL_IN = len(DIL_PAIRS) * 3 * DIL_HEADS * HEAD_DIM

DIFF_HEADS = D_MODEL // (2 * HEAD_DIM)
DIFF_IN = 6 * DIFF_HEADS * HEAD_DIM

N_EXPERTS = 16
N_EXPERT_GROUPS = 4
EXPERTS_PER_GROUP = N_EXPERTS // N_EXPERT_GROUPS
TOP_K = 2
EXPERT_FF = 512
MOE_BLOCK = 128

LAYERS_PER_MIXER = tuple(len(range(m, DEPTH, N_MIXERS)) for m in range(N_MIXERS))
N_FOX, N_NSA, N_DIL, N_DIFF = LAYERS_PER_MIXER

kernel_name = 'hybrid_fox_nsa_dilated_diff_moe'


def rms_norm(x, gain):
    xf = x.astype(jnp.float32)
    y = xf * lax.rsqrt(jnp.mean(xf * xf, axis=-1, keepdims=True) + EPS)
    return (y * gain.astype(jnp.float32)).astype(x.dtype)


def rope_tables(positions, dim):
    inv = ROPE_THETA ** (-jnp.arange(0, dim, 2, dtype=jnp.float32) / dim)
    ang = positions.astype(jnp.float32)[:, None] * inv[None, :]
    return jnp.cos(ang), jnp.sin(ang)


def apply_rope(x, cos, sin):
    x1, x2 = jnp.split(x.astype(jnp.float32), 2, axis=-1)
    return jnp.concatenate([x1 * cos - x2 * sin, x1 * sin + x2 * cos], axis=-1).astype(x.dtype)


def masked_softmax(s, mask):
    s = jnp.where(mask, s, NEG_INF)
    m = jnp.max(s, axis=-1, keepdims=True)
    e = jnp.where(mask, jnp.exp(s - m), 0.0)
    den = jnp.maximum(jnp.sum(e, axis=-1, keepdims=True), TINY)
    return e / den, (m + jnp.log(den))[..., 0]


def split_cols(t, sizes):
    outs, off = [], 0
    for n in sizes:
        outs.append(t[..., off:off + n])
        off += n
    return outs


def to_heads(t, n_heads):
    b, s, _ = t.shape
    return t.reshape(b, s, n_heads, -1).transpose(0, 2, 1, 3)


def from_heads(t):
    b, h, s, d = t.shape
    return t.transpose(0, 2, 1, 3).reshape(b, s, h * d)


def to_blocks(t, n, axis):
    shp = t.shape
    t = t.reshape(shp[:axis] + (n, shp[axis] // n) + shp[axis + 1:])
    return jnp.moveaxis(t, axis, 0)


def from_blocks(t, axis):
    t = jnp.moveaxis(t, 0, axis)
    shp = t.shape
    return t.reshape(shp[:axis] + (shp[axis] * shp[axis + 1],) + shp[axis + 2:])


def sweep_blocks(fn, n_blocks, *blocked):
    return lax.map(lambda a: fn(*a), (jnp.arange(n_blocks),) + tuple(blocked))


def fox_mixer(u, w_in, b_f, q_gain, k_gain, w_out):
    B, S, _ = u.shape
    H, nb, scale = FOX_HEADS, S // Q_BLOCK, HEAD_DIM ** -0.5
    q, k, v, f = split_cols(u @ w_in, [H * HEAD_DIM] * 3 + [H])
    q = rms_norm(to_heads(q, H), q_gain)
    k = rms_norm(to_heads(k, H), k_gain)
    v = to_heads(v, H)
    log_f = jax.nn.log_sigmoid((f + b_f).astype(jnp.float32))
    cum = jnp.cumsum(log_f, axis=1).transpose(0, 2, 1)
    kpos = jnp.arange(S)

    def block(i, qi, ci):
        s = jnp.einsum('bhqd,bhkd->bhqk', qi, k).astype(jnp.float32) * scale
        s = s + ci[..., None] - cum[:, :, None, :]
        qpos = i * Q_BLOCK + jnp.arange(Q_BLOCK)
        p, _ = masked_softmax(s, kpos[None, :] <= qpos[:, None])
        return jnp.einsum('bhqk,bhkd->bhqd', p.astype(v.dtype), v)

    o = from_blocks(sweep_blocks(block, nb, to_blocks(q, nb, 2), to_blocks(cum, nb, 2)), 2)
    return from_heads(o) @ w_out


def nsa_mixer(u, cos, sin, w_in, q_gain, k_gain, cmp_pos, cmp_w1, cmp_w2, w_out):
    B, S, _ = u.shape
    H, G, P, L, HD = NSA_HEADS, NSA_KV_GROUPS, NSA_HPG, NSA_BLOCK, HEAD_DIM
    NB = S // L
    n_sel = min(NSA_TOPN, NB)
    scale = HD ** -0.5
    q, kc, vc, ks, vs, kw, vw, gl = split_cols(u @ w_in, [H * HD] + [G * HD] * 6 + [3 * H])
    q = apply_rope(rms_norm(q.reshape(B, S, G, P, HD).transpose(0, 2, 3, 1, 4), q_gain), cos, sin)
    ks = apply_rope(rms_norm(to_heads(ks, G), k_gain[1]), cos, sin)
    kw = apply_rope(rms_norm(to_heads(kw, G), k_gain[2]), cos, sin)
    vs, vw = to_heads(vs, G), to_heads(vw, G)

    def compress(t, which):
        blk = t.reshape(B, G, NB, L, HD) + cmp_pos[which]
        hid = jax.nn.silu(blk.reshape(B, G, NB, L * HD) @ cmp_w1[which])
        return hid @ cmp_w2[which]

    kc = apply_rope(rms_norm(compress(to_heads(kc, G), 0), k_gain[0]), cos[L - 1::L], sin[L - 1::L])
    vc = compress(to_heads(vc, G), 1)
    t_pos = jnp.arange(S)
    j_blk = jnp.arange(NB)
    s_c = jnp.einsum('bgpsd,bgnd->bgpsn', q, kc).astype(jnp.float32) * scale
    p_c, _ = masked_softmax(s_c, (j_blk[None, :] + 1) * L <= t_pos[:, None] + 1)
    o_cmp = jnp.einsum('bgpsn,bgnd->bgpsd', p_c.astype(vc.dtype), vc)

    cur = t_pos // L
    imp = jnp.sum(p_c, axis=2)
    forced = (j_blk[None, :] == 0) | (j_blk[None, :] == cur[:, None]) | (j_blk[None, :] == cur[:, None] - 1)
    future = j_blk[None, :] > cur[:, None]
    imp = jnp.where(future, -1.0, jnp.where(forced, P + 1.0, imp))
    _, sel = lax.top_k(imp, n_sel)

    C = NSA_SEL_CHUNK
    nch = S // C
    ks_b = ks.reshape(B, G, NB, L, HD)
    vs_b = vs.reshape(B, G, NB, L, HD)
    bi = jnp.arange(B)[:, None, None, None]
    gi = jnp.arange(G)[None, :, None, None]

    def sel_block(i, qi, si):
        kg = ks_b[bi, gi, si].reshape(B, G, C, n_sel * L, HD)
        vg = vs_b[bi, gi, si].reshape(B, G, C, n_sel * L, HD)
        s = jnp.einsum('bgpcd,bgcmd->bgpcm', qi, kg).astype(jnp.float32) * scale
        tok = (si[..., None] * L + jnp.arange(L)).reshape(B, G, C, n_sel * L)
        qpos = i * C + jnp.arange(C)
        p, _ = masked_softmax(s, (tok <= qpos[:, None])[:, :, None])
        return jnp.einsum('bgpcm,bgcmd->bgpcd', p.astype(vg.dtype), vg)

    o_sel = from_blocks(sweep_blocks(sel_block, nch, to_blocks(q, nch, 3), to_blocks(sel, nch, 2)), 3)

    W = NSA_WINDOW
    nb = S // Q_BLOCK
    span = W + Q_BLOCK
    kw_p = jnp.pad(kw, ((0, 0), (0, 0), (W, 0), (0, 0)))
    vw_p = jnp.pad(vw, ((0, 0), (0, 0), (W, 0), (0, 0)))

    def win_block(i, qi):
        kb = lax.dynamic_slice_in_dim(kw_p, i * Q_BLOCK, span, axis=2)
        vb = lax.dynamic_slice_in_dim(vw_p, i * Q_BLOCK, span, axis=2)
        s = jnp.einsum('bgpqd,bgkd->bgpqk', qi, kb).astype(jnp.float32) * scale
        qpos = i * Q_BLOCK + jnp.arange(Q_BLOCK)
        kpos = i * Q_BLOCK - W + jnp.arange(span)
        dist = qpos[:, None] - kpos[None, :]
        p, _ = masked_softmax(s, (dist >= 0) & (dist < W) & (kpos[None, :] >= 0))
        return jnp.einsum('bgpqk,bgkd->bgpqd', p.astype(vb.dtype), vb)

    o_win = from_blocks(sweep_blocks(win_block, nb, to_blocks(q, nb, 3)), 3)

    g = jax.nn.sigmoid(gl.astype(jnp.float32)).reshape(B, S, 3, G, P).transpose(2, 0, 3, 4, 1)[..., None].astype(u.dtype)
    o = g[0] * o_cmp + g[1] * o_sel + g[2] * o_win
    return o.transpose(0, 3, 1, 2, 4).reshape(B, S, H * HD) @ w_out


def dilated_group(q, k, v, window, dilation):
    B, H, S, HD = q.shape
    C = DIL_CHUNK
    nb = S // C
    n_keys = window // dilation + 1
    span = C + window
    scale = HD ** -0.5
    k_p = jnp.pad(k, ((0, 0), (0, 0), (window, 0), (0, 0)))
    v_p = jnp.pad(v, ((0, 0), (0, 0), (window, 0), (0, 0)))
    ql = np.arange(C)[:, None]
    mm = np.arange(n_keys)[None, :]
    local = jnp.asarray(ql + window - mm * dilation)
    rel = jnp.asarray(ql - mm * dilation)

    def block(i, qi):
        kb = lax.dynamic_slice_in_dim(k_p, i * C, span, axis=2)[:, :, local]
        vb = lax.dynamic_slice_in_dim(v_p, i * C, span, axis=2)[:, :, local]
        s = jnp.einsum('bhqd,bhqnd->bhqn', qi, kb).astype(jnp.float32) * scale
        p, lse = masked_softmax(s, i * C + rel >= 0)
        return jnp.einsum('bhqn,bhqnd->bhqd', p.astype(vb.dtype), vb), lse

    o, lse = sweep_blocks(block, nb, to_blocks(q, nb, 2))
    return from_blocks(o, 2), from_blocks(lse, 2)


def dilated_mixer(u, cos, sin, w_in, q_gain, k_gain, w_out):
    B, S, _ = u.shape
    NG = len(DIL_PAIRS)
    proj = (u @ w_in).reshape(B, S, NG, 3, DIL_HEADS, HEAD_DIM).transpose(2, 3, 0, 4, 1, 5)
    outs, lses = [], []
    for gi, (window, dilation) in enumerate(DIL_PAIRS):
        q = apply_rope(rms_norm(proj[gi, 0], q_gain), cos, sin)
        k = apply_rope(rms_norm(proj[gi, 1], k_gain), cos, sin)
        o, lse = dilated_group(q, k, proj[gi, 2], window, dilation)
        outs.append(o)
        lses.append(lse)
    alpha = jax.nn.softmax(jnp.stack(lses, axis=0), axis=0)
    o = jnp.sum(alpha[..., None].astype(u.dtype) * jnp.stack(outs, axis=0), axis=0)
    return from_heads(o) @ w_out


def diff_mixer(u, cos, sin, w_in, q_gain, k_gain, lambdas, sub_gain, w_out, layer_idx):
    B, S, _ = u.shape
    H, HD = DIFF_HEADS, HEAD_DIM
    nb = S // Q_BLOCK
    scale = HD ** -0.5
    q, k, v = split_cols(u @ w_in, [2 * H * HD] * 3)
    q = apply_rope(rms_norm(to_heads(q, 2 * H), q_gain), cos, sin).reshape(B, H, 2, S, HD)
    k = apply_rope(rms_norm(to_heads(k, 2 * H), k_gain), cos, sin).reshape(B, H, 2, S, HD)
    v = to_heads(v, H)
    lam_init = 0.8 - 0.6 * math.exp(-0.3 * layer_idx)
    lam = (jnp.exp(jnp.sum(lambdas[0] * lambdas[1]).astype(jnp.float32))
           - jnp.exp(jnp.sum(lambdas[2] * lambdas[3]).astype(jnp.float32)) + lam_init)
    kpos = jnp.arange(S)

    def block(i, qi):
        s = jnp.einsum('bhcqd,bhckd->bhcqk', qi, k).astype(jnp.float32) * scale
        qpos = i * Q_BLOCK + jnp.arange(Q_BLOCK)
        p, _ = masked_softmax(s, kpos[None, :] <= qpos[:, None])
        a = p[:, :, 0] - lam * p[:, :, 1]
        return jnp.einsum('bhqk,bhkd->bhqd', a.astype(v.dtype), v)

    o = from_blocks(sweep_blocks(block, nb, to_blocks(q, nb, 3)), 2)
    o = rms_norm(o, sub_gain) * (1.0 - lam_init)
    return from_heads(o) @ w_out


def expert_dispatch(xt, eidx, w_gate, w_up, w_down):
    T, D = xt.shape
    NP = T * TOP_K
    E = w_gate.shape[0]
    R = NP + E * MOE_BLOCK
    NBK = R // MOE_BLOCK
    e_flat = eidx.reshape(-1)
    order = jnp.argsort(e_flat)
    e_sorted = e_flat[order]
    counts = jnp.bincount(e_flat, length=E)
    padded = (counts + MOE_BLOCK - 1) // MOE_BLOCK * MOE_BLOCK
    pad_end = jnp.cumsum(padded)
    pad_start = pad_end - padded
    start = jnp.cumsum(counts) - counts
    dest = pad_start[e_sorted] + (jnp.arange(NP) - start[e_sorted])
    row_token = jnp.full((R,), T, jnp.int32).at[dest].set((order // TOP_K).astype(jnp.int32))
    x_pad = jnp.concatenate([xt, jnp.zeros((1, D), xt.dtype)], axis=0)
    xs = x_pad[row_token].reshape(NBK, MOE_BLOCK, D)
    blk_expert = jnp.minimum(jnp.searchsorted(pad_end, jnp.arange(NBK) * MOE_BLOCK, side='right'), E - 1)

    def run(args):
        xb, e = args
        hid = jax.nn.silu(xb @ w_gate[e]) * (xb @ w_up[e])
        return hid @ w_down[e]

    ys = lax.map(run, (xs, blk_expert)).reshape(R, D)
    dest_orig = jnp.zeros((NP,), jnp.int32).at[order].set(dest.astype(jnp.int32))
    return ys[dest_orig].reshape(T, TOP_K, D)


def moe_ffn(u, router_w, router_b, w_gate, w_up, w_down):
    B, S, D = u.shape
    T = B * S
    xt = u.reshape(T, D)
    scores = jax.nn.sigmoid((xt @ router_w).astype(jnp.float32))
    sel = (scores + router_b.astype(jnp.float32)).reshape(T, N_EXPERT_GROUPS, EXPERTS_PER_GROUP)
    grp_score = jnp.sum(lax.top_k(sel, TOP_K)[0], axis=-1)
    grp = jnp.argmax(grp_score, axis=-1)
    in_grp = jnp.take_along_axis(sel, grp[:, None, None], axis=1)[:, 0]
    _, local = lax.top_k(in_grp, TOP_K)
    eidx = grp[:, None] * EXPERTS_PER_GROUP + local
    w = jnp.take_along_axis(scores, eidx, axis=1)
    w = w / jnp.sum(w, axis=-1, keepdims=True)
    y = expert_dispatch(xt, eidx, w_gate, w_up, w_down)
    return jnp.einsum('tk,tkd->td', w.astype(u.dtype), y).reshape(B, S, D)


def setup_inputs(seed: int = 0) -> dict:
    key = jax.random.key(seed)
    keys = jax.random.split(key, 40)
    counter = [0]

    def nxt():
        k = keys[counter[0]]
        counter[0] += 1
        return k

    def nrm(shape, scale):
        return scale * jax.random.normal(nxt(), shape, jnp.float32)

    def gain(shape):
        return 1.0 + 0.1 * jax.random.normal(nxt(), shape, jnp.float32)

    D, HD, L = D_MODEL, HEAD_DIM, NSA_BLOCK
    return {
        'x': nrm((BATCH, SEQ, D), 1.0),
        'c': nrm((BATCH, D), 1.0),
        'fox_w_in': nrm((N_FOX, D, FOX_IN), D ** -0.5),
        'fox_b_f': 2.0 + nrm((N_FOX, FOX_HEADS), 0.5),
        'fox_q_gain': gain((N_FOX, HD)),
        'fox_k_gain': gain((N_FOX, HD)),
        'fox_w_out': nrm((N_FOX, FOX_HEADS * HD, D), (FOX_HEADS * HD) ** -0.5),
        'nsa_w_in': nrm((N_NSA, D, NSA_IN), D ** -0.5),
        'nsa_q_gain': gain((N_NSA, HD)),
        'nsa_k_gain': gain((N_NSA, 3, HD)),
        'nsa_cmp_pos': nrm((N_NSA, 2, L, HD), 0.1),
        'nsa_cmp_w1': nrm((N_NSA, 2, L * HD, NSA_CMP_HIDDEN), (L * HD) ** -0.5),
        'nsa_cmp_w2': nrm((N_NSA, 2, NSA_CMP_HIDDEN, HD), NSA_CMP_HIDDEN ** -0.5),
        'nsa_w_out': nrm((N_NSA, NSA_HEADS * HD, D), (NSA_HEADS * HD) ** -0.5),
        'dil_w_in': nrm((N_DIL, D, DIL_IN), D ** -0.5),
        'dil_q_gain': gain((N_DIL, HD)),
        'dil_k_gain': gain((N_DIL, HD)),
        'dil_w_out': nrm((N_DIL, DIL_HEADS * HD, D), (DIL_HEADS * HD) ** -0.5),
        'diff_w_in': nrm((N_DIFF, D, DIFF_IN), D ** -0.5),
        'diff_q_gain': gain((N_DIFF, HD)),
        'diff_k_gain': gain((N_DIFF, HD)),
        'diff_lambda': nrm((N_DIFF, 4, HD), 0.1),
        'diff_sub_gain': gain((N_DIFF, 2 * HD)),
        'diff_w_out': nrm((N_DIFF, 2 * DIFF_HEADS * HD, D), (2 * DIFF_HEADS * HD) ** -0.5),
        'norm_gain': gain((DEPTH, 2, D)),
        'ada_w': nrm((DEPTH, D, 6 * D), 0.5 * D ** -0.5),
        'ada_b': nrm((DEPTH, 6 * D), 0.02),
        'router_w': nrm((D, N_EXPERTS), D ** -0.5),
        'router_b': nrm((N_EXPERTS,), 0.01),
        'moe_w_gate': nrm((DEPTH, N_EXPERTS, D, EXPERT_FF), D ** -0.5),
        'moe_w_up': nrm((DEPTH, N_EXPERTS, D, EXPERT_FF), D ** -0.5),
        'moe_w_down': nrm((DEPTH, N_EXPERTS, EXPERT_FF, D), EXPERT_FF ** -0.5),
    }


def reference(x, c, fox_w_in, fox_b_f, fox_q_gain, fox_k_gain, fox_w_out,
              nsa_w_in, nsa_q_gain, nsa_k_gain, nsa_cmp_pos, nsa_cmp_w1, nsa_cmp_w2, nsa_w_out,
              dil_w_in, dil_q_gain, dil_k_gain, dil_w_out,
              diff_w_in, diff_q_gain, diff_k_gain, diff_lambda, diff_sub_gain, diff_w_out,
              norm_gain, ada_w, ada_b, router_w, router_b, moe_w_gate, moe_w_up, moe_w_down):
    S = x.shape[1]
    cos, sin = rope_tables(jnp.arange(S), HEAD_DIM)
    cond = jax.nn.silu(c)
    h = x
    for i in range(DEPTH):
        mod = cond @ ada_w[i] + ada_b[i]
        sh1, sc1, g1, sh2, sc2, g2 = jnp.split(mod[:, None, :], 6, axis=-1)
        u = rms_norm(h, norm_gain[i, 0]) * (1.0 + sc1) + sh1
        kind, j = i % N_MIXERS, i // N_MIXERS
        if kind == 0:
            y = fox_mixer(u, fox_w_in[j], fox_b_f[j], fox_q_gain[j], fox_k_gain[j], fox_w_out[j])
        elif kind == 1:
            y = nsa_mixer(u, cos, sin, nsa_w_in[j], nsa_q_gain[j], nsa_k_gain[j], nsa_cmp_pos[j],
                          nsa_cmp_w1[j], nsa_cmp_w2[j], nsa_w_out[j])
        elif kind == 2:
            y = dilated_mixer(u, cos, sin, dil_w_in[j], dil_q_gain[j], dil_k_gain[j], dil_w_out[j])
        else:
            y = diff_mixer(u, cos, sin, diff_w_in[j], diff_q_gain[j], diff_k_gain[j], diff_lambda[j],
                           diff_sub_gain[j], diff_w_out[j], i)
        h = h + g1 * y
        u = rms_norm(h, norm_gain[i, 1]) * (1.0 + sc2) + sh2
        h = h + g2 * moe_ffn(u, router_w, router_b, moe_w_gate[i], moe_w_up[i], moe_w_down[i])
    return h
```

```cpp
#include <hip/hip_runtime.h>
#include <cstdio>
#include <cstdint>
namespace pg8 {
#define PG8_LAS __attribute__((address_space(3)))
typedef unsigned short bf16_t;
typedef short bf16x8 __attribute__((ext_vector_type(8)));
typedef float f32x4 __attribute__((ext_vector_type(4)));
typedef unsigned u32x4 __attribute__((ext_vector_type(4)));
constexpr int BM = 256, BK = 64, HALF = 128, HTB = HALF * BK * 2  , STAGE_BYTES = 8 * HTB, NXCD = 8, WGM = 8;

__host__ __device__ __forceinline__ int lds_byte(int r, int c) { const int st = (r >> 4) * 2 + (c >> 5), rr = r & 15, cc = c & 31, ob = rr * 64 + cc * 2; return st * 1024 + (ob ^ (((ob >> 9) & 1) << 5)); }
__host__ __device__ __forceinline__ void stage_rc(int b, int& R, int& C) { const int st = b / 1024, sb = b % 1024, swz = sb ^ (((sb >> 9) & 1) << 5); R = (st >> 1) * 16 + swz / 64; C = (st & 1) * 32 + (swz % 64) / 2; }
__host__ __device__ __forceinline__ int perm32(int rho) { const int n = rho >> 4, i = rho & 15; return 8 * (i >> 2) + 4 * n + (i & 3); }

struct Unit { int pm, pn; };
struct Gemm { const bf16_t* A; const bf16_t* Bt; int M, N, K; };

struct StaticOrder {
    int nM, nN, nwg, G, c;
    __host__ __device__ void init(int M, int N, int G_, int c_) { nM = M / BM; nN = N / BM; nwg = nM * nN; G = G_; c = c_; }
    __host__ __device__ bool next(int i, Unit& u) const {
        const long L = (long)i * G + c; if (L >= nwg) return false;
        int wgid = (int)L; { const int q = nwg / NXCD, r = nwg % NXCD, xcd = wgid % NXCD, off = wgid / NXCD; wgid = (xcd < r ? xcd * (q + 1) : r * (q + 1) + (xcd - r) * q) + off; }
        const int nig = WGM * nN, gid = wgid / nig, fm = gid * WGM, gsz = (nM - fm) < WGM ? (nM - fm) : WGM;
        u.pm = fm + ((wgid % nig) % gsz); u.pn = (wgid % nig) / gsz; return true;
    }
    __device__ __forceinline__ void a_ready(const Unit&) const {}
    __device__ __forceinline__ void done(const Unit&) const {}
};
__device__ __forceinline__ unsigned cvt_pk_bf16(float lo, float hi) { unsigned r; asm volatile("v_cvt_pk_bf16_f32 %0, %1, %2" : "=v"(r) : "v"(lo), "v"(hi)); return r; }
typedef float f32x2 __attribute__((ext_vector_type(2)));
struct EpiStore {
    static constexpr bool PERM = true, AFTER_DRAIN = false;
    bf16_t* O; int ldc; int ntn; int n_main; float* tail; int tail_n;
    __device__ __forceinline__ void operator()(const f32x4 (&acc)[2][2][4][2], const Unit& u, int wr, int wc, int fr, int fq) const {
        const int row0 = u.pm * BM + wr * 64 + fr; const int ct = u.pn % ntn;
#pragma unroll
        for (int bj = 0; bj < 2; ++bj) {
            const int col = ct * BM + bj * HALF + wc * 32 + 8 * fq;
            if (col < n_main) {
#pragma unroll
                for (int ai = 0; ai < 2; ++ai)
#pragma unroll
                    for (int m = 0; m < 4; ++m) { const f32x4 v0 = acc[ai][bj][m][0], v1 = acc[ai][bj][m][1];
                        u32x4 w; w.x = cvt_pk_bf16(v0[0], v0[1]); w.y = cvt_pk_bf16(v0[2], v0[3]); w.z = cvt_pk_bf16(v1[0], v1[1]); w.w = cvt_pk_bf16(v1[2], v1[3]);
                        *(u32x4*)(O + (size_t)(row0 + ai * HALF + m * 16) * ldc + col) = w; }
            } else if (col - n_main < tail_n) {
#pragma unroll
                for (int ai = 0; ai < 2; ++ai)
#pragma unroll
                    for (int m = 0; m < 4; ++m) { float* p = tail + (size_t)(row0 + ai * HALF + m * 16) * tail_n + (col - n_main);
                        *(f32x4*)p = acc[ai][bj][m][0]; *(f32x4*)(p + 4) = acc[ai][bj][m][1]; }
            }
        }
    }
};
struct EpiSwiGLU {
    static constexpr bool PERM = true, AFTER_DRAIN = false;
    bf16_t* H; int ntn;
    __device__ __forceinline__ void operator()(const f32x4 (&acc)[2][2][4][2], const Unit& u, int wr, int wc, int fr, int fq) const {
        const int row0 = u.pm * BM + wr * 64 + fr; const int ct = u.pn % ntn;
        typedef unsigned u32x2v __attribute__((ext_vector_type(2)));
#pragma unroll
        for (int bj = 0; bj < 2; ++bj) {
            const int hc = ct * 128 + bj * 64 + wc * 16 + 4 * fq;
#pragma unroll
            for (int ai = 0; ai < 2; ++ai)
#pragma unroll
                for (int m = 0; m < 4; ++m) { const f32x4 g = acc[ai][bj][m][0], up = acc[ai][bj][m][1]; float r[4];
#pragma unroll
                    for (int i = 0; i < 4; ++i) { const float e = __builtin_amdgcn_exp2f(-g[i] * 1.4426950408889634f); r[i] = g[i] * __builtin_amdgcn_rcpf(1.0f + e) * up[i]; }
                    u32x2v w; w.x = cvt_pk_bf16(r[0], r[1]); w.y = cvt_pk_bf16(r[2], r[3]);
                    *(u32x2v*)(H + (size_t)(row0 + ai * HALF + m * 16) * 512 + hc) = w; }
        }
    }
};
struct MoeOrder {
    const int* tile_e; int ntiles, NT, G, c;
    __device__ __forceinline__ bool next(int i, Unit& u) const {
        const int L = i * G + c; if (L >= ntiles * NT) return false;
        const int pm = L / NT, j = L % NT; u.pm = pm; u.pn = tile_e[pm] * NT + j; return true;
    }
    __device__ __forceinline__ void a_ready(const Unit&) const {}
    __device__ __forceinline__ void done(const Unit&) const {}
};
template <class Epi, class Sched, bool ALIGN_EPI = false, bool SP2 = false>
__device__ __forceinline__ void gemm_phase(PG8_LAS unsigned char* lds, const Gemm g, const Sched& S, const Epi& E) {
    int tid_ = threadIdx.x; asm volatile("" : "+v"(tid_));
    const int tid = tid_, wid = __builtin_amdgcn_readfirstlane(tid >> 6), lane = tid & 63, wr = wid >> 2, wc = wid & 3, fr = lane & 15, fq = lane >> 4;
    const int K = g.K, nt = K / BK;
    unsigned voffA[2], voffB[2];
#pragma unroll
    for (int i = 0; i < 2; ++i) { int R, C; stage_rc(tid * 16 + i * 8192, R, C); const int Rb = Epi::PERM ? ((R & ~31) + perm32(R & 31)) : R;
        voffA[i] = (unsigned)(R * K + C) * 2u; voffB[i] = (unsigned)(Rb * K + C) * 2u; }
    const size_t kstep = (size_t)(BK * 2);
    const size_t hstep = (size_t)HALF * K * 2;
    const size_t tstep = 2 * hstep;
    const unsigned ldsw = (unsigned)wid * 1024u;
    const int aoff = lds_byte(wr * 64 + fr, fq * 8), boff = lds_byte(wc * 32 + fr, fq * 8);
#define PG8_SA(b, h) (((b) * 2 + (h)) * HTB)
#define PG8_SB(b, h) ((4 + (b) * 2 + (h)) * HTB)
#define PG8_STAGE(bufoff, gbase, voff) do { _Pragma("unroll") for (int _i = 0; _i < 2; ++_i) \
        __builtin_amdgcn_global_load_lds((const unsigned*)((const char*)(gbase) + (voff)[_i]), (PG8_LAS unsigned*)(lds + (bufoff) + ldsw + _i * 8192), 16, 0, 0); } while (0)
#define PG8_LDA(dst, b, h) do { _Pragma("unroll") for (int m = 0; m < 4; ++m) _Pragma("unroll") for (int k = 0; k < 2; ++k) dst[m][k] = *(const PG8_LAS bf16x8*)(lds + PG8_SA(b, h) + aoff + m * 2048 + k * 1024); } while (0)
#define PG8_LDB(dst, b, h) do { _Pragma("unroll") for (int n = 0; n < 2; ++n) _Pragma("unroll") for (int k = 0; k < 2; ++k) dst[n][k] = *(const PG8_LAS bf16x8*)(lds + PG8_SB(b, h) + boff + n * 2048 + k * 1024); } while (0)
#define PG8_MMA(ai, bj, At, Bt) do { __builtin_amdgcn_s_setprio(1); _Pragma("unroll") for (int m = 0; m < 4; ++m) _Pragma("unroll") for (int n = 0; n < 2; ++n) _Pragma("unroll") for (int k = 0; k < 2; ++k) \
        acc[ai][bj][m][n] = __builtin_amdgcn_mfma_f32_16x16x32_bf16(Bt[n][k], At[m][k], acc[ai][bj][m][n], 0, 0, 0); __builtin_amdgcn_s_setprio(0); } while (0)
#define PG8_WAIT_V(n) asm volatile("s_waitcnt vmcnt(" #n ")" ::: "memory")
#define PG8_WAIT_L(n) asm volatile("s_waitcnt lgkmcnt(" #n ")" ::: "memory")
#define PG8_BAR __builtin_amdgcn_s_barrier()
#define PG8_SCHED __builtin_amdgcn_sched_barrier(0)
    Unit cur, nxt; int ui = 0;
    if (!S.next(0, cur)) return;
    f32x4 acc[2][2][4][2];
#pragma unroll
    for (int a = 0; a < 2; ++a)
#pragma unroll
        for (int b = 0; b < 2; ++b)
#pragma unroll
            for (int m = 0; m < 4; ++m)
#pragma unroll
                for (int n = 0; n < 2; ++n) acc[a][b][m][n] = (f32x4){0.f, 0.f, 0.f, 0.f};
    bf16x8 At[4][2], B0[2][2], B1[2][2];
    const char* cA = (const char*)g.A + (size_t)cur.pm * tstep; const char* cB = (const char*)g.Bt + (size_t)cur.pn * tstep;
    S.a_ready(cur);
    if constexpr (SP2) {
        PG8_STAGE(PG8_SB(0, 0), cB, voffB); PG8_STAGE(PG8_SB(0, 1), cB + hstep, voffB); PG8_STAGE(PG8_SA(0, 0), cA, voffA); PG8_STAGE(PG8_SA(0, 1), cA + hstep, voffA);
        if (wr == 1) PG8_BAR;
        PG8_WAIT_V(2); PG8_BAR;
        PG8_STAGE(PG8_SB(1, 0), cB + kstep, voffB); PG8_STAGE(PG8_SA(1, 0), cA + kstep, voffA); PG8_STAGE(PG8_SB(1, 1), cB + hstep + kstep, voffB);
        PG8_WAIT_V(6); PG8_BAR;
    } else {
        PG8_STAGE(PG8_SB(0, 0), cB, voffB); PG8_STAGE(PG8_SA(0, 0), cA, voffA); PG8_STAGE(PG8_SB(0, 1), cB + hstep, voffB); PG8_STAGE(PG8_SA(0, 1), cA + hstep, voffA);
        if (wr == 1) PG8_BAR;
        PG8_WAIT_V(4); PG8_BAR;
        PG8_STAGE(PG8_SB(1, 0), cB + kstep, voffB); PG8_STAGE(PG8_SA(1, 0), cA + kstep, voffA); PG8_STAGE(PG8_SB(1, 1), cB + hstep + kstep, voffB);
        PG8_WAIT_V(6); PG8_BAR;
    }
    for (;;) {
        const bool has_next = S.next(ui + 1, nxt);
        const char* nA = has_next ? (const char*)g.A + (size_t)nxt.pm * tstep : cA; const char* nB = has_next ? (const char*)g.Bt + (size_t)nxt.pn * tstep : cB;
        for (int t = 0; t < nt; t += 2) {
            const bool last = (t == nt - 2);
            const char* a1 = cA + (size_t)(t + 1) * kstep;
            const char* a2 = last ? nA : cA + (size_t)(t + 2) * kstep; const char* b2 = last ? nB : cB + (size_t)(t + 2) * kstep;
            const char* a3 = a2 + kstep; const char* b3 = b2 + kstep;
            if (last && has_next) S.a_ready(nxt);
            if constexpr (SP2) {
            PG8_LDB(B0, 0, 0); PG8_LDB(B1, 0, 1); PG8_SCHED; PG8_LDA(At, 0, 0); PG8_STAGE(PG8_SA(1, 1), a1 + hstep, voffA);
            PG8_WAIT_V(8); PG8_WAIT_L(0); PG8_BAR; PG8_MMA(0, 0, At, B0); PG8_MMA(0, 1, At, B1); PG8_BAR; PG8_SCHED;
            PG8_LDA(At, 0, 1); PG8_STAGE(PG8_SB(0, 0), b2, voffB); PG8_STAGE(PG8_SB(0, 1), b2 + hstep, voffB); PG8_STAGE(PG8_SA(0, 0), a2, voffA);
            PG8_WAIT_V(8); PG8_WAIT_L(0); PG8_BAR; PG8_MMA(1, 0, At, B0); PG8_MMA(1, 1, At, B1); PG8_BAR; PG8_SCHED;
            PG8_LDB(B0, 1, 0); PG8_LDB(B1, 1, 1); PG8_SCHED; PG8_LDA(At, 1, 0); PG8_STAGE(PG8_SA(0, 1), a2 + hstep, voffA);
            PG8_WAIT_V(8); PG8_WAIT_L(0); PG8_BAR; PG8_MMA(0, 0, At, B0); PG8_MMA(0, 1, At, B1); PG8_BAR; PG8_SCHED;
            PG8_LDA(At, 1, 1); PG8_STAGE(PG8_SB(1, 0), b3, voffB); PG8_STAGE(PG8_SB(1, 1), b3 + hstep, voffB); PG8_STAGE(PG8_SA(1, 0), a3, voffA);
            PG8_WAIT_V(8); PG8_WAIT_L(0); PG8_BAR; PG8_MMA(1, 0, At, B0); PG8_MMA(1, 1, At, B1); PG8_BAR; PG8_SCHED;
            } else {
            PG8_LDB(B0, 0, 0); PG8_SCHED; PG8_LDA(At, 0, 0); PG8_STAGE(PG8_SA(1, 1), a1 + hstep, voffA);
            PG8_WAIT_L(8); PG8_BAR; PG8_WAIT_L(0); PG8_MMA(0, 0, At, B0); PG8_BAR; PG8_SCHED;
            PG8_LDB(B1, 0, 1); PG8_STAGE(PG8_SB(0, 0), b2, voffB);
            PG8_BAR; PG8_WAIT_L(0); PG8_MMA(0, 1, At, B1); PG8_BAR;
            PG8_LDA(At, 0, 1); PG8_STAGE(PG8_SA(0, 0), a2, voffA);
            PG8_BAR; PG8_WAIT_L(0); PG8_MMA(1, 0, At, B0); PG8_BAR; PG8_SCHED;
            PG8_STAGE(PG8_SB(0, 1), b2 + hstep, voffB);
            PG8_WAIT_V(6); PG8_BAR; PG8_MMA(1, 1, At, B1); PG8_BAR;
            PG8_LDB(B0, 1, 0); PG8_SCHED; PG8_LDA(At, 1, 0); PG8_STAGE(PG8_SA(0, 1), a2 + hstep, voffA);
            PG8_WAIT_L(8); PG8_BAR; PG8_WAIT_L(0); PG8_MMA(0, 0, At, B0); PG8_BAR; PG8_SCHED;
            PG8_LDB(B1, 1, 1); PG8_STAGE(PG8_SB(1, 0), b3, voffB);
            PG8_BAR; PG8_WAIT_L(0); PG8_MMA(0, 1, At, B1); PG8_BAR;
            PG8_LDA(At, 1, 1); PG8_STAGE(PG8_SA(1, 0), a3, voffA);
            PG8_BAR; PG8_WAIT_L(0); PG8_MMA(1, 0, At, B0); PG8_BAR; PG8_SCHED;
            PG8_STAGE(PG8_SB(1, 1), b3 + hstep, voffB);
            PG8_WAIT_V(6); PG8_BAR; PG8_MMA(1, 1, At, B1); PG8_BAR;
            }
        }
        if constexpr (ALIGN_EPI) { if (wr == 0) PG8_BAR; }
        if constexpr (!Epi::AFTER_DRAIN) { E(acc, cur, wr, wc, fr, fq); S.done(cur); }
        if (!has_next) break;
#pragma unroll
        for (int a = 0; a < 2; ++a)
#pragma unroll
            for (int b = 0; b < 2; ++b)
#pragma unroll
                for (int m = 0; m < 4; ++m)
#pragma unroll
                    for (int n = 0; n < 2; ++n) acc[a][b][m][n] = (f32x4){0.f, 0.f, 0.f, 0.f};
        cur = nxt; cA = nA; cB = nB; ++ui;
        if constexpr (ALIGN_EPI) { if (wr == 1) PG8_BAR; }
    }
    PG8_WAIT_V(0);
    if constexpr (!ALIGN_EPI) { if (wr == 0) PG8_BAR; }
    PG8_BAR;
    if constexpr (Epi::AFTER_DRAIN) { E.fused(acc, cur, wr, wc, fr, fq, lds, wid, lane); S.done(cur); }
#undef PG8_SA
#undef PG8_SB
#undef PG8_STAGE
#undef PG8_LDA
#undef PG8_LDB
#undef PG8_MMA
#undef PG8_WAIT_V
#undef PG8_WAIT_L
#undef PG8_BAR
#undef PG8_SCHED
}
}
#define GAS __attribute__((address_space(1)))
#define LAS __attribute__((address_space(3)))
#define DI __device__ __forceinline__
typedef unsigned short bf16;
typedef unsigned v4u __attribute__((ext_vector_type(4)));
typedef unsigned v2u __attribute__((ext_vector_type(2)));
typedef float f32x4 __attribute__((ext_vector_type(4)));
typedef float f32x2 __attribute__((ext_vector_type(2)));
typedef GAS unsigned gu32;
#define LDS_WAIT() asm volatile("s_waitcnt lgkmcnt(0)" ::: "memory")
#define VM_WAIT() asm volatile("s_waitcnt vmcnt(0)" ::: "memory")
DI unsigned f2bf(float f) { unsigned u = __builtin_bit_cast(unsigned, f); return (u + 0x7fffu + ((u >> 16) & 1u)) >> 16; }
DI unsigned pk2(float lo, float hi) { return f2bf(lo) | (f2bf(hi) << 16); }
DI float bflo(unsigned u) { return __builtin_bit_cast(float, u << 16); }
DI float bfhi(unsigned u) { return __builtin_bit_cast(float, u & 0xffff0000u); }
DI float wave_sum(float v) {
#pragma unroll
    for (int o = 1; o < 64; o <<= 1) v += __shfl_xor(v, o);
    return v;
}
DI float wave_max(float v) {
#pragma unroll
    for (int o = 1; o < 64; o <<= 1) v = fmaxf(v, __shfl_xor(v, o));
    return v;
}
#define XB_TMO      128
#define XB_XCNT(j)  (256  + 64 * (j))
#define XB_XSUB(j)  (1280 + 64 * (j))
#define XB_XGEN(j)  (2304 + 64 * (j))
#define XB_TOP      3328
#define XB_TOPGEN   3392
#define XCD_BAR_WORDS 3456
#define XB_SPIN_CAP (1u << 18)

__device__ __forceinline__ unsigned xb_ld(unsigned* p)              { return __hip_atomic_load(p, __ATOMIC_RELAXED, __HIP_MEMORY_SCOPE_AGENT); }
__device__ __forceinline__ unsigned xb_add(unsigned* p, unsigned v) { return __hip_atomic_fetch_add(p, v, __ATOMIC_RELAXED, __HIP_MEMORY_SCOPE_AGENT); }
__device__ __forceinline__ unsigned xb_xcc_id() { return (unsigned)__builtin_amdgcn_s_getreg((3 << 11) | 20) & 0xFu; }
#define XB_SPIN(cond, bar) do { unsigned _sp = 0; while (cond) { __builtin_amdgcn_s_sleep(1); \
    if ((++_sp & 255u) == 0u) { if (xb_ld(&(bar)[XB_TMO])) break; if (_sp > XB_SPIN_CAP) { atomicAdd(&(bar)[XB_TMO], 1u); break; } } } } while (0)

struct XcdBarrier {
    unsigned* bar; unsigned x;
    volatile LAS unsigned* st;
};

__device__ __forceinline__ XcdBarrier xcd_barrier_post(unsigned* bar, volatile LAS unsigned* st) {
    XcdBarrier b; b.bar = bar; b.x = xb_xcc_id(); b.st = st;
    if (threadIdx.x == 0) (void)xb_add(&bar[XB_XCNT(b.x)], 1u);
    return b;
}
__device__ __forceinline__ void xcd_barrier_complete(unsigned* bar, unsigned x, unsigned& nloc, unsigned& nx) {
    const unsigned G = gridDim.x * gridDim.y * gridDim.z;
    unsigned sum, cnt, mine, sp = 0u;
    for (;;) {
        sum = 0u; cnt = 0u; mine = 0u;
#pragma unroll
        for (unsigned j = 0; j < 16; ++j) { const unsigned c = xb_ld(&bar[XB_XCNT(j)]); sum += c; cnt += (c > 0u) ? 1u : 0u; mine = (j == x) ? c : mine; }
        if (sum == G) break;
        __builtin_amdgcn_s_sleep(1);
        if ((++sp & 255u) == 0u) { if (xb_ld(&bar[XB_TMO])) break; if (sp > XB_SPIN_CAP) { atomicAdd(&bar[XB_TMO], 1u); break; } }
    }
    nloc = mine > 0u ? mine : 1u; nx = cnt > 0u ? cnt : 1u;
}

__device__ __forceinline__ void xcd_barrier(const XcdBarrier& b) {
    asm volatile("s_waitcnt vmcnt(0)" ::: "memory");
    __syncthreads();
    if (threadIdx.x == 0) {
        unsigned* bar = b.bar;
        __builtin_amdgcn_s_waitcnt(0);
        unsigned nloc = b.st[0], nx = b.st[1];
        if (nloc == 0u) { xcd_barrier_complete(bar, b.x, nloc, nx); b.st[0] = nloc; b.st[1] = nx; }
        const unsigned old = xb_add(&bar[XB_XSUB(b.x)], 1u);
        const unsigned gen = old / nloc;
        if (old + 1u == (gen + 1u) * nloc) {
            __builtin_amdgcn_fence(__ATOMIC_RELEASE, "agent");
            asm volatile("s_waitcnt vmcnt(0)" ::: "memory");
            const unsigned og = xb_add(&bar[XB_TOP], 1u);
            const unsigned tg = og / nx;
            if (og + 1u == (tg + 1u) * nx) xb_add(&bar[XB_TOPGEN], 1u);
            else XB_SPIN(xb_ld(&bar[XB_TOPGEN]) == tg, bar);
            __builtin_amdgcn_fence(__ATOMIC_ACQUIRE, "agent");
            xb_add(&bar[XB_XGEN(b.x)], 1u);
            asm volatile("s_waitcnt vmcnt(0)" ::: "memory");
        } else {
            XB_SPIN(xb_ld(&bar[XB_XGEN(b.x)]) == gen, bar);
            __builtin_amdgcn_fence(__ATOMIC_ACQUIRE, "agent");
            asm volatile("s_waitcnt vmcnt(0)" ::: "memory");
        }
    }
    __syncthreads();
}
constexpr int BATCH = 8, SEQ = 4096, DM = 1024, T = BATCH * SEQ, HD = 64;
constexpr int NWAVES = 8, NTHR = 512;
constexpr float EPS = 1e-6f, LOG2E = 1.4426950408889634f, QSC = 0.125f * LOG2E;
enum { I_X = 0, I_C, I_FOX_WIN, I_FOX_BF, I_FOX_QG, I_FOX_KG, I_FOX_WOUT, I_NSA_WIN, I_NSA_QG, I_NSA_KG, I_NSA_POS, I_NSA_W1, I_NSA_W2, I_NSA_WOUT,
       I_DIL_WIN, I_DIL_QG, I_DIL_KG, I_DIL_WOUT, I_DIFF_WIN, I_DIFF_QG, I_DIFF_KG, I_DIFF_LAM, I_DIFF_SG, I_DIFF_WOUT,
       I_NORM_GAIN, I_ADA_W, I_ADA_B, I_ROUTER_W, I_ROUTER_B, I_MOE_WG, I_MOE_WU, I_MOE_WD, N_IN };
constexpr size_t MiB = 1u << 20;
constexpr size_t WS_CTL = 0, CTL_ZERO_BYTES = 1 * MiB;
constexpr size_t WS_MODP = 1 * MiB, WS_MOD = 7 * MiB, WS_ROPE = 8 * MiB, WS_FLOG = 9 * MiB, WS_CUM = 11 * MiB, WS_GATE = 13 * MiB, WS_LSE = 19 * MiB, WS_SELM = 21 * MiB;
constexpr size_t WS_KC = 22 * MiB, WS_VC = 22 * MiB + 512 * 1024;
constexpr size_t WS_EIDX = 23 * MiB, WS_WTS = WS_EIDX + 256 * 1024, WS_LRANK = WS_WTS + 256 * 1024, WS_ROWOF = WS_LRANK + 256 * 1024;
constexpr size_t WS_HIST = 24 * MiB, WS_TILEE = WS_HIST + 64 * 1024, WS_NTILES = WS_TILEE + 4096;
constexpr size_t WS_FOXWIN = 32 * MiB, WS_NSAWIN = 39 * MiB, WS_DILWIN = 45 * MiB, WS_DIFFWIN = 63 * MiB, WS_WOUT = 69 * MiB;
constexpr size_t WS_MOEW = 80 * MiB, MOEW_LAYER = 48 * MiB, MOEW_D_OFF = 32 * MiB;
constexpr size_t WS_UO = 272 * MiB, WS_O2 = 336 * MiB, WS_R1 = 400 * MiB, WS_HID = WS_R1 + 136 * MiB, WS_END = 608 * MiB;
constexpr int CW_BAR = 4096;
constexpr int LDS_BYTES = 147456, MISC_OFF = 131072 + 320;
constexpr int FOX_NPAD = 3328, NSA_NPAD = 2816;

struct Args { const float* in[N_IN]; float* out; unsigned char* ws; int ph_lo, ph_hi; };
struct Ctx {
    float* hbuf; unsigned char* ws; LAS unsigned char* lds;
    int tid, lane, wave, G, blk;
};
constexpr int PTR_OFF = 131072 + 1024;
DI const float* inp(const Ctx& C, int i) {
    const unsigned long long v = ((const LAS unsigned long long*)(C.lds + PTR_OFF))[i];
    const unsigned lo = __builtin_amdgcn_readfirstlane((unsigned)v), hi = __builtin_amdgcn_readfirstlane((unsigned)(v >> 32));
    return (const float*)(((unsigned long long)hi << 32) | lo);
}

DI void conv_item(const float* W0, const float* W1, int K, int Nsrc, int ldn, bf16* WT, int mode, int nblk, int item, LAS float* scr, int lane) {
    const int kb = item / nblk, nb = item % nblk, k0 = 64 * kb, n0 = 32 * nb;
    const int n = n0 + (lane & 31);
    const float* src; bool valid;
    if (mode == 0) { valid = n < Nsrc; src = W0 + n; }
    else { const int j = n >> 3, i = n & 7; valid = true; src = ((i < 4) ? W0 : W1) + 4 * j + (i & 3); }
#pragma unroll 8
    for (int i = 0; i < 32; ++i) { const int kk = 2 * i + (lane >> 5); scr[kk * 33 + (lane & 31)] = valid ? src[(size_t)(k0 + kk) * ldn] : 0.f; }
    LDS_WAIT(); asm volatile("" ::: "memory");
    const int c = lane & 7;
#pragma unroll
    for (int j = 0; j < 4; ++j) { const int nn = (lane >> 3) + 8 * j; const LAS float* s = scr + (8 * c) * 33 + nn;
        v4u o; o.x = pk2(s[0 * 33], s[1 * 33]); o.y = pk2(s[2 * 33], s[3 * 33]); o.z = pk2(s[4 * 33], s[5 * 33]); o.w = pk2(s[6 * 33], s[7 * 33]);
        *(v4u*)(WT + (size_t)(n0 + nn) * K + k0 + 8 * c) = o; }
    LDS_WAIT(); asm volatile("" ::: "memory");
}
DI void sincos_d(double x, float& s, float& c) {
    const double k = __builtin_rint(x * 0.6366197723675814);
    double r = __builtin_fma(-k, 1.5707963267948966, x); r = __builtin_fma(-k, 6.123233995736766e-17, r);
    const int q = ((int)k) & 3; const double r2 = r * r;
    double sp = 1.0 / 6227020800.0; sp = sp * r2 - 1.0 / 39916800.0; sp = sp * r2 + 1.0 / 362880.0; sp = sp * r2 - 1.0 / 5040.0; sp = sp * r2 + 1.0 / 120.0; sp = sp * r2 - 1.0 / 6.0; sp = sp * r2 + 1.0; sp *= r;
    double cp = -1.0 / 87178291200.0; cp = cp * r2 + 1.0 / 479001600.0; cp = cp * r2 - 1.0 / 3628800.0; cp = cp * r2 + 1.0 / 40320.0; cp = cp * r2 - 1.0 / 720.0; cp = cp * r2 + 1.0 / 24.0; cp = cp * r2 - 0.5; cp = cp * r2 + 1.0;
    const double ss = (q == 0) ? sp : (q == 1) ? cp : (q == 2) ? -sp : -cp;
    const double cc = (q == 0) ? cp : (q == 1) ? -sp : (q == 2) ? -cp : sp;
    s = (float)ss; c = (float)cc;
}
DI void phase_p0a(Ctx& C) {
    const int gw = C.blk * NWAVES + C.wave, NGW = C.G * NWAVES;
    LAS float* cond = (LAS float*)C.lds;
    for (int i = C.tid; i < BATCH * DM; i += NTHR) { const float v = inp(C, I_C)[i]; cond[i] = v / (1.0f + expf(-v)); }
    __syncthreads();
    float* MODP = (float*)(C.ws + WS_MODP);
    for (int it = gw; it < 4 * 96 * 8; it += NGW) {
        const int l = it / 768, rem = it % 768, cg = rem / 8, kc = rem % 8, col = cg * 64 + C.lane;
        float acc[8];
#pragma unroll
        for (int b = 0; b < 8; ++b) acc[b] = 0.f;
        const float* w = inp(C, I_ADA_W) + ((size_t)l * DM + kc * 128) * 6144 + col;
#pragma unroll 4
        for (int k = 0; k < 128; ++k) { const float wv = w[(size_t)k * 6144];
#pragma unroll
            for (int b = 0; b < 8; ++b) acc[b] += cond[b * DM + kc * 128 + k] * wv; }
#pragma unroll
        for (int b = 0; b < 8; ++b) MODP[(((size_t)kc * 4 + l) * 8 + b) * 6144 + col] = acc[b];
    }
    __syncthreads();
    { f32x2* ROPE = (f32x2*)(C.ws + WS_ROPE);
      for (int i = C.blk * NTHR + C.tid; i < SEQ * 32; i += C.G * NTHR) { const int t = i >> 5, f = i & 31;
          const float inv = exp2f(-(float)f * (13.287712379549449f / 32.0f)); const float ang = (float)t * inv; float s, c; sincos_d((double)ang, s, c); ROPE[i] = (f32x2){c, s}; } }
    LAS float* scr = (LAS float*)(C.lds + C.wave * 16384);
    constexpr int I_FOXIN = 16 * (FOX_NPAD / 32), I_NSAIN = 16 * (NSA_NPAD / 32), I_DILIN = 16 * (9216 / 32), I_DIFFIN = 16 * (3072 / 32), I_WO = 16 * 32, I_GU = 16 * 32, I_D = 8 * 32;
    constexpr int NITEMS = I_FOXIN + I_NSAIN + I_DILIN + I_DIFFIN + 4 * I_WO + 64 * I_GU + 64 * I_D;
    for (int it = gw; it < NITEMS; it += NGW) {
        int r = it;
        if (r < I_FOXIN) { conv_item(inp(C, I_FOX_WIN), nullptr, DM, 3088, 3088, (bf16*)(C.ws + WS_FOXWIN), 0, FOX_NPAD / 32, r, scr, C.lane); continue; } r -= I_FOXIN;
        if (r < I_NSAIN) { conv_item(inp(C, I_NSA_WIN), nullptr, DM, 2608, 2608, (bf16*)(C.ws + WS_NSAWIN), 0, NSA_NPAD / 32, r, scr, C.lane); continue; } r -= I_NSAIN;
        if (r < I_DILIN) { conv_item(inp(C, I_DIL_WIN), nullptr, DM, 9216, 9216, (bf16*)(C.ws + WS_DILWIN), 0, 9216 / 32, r, scr, C.lane); continue; } r -= I_DILIN;
        if (r < I_DIFFIN) { conv_item(inp(C, I_DIFF_WIN), nullptr, DM, 3072, 3072, (bf16*)(C.ws + WS_DIFFWIN), 0, 3072 / 32, r, scr, C.lane); continue; } r -= I_DIFFIN;
        if (r < 4 * I_WO) { const int m = r / I_WO; const float* src = (m == 0) ? inp(C, I_FOX_WOUT) : (m == 1) ? inp(C, I_NSA_WOUT) : (m == 2) ? inp(C, I_DIL_WOUT) : inp(C, I_DIFF_WOUT);
            conv_item(src, nullptr, DM, DM, DM, (bf16*)(C.ws + WS_WOUT + (size_t)m * 2 * MiB), 0, 32, r % I_WO, scr, C.lane); continue; } r -= 4 * I_WO;
        if (r < 64 * I_GU) { const int le = r / I_GU, l = le / 16, e = le % 16;
            conv_item(inp(C, I_MOE_WG) + (size_t)le * DM * 512, inp(C, I_MOE_WU) + (size_t)le * DM * 512, DM, 1024, 512, (bf16*)(C.ws + WS_MOEW + (size_t)l * MOEW_LAYER + (size_t)e * 2 * MiB), 1, 32, r % I_GU, scr, C.lane); continue; } r -= 64 * I_GU;
        { const int le = r / I_D, l = le / 16, e = le % 16;
            conv_item(inp(C, I_MOE_WD) + (size_t)le * 512 * DM, nullptr, 512, DM, DM, (bf16*)(C.ws + WS_MOEW + (size_t)l * MOEW_LAYER + MOEW_D_OFF + (size_t)e * MiB), 0, 32, r % I_D, scr, C.lane); }
    }
}
DI void phase_p0b(Ctx& C) {
    const float* MODP = (const float*)(C.ws + WS_MODP); float* MOD = (float*)(C.ws + WS_MOD);
    for (int i = C.blk * NTHR + C.tid; i < 4 * 8 * 6144; i += C.G * NTHR) { const int l = i / (8 * 6144), col = i % 6144;
        float s = inp(C, I_ADA_B)[l * 6144 + col];
#pragma unroll
        for (int kc = 0; kc < 8; ++kc) s += MODP[(size_t)kc * (4 * 8 * 6144) + i];
        MOD[i] = s; }
}
DI void ld_row_f32(const float* p, int lane, f32x4 (&v)[4]) {
#pragma unroll
    for (int j = 0; j < 4; ++j) v[j] = *(const f32x4*)(p + 4 * lane + 256 * j);
}
DI void st_row_f32(float* p, int lane, const f32x4 (&v)[4]) {
#pragma unroll
    for (int j = 0; j < 4; ++j) *(f32x4*)(p + 4 * lane + 256 * j) = v[j];
}
DI void ld_row_bf16(const bf16* p, int lane, f32x4 (&v)[4]) {
#pragma unroll
    for (int j = 0; j < 4; ++j) { const v2u w = *(const v2u*)(p + 4 * lane + 256 * j); v[j] = (f32x4){bflo(w.x), bfhi(w.x), bflo(w.y), bfhi(w.y)}; }
}
DI void st_row_bf16(bf16* p, int lane, const f32x4 (&v)[4]) {
#pragma unroll
    for (int j = 0; j < 4; ++j) { v2u w; w.x = pk2(v[j].x, v[j].y); w.y = pk2(v[j].z, v[j].w); *(v2u*)(p + 4 * lane + 256 * j) = w; }
}
DI void norm_mod(const f32x4 (&h)[4], const float* gain, const float* sc, const float* sh, int lane, f32x4 (&u)[4]) {
    float ss = 0.f;
#pragma unroll
    for (int j = 0; j < 4; ++j) ss += (h[j].x * h[j].x + h[j].y * h[j].y) + (h[j].z * h[j].z + h[j].w * h[j].w);
    const float r = 1.0f / sqrtf(wave_sum(ss) * (1.0f / DM) + EPS);
#pragma unroll
    for (int j = 0; j < 4; ++j) { const f32x4 g = *(const f32x4*)(gain + 4 * lane + 256 * j), s1 = *(const f32x4*)(sc + 4 * lane + 256 * j), s0 = *(const f32x4*)(sh + 4 * lane + 256 * j);
        u[j] = (h[j] * r) * g * (s1 + 1.0f) + s0; }
}
DI void moe_combine(Ctx& C, int LP, int row, int b, f32x4 (&h)[4]) {
    const int* ROWOF = (const int*)(C.ws + WS_ROWOF); const float* WTS = (const float*)(C.ws + WS_WTS); const bf16* YS = (const bf16*)(C.ws + WS_R1);
    const float* g2 = (const float*)(C.ws + WS_MOD) + ((size_t)(LP * 8 + b) * 6 + 5) * DM;
    const int r0 = ROWOF[2 * row], r1 = ROWOF[2 * row + 1]; const float w0 = WTS[2 * row], w1 = WTS[2 * row + 1];
    f32x4 y0[4], y1[4]; ld_row_bf16(YS + (size_t)r0 * DM, C.lane, y0); ld_row_bf16(YS + (size_t)r1 * DM, C.lane, y1);
#pragma unroll
    for (int j = 0; j < 4; ++j) { const f32x4 g = *(const f32x4*)(g2 + 4 * C.lane + 256 * j); h[j] += g * (y0[j] * w0 + y1[j] * w1); }
}
template <int L> DI void phase_n1(Ctx& C) {
    const int RPB = T / C.G, RPW = RPB / NWAVES;
    const float* MOD = (const float*)(C.ws + WS_MOD); bf16* U = (bf16*)(C.ws + WS_UO);
    for (int i = 0; i < RPW; ++i) {
        const int row = C.blk * RPB + C.wave * RPW + i, b = row / SEQ;
        f32x4 h[4], u[4];
        if (L == 0) ld_row_f32(inp(C, I_X) + (size_t)row * DM, C.lane, h);
        else { ld_row_f32(C.hbuf + (size_t)row * DM, C.lane, h); moe_combine(C, L - 1, row, b, h); }
        st_row_f32(C.hbuf + (size_t)row * DM, C.lane, h);
        norm_mod(h, inp(C, I_NORM_GAIN) + (L * 2 + 0) * DM, MOD + ((size_t)(L * 8 + b) * 6 + 1) * DM, MOD + ((size_t)(L * 8 + b) * 6 + 0) * DM, C.lane, u);
        st_row_bf16(U + (size_t)row * DM, C.lane, u);
    }
}
DI void phase_final(Ctx& C) {
    const int RPB = T / C.G, RPW = RPB / NWAVES;
    for (int i = 0; i < RPW; ++i) {
        const int row = C.blk * RPB + C.wave * RPW + i, b = row / SEQ;
        f32x4 h[4]; ld_row_f32(C.hbuf + (size_t)row * DM, C.lane, h); moe_combine(C, 3, row, b, h); st_row_f32(C.hbuf + (size_t)row * DM, C.lane, h);
    }
}
template <int L> DI void phase_n2(Ctx& C, const bf16* Y) {
    const int RPB = T / C.G, RPW = RPB / NWAVES;
    const float* MOD = (const float*)(C.ws + WS_MOD); bf16* U = (bf16*)(C.ws + WS_UO);
    LAS float* wT = (LAS float*)C.lds; LAS int* hist = (LAS int*)(C.lds + 65536);
    for (int idx = C.tid; idx < DM * 16; idx += NTHR) wT[(idx & 15) * DM + (idx >> 4)] = inp(C, I_ROUTER_W)[idx];
    if (C.tid < 16) hist[C.tid] = 0;
    __syncthreads();
    int* EIDX = (int*)(C.ws + WS_EIDX); float* WTS = (float*)(C.ws + WS_WTS); int* LRANK = (int*)(C.ws + WS_LRANK);
    for (int i = 0; i < RPW; ++i) {
        const int row = C.blk * RPB + C.wave * RPW + i, b = row / SEQ;
        f32x4 h[4], y[4], u[4]; ld_row_f32(C.hbuf + (size_t)row * DM, C.lane, h); ld_row_bf16(Y + (size_t)row * DM, C.lane, y);
        const float* g1 = MOD + ((size_t)(L * 8 + b) * 6 + 2) * DM;
#pragma unroll
        for (int j = 0; j < 4; ++j) h[j] += *(const f32x4*)(g1 + 4 * C.lane + 256 * j) * y[j];
        st_row_f32(C.hbuf + (size_t)row * DM, C.lane, h);
        norm_mod(h, inp(C, I_NORM_GAIN) + (L * 2 + 1) * DM, MOD + ((size_t)(L * 8 + b) * 6 + 4) * DM, MOD + ((size_t)(L * 8 + b) * 6 + 3) * DM, C.lane, u);
        st_row_bf16(U + (size_t)row * DM, C.lane, u);
        float sc[16], sel[16];
#pragma unroll
        for (int e = 0; e < 16; ++e) { float a = 0.f;
#pragma unroll
            for (int j = 0; j < 4; ++j) { const f32x4 w = *(const LAS f32x4*)(wT + e * DM + 256 * j + 4 * C.lane); a += (u[j].x * w.x + u[j].y * w.y) + (u[j].z * w.z + u[j].w * w.w); }
            a = wave_sum(a); sc[e] = 1.0f / (1.0f + expf(-a)); sel[e] = sc[e] + inp(C, I_ROUTER_B)[e]; }
        float bs = -INFINITY, bw0 = 0.f, bw1 = 0.f; int be0 = 0, be1 = 1;
#pragma unroll
        for (int g = 0; g < 4; ++g) {
            const float a0 = sel[4 * g], a1 = sel[4 * g + 1], a2 = sel[4 * g + 2], a3 = sel[4 * g + 3];
            const float c0 = sc[4 * g], c1 = sc[4 * g + 1], c2 = sc[4 * g + 2], c3 = sc[4 * g + 3];
            int i1 = 0; float v1 = a0, s1 = c0;
            if (a1 > v1) { v1 = a1; s1 = c1; i1 = 1; } if (a2 > v1) { v1 = a2; s1 = c2; i1 = 2; } if (a3 > v1) { v1 = a3; s1 = c3; i1 = 3; }
            int i2 = -1; float v2 = -INFINITY, s2 = 0.f;
            if (i1 != 0 && a0 > v2) { v2 = a0; s2 = c0; i2 = 0; } if (i1 != 1 && a1 > v2) { v2 = a1; s2 = c1; i2 = 1; }
            if (i1 != 2 && a2 > v2) { v2 = a2; s2 = c2; i2 = 2; } if (i1 != 3 && a3 > v2) { v2 = a3; s2 = c3; i2 = 3; }
            const float gs = v1 + v2;
            if (gs > bs) { bs = gs; be0 = 4 * g + i1; be1 = 4 * g + i2; bw0 = s1; bw1 = s2; }
        }
        if (C.lane == 0) {
            const float inv = 1.0f / (bw0 + bw1);
            EIDX[2 * row] = be0; EIDX[2 * row + 1] = be1; WTS[2 * row] = bw0 * inv; WTS[2 * row + 1] = bw1 * inv;
            LRANK[2 * row] = __hip_atomic_fetch_add(hist + be0, 1, __ATOMIC_RELAXED, __HIP_MEMORY_SCOPE_WORKGROUP);
            LRANK[2 * row + 1] = __hip_atomic_fetch_add(hist + be1, 1, __ATOMIC_RELAXED, __HIP_MEMORY_SCOPE_WORKGROUP);
        }
    }
    __syncthreads();
    if (C.tid < 16) ((int*)(C.ws + WS_HIST))[C.blk * 16 + C.tid] = hist[C.tid];
    __syncthreads();
}
DI void phase_s(Ctx& C) {
    const int RPB = T / C.G, RPW = RPB / NWAVES;
    LAS int* tot = (LAS int*)C.lds; LAS int* before = tot + 16; LAS int* base = tot + 32;
    if (C.tid < 48) tot[C.tid] = 0;
    __syncthreads();
    const int* HIST = (const int*)(C.ws + WS_HIST);
    for (int idx = C.tid; idx < C.G * 16; idx += NTHR) { const int bb = idx >> 4, e = idx & 15; const int c = HIST[idx];
        __hip_atomic_fetch_add(tot + e, c, __ATOMIC_RELAXED, __HIP_MEMORY_SCOPE_WORKGROUP);
        if (bb < C.blk) __hip_atomic_fetch_add(before + e, c, __ATOMIC_RELAXED, __HIP_MEMORY_SCOPE_WORKGROUP); }
    __syncthreads();
    if (C.tid == 0) { int ps = 0; int* TILEE = (int*)(C.ws + WS_TILEE);
        for (int e = 0; e < 16; ++e) { base[e] = ps + before[e]; const int pe = (tot[e] + 255) & ~255;
            if (C.blk == 0) for (int tl = ps >> 8; tl < ((ps + pe) >> 8); ++tl) TILEE[tl] = e;
            ps += pe; }
        if (C.blk == 0) *(int*)(C.ws + WS_NTILES) = ps >> 8; }
    __syncthreads();
    const int* EIDX = (const int*)(C.ws + WS_EIDX); const int* LRANK = (const int*)(C.ws + WS_LRANK); int* ROWOF = (int*)(C.ws + WS_ROWOF);
    const bf16* U = (const bf16*)(C.ws + WS_UO); bf16* XS = (bf16*)(C.ws + WS_R1);
    for (int i = 0; i < RPW; ++i) {
        const int row = C.blk * RPB + C.wave * RPW + i;
        const int d0 = base[EIDX[2 * row]] + LRANK[2 * row], d1 = base[EIDX[2 * row + 1]] + LRANK[2 * row + 1];
        if (C.lane == 0) { ROWOF[2 * row] = d0; ROWOF[2 * row + 1] = d1; }
        const v4u a = *(const v4u*)(U + (size_t)row * DM + 8 * C.lane), bq = *(const v4u*)(U + (size_t)row * DM + 512 + 8 * C.lane);
        *(v4u*)(XS + (size_t)d0 * DM + 8 * C.lane) = a; *(v4u*)(XS + (size_t)d0 * DM + 512 + 8 * C.lane) = bq;
        *(v4u*)(XS + (size_t)d1 * DM + 8 * C.lane) = a; *(v4u*)(XS + (size_t)d1 * DM + 512 + 8 * C.lane) = bq;
    }
    __syncthreads();
}
DI void gemm_qkv(Ctx& C, const bf16* A, const bf16* Bt, int Npad, bf16* O, int ldc, int n_main, float* tail, int tail_n) {
    pg8::Gemm g{A, Bt, T, Npad, DM}; pg8::StaticOrder S; S.init(T, Npad, C.G, C.blk);
    pg8::EpiStore E{O, ldc, 1 << 20, n_main, tail, tail_n};
    pg8::gemm_phase<pg8::EpiStore, pg8::StaticOrder, true, true>(C.lds, g, S, E);
}
DI void gemm_moe1(Ctx& C, int L) {
    const int ntiles = *(const int*)(C.ws + WS_NTILES);
    pg8::Gemm g{(const bf16*)(C.ws + WS_R1), (const bf16*)(C.ws + WS_MOEW + (size_t)L * MOEW_LAYER), ntiles * 256, 16 * 1024, DM};
    pg8::MoeOrder S{(const int*)(C.ws + WS_TILEE), ntiles, 4, C.G, C.blk};
    pg8::EpiSwiGLU E{(bf16*)(C.ws + WS_HID), 4};
    pg8::gemm_phase<pg8::EpiSwiGLU, pg8::MoeOrder, true, true>(C.lds, g, S, E);
}
DI void gemm_moe2(Ctx& C, int L) {
    const int ntiles = *(const int*)(C.ws + WS_NTILES);
    pg8::Gemm g{(const bf16*)(C.ws + WS_HID), (const bf16*)(C.ws + WS_MOEW + (size_t)L * MOEW_LAYER + MOEW_D_OFF), ntiles * 256, 16 * 1024, 512};
    pg8::MoeOrder S{(const int*)(C.ws + WS_TILEE), ntiles, 4, C.G, C.blk};
    pg8::EpiStore E{(bf16*)(C.ws + WS_R1), DM, 4, DM, nullptr, 0};
    pg8::gemm_phase<pg8::EpiStore, pg8::MoeOrder, true, true>(C.lds, g, S, E);
}
struct PrepSeg { int col0, nvec; const float* gain; int rope; float scale; };
template <int NSEG> DI void prep_rows(Ctx& C, bf16* QKV, int ldq, const PrepSeg (&segs)[NSEG]) {
    const int gw = C.blk * NWAVES + C.wave, NGW = C.G * NWAVES, sub = C.lane & 7;
    const f32x2* ROPE = (const f32x2*)(C.ws + WS_ROPE);
    for (int row = gw; row < T; row += NGW) {
        const int t = row % SEQ;
#pragma unroll
        for (int sg = 0; sg < NSEG; ++sg) {
            for (int v0 = 0; v0 < segs[sg].nvec; v0 += 8) {
                const int vec = v0 + (C.lane >> 3); const bool act = vec < segs[sg].nvec; const int vv = act ? vec : 0;
                bf16* p = QKV + (size_t)row * ldq + segs[sg].col0 + vv * 64 + sub * 8;
                const v4u w = *(const v4u*)p;
                float x[8] = {bflo(w.x), bfhi(w.x), bflo(w.y), bfhi(w.y), bflo(w.z), bfhi(w.z), bflo(w.w), bfhi(w.w)};
                float ss = 0.f;
#pragma unroll
                for (int e = 0; e < 8; ++e) ss += x[e] * x[e];
                ss += __shfl_xor(ss, 1); ss += __shfl_xor(ss, 2); ss += __shfl_xor(ss, 4);
                const float r = 1.0f / sqrtf(ss * (1.0f / 64.0f) + EPS);
                const f32x4 g0 = *(const f32x4*)(segs[sg].gain + sub * 8), g1 = *(const f32x4*)(segs[sg].gain + sub * 8 + 4);
                const float gg[8] = {g0.x, g0.y, g0.z, g0.w, g1.x, g1.y, g1.z, g1.w};
#pragma unroll
                for (int e = 0; e < 8; ++e) x[e] = x[e] * r * gg[e];
                if (segs[sg].rope) {
#pragma unroll
                    for (int e = 0; e < 8; ++e) { const float pr = __shfl_xor(x[e], 4); const f32x2 cs = ROPE[t * 32 + (sub & 3) * 8 + e];
                        x[e] = (sub < 4) ? (x[e] * cs.x - pr * cs.y) : (pr * cs.y + x[e] * cs.x); }
                }
                const float sc = segs[sg].scale;
                v4u o; o.x = pk2(x[0] * sc, x[1] * sc); o.y = pk2(x[2] * sc, x[3] * sc); o.z = pk2(x[4] * sc, x[5] * sc); o.w = pk2(x[6] * sc, x[7] * sc);
                if (act) *(v4u*)p = o;
            }
        }
    }
}
DI float log_sigmoid(float x) { return (x < 0.f) ? (x - log1pf(expf(x))) : (-log1pf(expf(-x))); }
DI void fox_scan(Ctx& C) {
    const int gw = C.blk * NWAVES + C.wave, NGW = C.G * NWAVES;
    const float* FLOG = (const float*)(C.ws + WS_FLOG); float* CUM = (float*)(C.ws + WS_CUM);
    for (int task = gw; task < BATCH * 16; task += NGW) {
        const int b = task / 16, h = task % 16; const float bf = inp(C, I_FOX_BF)[h];
        const float* src = FLOG + ((size_t)b * SEQ + 64 * C.lane) * 16 + h;
        float run = 0.f;
        for (int i = 0; i < 64; ++i) run += log_sigmoid(src[(size_t)i * 16] + bf);
        float inc = run;
#pragma unroll
        for (int o = 1; o < 64; o <<= 1) { const float v = __shfl_up(inc, o); if (C.lane >= o) inc += v; }
        float acc = inc - run;
        float* dst = CUM + ((size_t)b * 16 + h) * SEQ + 64 * C.lane;
        for (int i = 0; i < 64; ++i) { acc += log_sigmoid(src[(size_t)i * 16] + bf); dst[i] = acc * LOG2E; }
    }
}
template <class AllowF, class BiasF>
DI void nattn(const bf16* qptr, const bf16* kbase, size_t kstride, const bf16* vbase, size_t vstride, int klo, int khi, AllowF allow, BiasF bias, float (&o)[64], float& m, float& l) {
    unsigned q[32];
#pragma unroll
    for (int c = 0; c < 8; ++c) { const v4u w = *(const v4u*)(qptr + 8 * c); q[4 * c] = w.x; q[4 * c + 1] = w.y; q[4 * c + 2] = w.z; q[4 * c + 3] = w.w; }
    m = -1e30f; l = 0.f;
#pragma unroll
    for (int d = 0; d < 64; ++d) o[d] = 0.f;
    for (int kk = klo; kk < khi; ++kk) {
        const bool ok = allow(kk);
        if (!__any(ok)) continue;
        const v4u* kp = (const v4u*)(kbase + (size_t)kk * kstride);
        float s = 0.f;
#pragma unroll
        for (int c = 0; c < 8; ++c) { const v4u w = kp[c];
            s += bflo(q[4 * c]) * bflo(w.x) + bfhi(q[4 * c]) * bfhi(w.x) + bflo(q[4 * c + 1]) * bflo(w.y) + bfhi(q[4 * c + 1]) * bfhi(w.y) + bflo(q[4 * c + 2]) * bflo(w.z) + bfhi(q[4 * c + 2]) * bfhi(w.z) + bflo(q[4 * c + 3]) * bflo(w.w) + bfhi(q[4 * c + 3]) * bfhi(w.w); }
        s += bias(kk);
        if (ok) {
            const float mn = fmaxf(m, s), a = exp2f(m - mn), p = exp2f(s - mn);
            l = l * a + p; m = mn;
            const v4u* vp = (const v4u*)(vbase + (size_t)kk * vstride);
#pragma unroll
            for (int c = 0; c < 8; ++c) { const v4u w = vp[c];
                o[8 * c] = o[8 * c] * a + p * bflo(w.x); o[8 * c + 1] = o[8 * c + 1] * a + p * bfhi(w.x); o[8 * c + 2] = o[8 * c + 2] * a + p * bflo(w.y); o[8 * c + 3] = o[8 * c + 3] * a + p * bfhi(w.y);
                o[8 * c + 4] = o[8 * c + 4] * a + p * bflo(w.z); o[8 * c + 5] = o[8 * c + 5] * a + p * bfhi(w.z); o[8 * c + 6] = o[8 * c + 6] * a + p * bflo(w.w); o[8 * c + 7] = o[8 * c + 7] * a + p * bfhi(w.w); }
        }
    }
}
DI void st_o64(bf16* p, const float (&o)[64], float sc) {
#pragma unroll
    for (int c = 0; c < 8; ++c) { v4u w; w.x = pk2(o[8 * c] * sc, o[8 * c + 1] * sc); w.y = pk2(o[8 * c + 2] * sc, o[8 * c + 3] * sc); w.z = pk2(o[8 * c + 4] * sc, o[8 * c + 5] * sc); w.w = pk2(o[8 * c + 6] * sc, o[8 * c + 7] * sc); *(v4u*)(p + 8 * c) = w; }
}
DI void attn_fox_naive(Ctx& C) {
    const int gw = C.blk * NWAVES + C.wave, NGW = C.G * NWAVES;
    const bf16* QKV = (const bf16*)(C.ws + WS_R1); bf16* O = (bf16*)(C.ws + WS_UO); const float* CUM = (const float*)(C.ws + WS_CUM);
    for (int task = gw; task < BATCH * 16 * 64; task += NGW) {
        const int chunk = task / 128, bh = task % 128, b = bh / 16, h = bh % 16, t = chunk * 64 + C.lane; const size_t row = (size_t)b * SEQ + t;
        const float* cum = CUM + (size_t)bh * SEQ; const float cq = cum[t];
        float o[64], m, l;
        nattn(QKV + row * 3072 + h * 64, QKV + (size_t)b * SEQ * 3072 + 1024 + h * 64, 3072, QKV + (size_t)b * SEQ * 3072 + 2048 + h * 64, 3072, 0, chunk * 64 + 64,
              [&](int kk) { return kk <= t; }, [&](int kk) { return cq - cum[kk]; }, o, m, l);
        st_o64(O + row * DM + h * 64, o, 1.0f / l);
    }
}
DI void attn_diff_naive(Ctx& C) {
    const int gw = C.blk * NWAVES + C.wave, NGW = C.G * NWAVES;
    const bf16* QKV = (const bf16*)(C.ws + WS_R1);
    for (int task = gw; task < BATCH * 16 * 64 * 2; task += NGW) {
        const int half = task & 1, t2 = task >> 1, chunk = t2 / 128, bh = t2 % 128, b = bh / 16, hh = bh % 16, t = chunk * 64 + C.lane; const size_t row = (size_t)b * SEQ + t;
        bf16* O = (bf16*)(C.ws + ((hh & 1) ? WS_O2 : WS_UO));
        float o[64], m, l;
        nattn(QKV + row * 3072 + hh * 64, QKV + (size_t)b * SEQ * 3072 + 1024 + hh * 64, 3072, QKV + (size_t)b * SEQ * 3072 + 2048 + (hh >> 1) * 128 + half * 64, 3072, 0, chunk * 64 + 64,
              [&](int kk) { return kk <= t; }, [&](int) { return 0.f; }, o, m, l);
        st_o64(O + row * DM + (hh >> 1) * 128 + half * 64, o, 1.0f / l);
    }
}
DI void diff_combine(Ctx& C) {
    const int gw = C.blk * NWAVES + C.wave, NGW = C.G * NWAVES;
    const float lam_init = 0.8f - 0.6f * expf(-0.3f * 3.0f);
    const float* lm = inp(C, I_DIFF_LAM);
    const float s01 = wave_sum(lm[C.lane] * lm[64 + C.lane]), s23 = wave_sum(lm[128 + C.lane] * lm[192 + C.lane]);
    const float lam = expf(s01) - expf(s23) + lam_init;
    bf16* O0 = (bf16*)(C.ws + WS_UO); const bf16* O1 = (const bf16*)(C.ws + WS_O2);
    for (int row = gw; row < T; row += NGW) {
        f32x4 a[4], bq[4]; ld_row_bf16(O0 + (size_t)row * DM, C.lane, a); ld_row_bf16(O1 + (size_t)row * DM, C.lane, bq);
#pragma unroll
        for (int j = 0; j < 4; ++j) { f32x4 d = a[j] - bq[j] * lam; float ss = (d.x * d.x + d.y * d.y) + (d.z * d.z + d.w * d.w);
            ss += __shfl_xor(ss, 1); ss += __shfl_xor(ss, 2); ss += __shfl_xor(ss, 4); ss += __shfl_xor(ss, 8); ss += __shfl_xor(ss, 16);
            const float r = (1.0f - lam_init) / sqrtf(ss * (1.0f / 128.0f) + EPS);
            const f32x4 g = *(const f32x4*)(inp(C, I_DIFF_SG) + ((4 * C.lane) & 127)); a[j] = d * r * g; }
        st_row_bf16(O0 + (size_t)row * DM, C.lane, a);
    }
}
DI void attn_dil_naive(Ctx& C, int gi, int dil) {
    const int gw = C.blk * NWAVES + C.wave, NGW = C.G * NWAVES;
    const bf16* QKV = (const bf16*)(C.ws + WS_R1); bf16* O = (bf16*)(C.ws + WS_O2); float* LSE = (float*)(C.ws + WS_LSE);
    const int sublen = SEQ / dil, nchunk = sublen / 64;
    for (int task = gw; task < BATCH * 16 * 64; task += NGW) {
        const int bh = task % 128, w = task / 128, b = bh / 16, h = bh % 16, r = w / nchunk, chunk = w % nchunk, u = chunk * 64 + C.lane;
        const size_t row = (size_t)b * SEQ + (size_t)u * dil + r; const size_t row0 = (size_t)b * SEQ + r;
        float o[64], m, l;
        const int klo = (chunk * 64 - 128) > 0 ? (chunk * 64 - 128) : 0;
        nattn(QKV + row * 3072 + h * 64, QKV + row0 * 3072 + 1024 + h * 64, (size_t)dil * 3072, QKV + row0 * 3072 + 2048 + h * 64, (size_t)dil * 3072, klo, chunk * 64 + 64,
              [&](int kk) { return kk <= u && u - kk <= 128; }, [&](int) { return 0.f; }, o, m, l);
        const float inv = 1.0f / l; float lse = m + log2f(l);
        bf16* op = O + row * DM + h * 64;
        if (gi == 0) { st_o64(op, o, inv); LSE[row * 16 + h] = lse; }
        else {
            const float lo = LSE[row * 16 + h], mx = fmaxf(lo, lse), ea = exp2f(lo - mx), eb = exp2f(lse - mx), rs = 1.0f / (ea + eb), fa = ea * rs, fb = eb * rs * inv;
#pragma unroll
            for (int c = 0; c < 8; ++c) { const v4u w = *(const v4u*)(op + 8 * c);
                o[8 * c] = bflo(w.x) * fa + o[8 * c] * fb; o[8 * c + 1] = bfhi(w.x) * fa + o[8 * c + 1] * fb; o[8 * c + 2] = bflo(w.y) * fa + o[8 * c + 2] * fb; o[8 * c + 3] = bfhi(w.y) * fa + o[8 * c + 3] * fb;
                o[8 * c + 4] = bflo(w.z) * fa + o[8 * c + 4] * fb; o[8 * c + 5] = bfhi(w.z) * fa + o[8 * c + 5] * fb; o[8 * c + 6] = bflo(w.w) * fa + o[8 * c + 6] * fb; o[8 * c + 7] = bfhi(w.w) * fa + o[8 * c + 7] * fb; }
            st_o64(op, o, 1.0f); LSE[row * 16 + h] = mx + log2f(ea + eb);
        }
    }
}
constexpr int NSA_LDQ = 2560;
DI void nsa_compress(Ctx& C) {
    const bf16* QKV = (const bf16*)(C.ws + WS_R1); const f32x2* ROPE = (const f32x2*)(C.ws + WS_ROPE);
    LAS float* vec = (LAS float*)C.lds;
    LAS float* part = (LAS float*)(C.lds + 65536);
    LAS float* hid = (LAS float*)(C.lds + 65536 + 8192);
    float* KC = (float*)(C.ws + WS_KC); float* VC = (float*)(C.ws + WS_VC);
    for (int task = C.blk; task < 1024; task += C.G) {
        const int which = task / 512, r = task % 512, b = r / 64, g = (r / 16) % 4, n0 = (r % 16) * 4;
        const int col = (which == 0 ? 1024 : 1280) + g * 64;
        const float* pos = inp(C, I_NSA_POS) + which * 4096;
        for (int idx = C.tid; idx < 16384; idx += NTHR) { const int tsk = idx >> 12, rem = idx & 4095, l = rem >> 6, d = rem & 63;
            const unsigned short raw = QKV[((size_t)b * SEQ + (n0 + tsk) * 64 + l) * NSA_LDQ + col + d];
            vec[idx] = __builtin_bit_cast(float, (unsigned)raw << 16) + pos[rem]; }
        __syncthreads();
        { const int j = C.tid & 127, pt = C.tid >> 7; float a0 = 0.f, a1 = 0.f, a2 = 0.f, a3 = 0.f;
          const float* w1 = inp(C, I_NSA_W1) + ((size_t)which * 4096 + pt * 1024) * 128 + j; const LAS float* vv = vec + pt * 1024;
#pragma unroll 8
          for (int k = 0; k < 1024; ++k) { const float w = w1[(size_t)k * 128]; a0 += vv[k] * w; a1 += vv[4096 + k] * w; a2 += vv[8192 + k] * w; a3 += vv[12288 + k] * w; }
          part[(pt * 4 + 0) * 128 + j] = a0; part[(pt * 4 + 1) * 128 + j] = a1; part[(pt * 4 + 2) * 128 + j] = a2; part[(pt * 4 + 3) * 128 + j] = a3; }
        __syncthreads();
        { const int tsk = C.tid >> 7, j = C.tid & 127; const float s = (part[(0 * 4 + tsk) * 128 + j] + part[(1 * 4 + tsk) * 128 + j]) + (part[(2 * 4 + tsk) * 128 + j] + part[(3 * 4 + tsk) * 128 + j]);
          hid[tsk * 128 + j] = s / (1.0f + expf(-s)); }
        __syncthreads();
        if (C.tid < 256) { const int tsk = C.tid >> 6, d = C.tid & 63; float o = 0.f;
            const float* w2 = inp(C, I_NSA_W2) + (size_t)which * 128 * 64 + d;
#pragma unroll 8
            for (int j = 0; j < 128; ++j) o += hid[tsk * 128 + j] * w2[j * 64];
            const size_t oi = (((size_t)b * 4 + g) * 64 + n0 + tsk) * 64 + d;
            if (which == 1) VC[oi] = o;
            else { const float ss = wave_sum(o * o); float y = o / sqrtf(ss * (1.0f / 64.0f) + EPS) * inp(C, I_NSA_KG)[d];
                const float pr = __shfl_xor(y, 32); const f32x2 cs = ROPE[((n0 + tsk) * 64 + 63) * 32 + (d & 31)];
                KC[oi] = (d < 32) ? (y * cs.x - pr * cs.y) : (pr * cs.y + y * cs.x); } }
        __syncthreads();
    }
}
DI float rdl(float v, int l) { return __builtin_bit_cast(float, __builtin_amdgcn_readlane(__builtin_bit_cast(int, v), l)); }
DI void nsa_cmp_select(Ctx& C) {
    const bf16* QKV = (const bf16*)(C.ws + WS_R1); bf16* OC = (bf16*)(C.ws + WS_O2); const float* GATE = (const float*)(C.ws + WS_GATE);
    const float* KC = (const float*)(C.ws + WS_KC); const float* VC = (const float*)(C.ws + WS_VC); unsigned long long* SELM = (unsigned long long*)(C.ws + WS_SELM);
    LAS float* kcT = (LAS float*)C.lds;
    LAS float* vcl = (LAS float*)(C.lds + 16384);
    for (int task = C.blk; task < BATCH * 4 * 8; task += C.G) {
        const int b = task / 32, g = (task / 8) % 4, cur = (task % 8) * 8 + C.wave;
        __syncthreads();
        for (int idx = C.tid; idx < 4096; idx += NTHR) { const int j = idx >> 6, d = idx & 63; kcT[d * 64 + j] = KC[((size_t)b * 4 + g) * 4096 + idx]; vcl[idx] = VC[((size_t)b * 4 + g) * 4096 + idx]; }
        __syncthreads();
        for (int tt = 0; tt < 64; ++tt) {
            const int t = cur * 64 + tt; const size_t row = (size_t)b * SEQ + t; const int nvalid = cur + (tt == 63 ? 1 : 0);
            const bool valid = C.lane < nvalid;
            float imp = 0.f;
#pragma unroll 1
            for (int p = 0; p < 4; ++p) {
                const int head = g * 4 + p;
                const float qv = __builtin_bit_cast(float, (unsigned)QKV[row * NSA_LDQ + head * 64 + C.lane] << 16);
                float s = 0.f;
#pragma unroll 8
                for (int d = 0; d < 64; ++d) s += rdl(qv, d) * kcT[d * 64 + C.lane];
                const float mx = wave_max(valid ? s : -1e30f); const float e = valid ? exp2f(s - mx) : 0.f;
                const float den = fmaxf(wave_sum(e), 1e-30f); const float pj = e / den;
                imp += pj;
                float o = 0.f;
#pragma unroll 8
                for (int j = 0; j < 64; ++j) o += rdl(pj, j) * vcl[j * 64 + C.lane];
                const float g0 = 1.0f / (1.0f + expf(-GATE[row * 48 + head]));
                OC[row * DM + head * 64 + C.lane] = (bf16)f2bf(g0 * o);
            }
            const float v = (C.lane > cur) ? -1.0f : ((C.lane == 0 || C.lane == cur || C.lane == cur - 1) ? 5.0f : imp);
            int rank = 0;
#pragma unroll 8
            for (int j = 0; j < 64; ++j) { const float vj = rdl(v, j); rank += (vj > v || (vj == v && j < C.lane)) ? 1 : 0; }
            unsigned long long mask = __ballot(rank < 16);
            if (cur < 63) mask &= ((2ull << cur) - 1ull);
            if (C.lane == 0) SELM[((size_t)b * 4 + g) * SEQ + t] = mask;
        }
    }
    __syncthreads();
}
DI void attn_nsa_naive(Ctx& C) {
    const int gw = C.blk * NWAVES + C.wave, NGW = C.G * NWAVES;
    const bf16* QKV = (const bf16*)(C.ws + WS_R1); bf16* O = (bf16*)(C.ws + WS_UO); const bf16* OC = (const bf16*)(C.ws + WS_O2); const float* GATE = (const float*)(C.ws + WS_GATE);
    const unsigned long long* SELM = (const unsigned long long*)(C.ws + WS_SELM);
    for (int task = gw; task < BATCH * 16 * 64; task += NGW) {
        const int chunk = task / 128, bh = task % 128, b = bh / 16, head = bh % 16, g = head >> 2, t = chunk * 64 + C.lane; const size_t row = (size_t)b * SEQ + t;
        const size_t kb = (size_t)b * SEQ * NSA_LDQ;
        const unsigned long long mask = SELM[((size_t)b * 4 + g) * SEQ + t];
        float o[64], m, l;
        nattn(QKV + row * NSA_LDQ + head * 64, QKV + kb + 1536 + g * 64, NSA_LDQ, QKV + kb + 1792 + g * 64, NSA_LDQ, 0, chunk * 64 + 64,
              [&](int kk) { return ((mask >> (kk >> 6)) & 1ull) != 0ull && kk <= t; }, [&](int) { return 0.f; }, o, m, l);
        { const float g1 = 1.0f / (1.0f + expf(-GATE[row * 48 + 16 + head])) / l; const bf16* ocp = OC + row * DM + head * 64; bf16* op = O + row * DM + head * 64;
#pragma unroll
          for (int c = 0; c < 8; ++c) { const v4u w = *(const v4u*)(ocp + 8 * c); v4u r;
              r.x = pk2(bflo(w.x) + g1 * o[8 * c], bfhi(w.x) + g1 * o[8 * c + 1]); r.y = pk2(bflo(w.y) + g1 * o[8 * c + 2], bfhi(w.y) + g1 * o[8 * c + 3]);
              r.z = pk2(bflo(w.z) + g1 * o[8 * c + 4], bfhi(w.z) + g1 * o[8 * c + 5]); r.w = pk2(bflo(w.w) + g1 * o[8 * c + 6], bfhi(w.w) + g1 * o[8 * c + 7]); *(v4u*)(op + 8 * c) = r; } }
    }
    asm volatile("s_waitcnt vmcnt(0)" ::: "memory");
    for (int task = gw; task < BATCH * 16 * 64; task += NGW) {
        const int chunk = task / 128, bh = task % 128, b = bh / 16, head = bh % 16, g = head >> 2, t = chunk * 64 + C.lane; const size_t row = (size_t)b * SEQ + t;
        const size_t kb = (size_t)b * SEQ * NSA_LDQ;
        float o[64], m, l;
        const int klo = (chunk * 64 - 511) > 0 ? (chunk * 64 - 511) : 0;
        nattn(QKV + row * NSA_LDQ + head * 64, QKV + kb + 2048 + g * 64, NSA_LDQ, QKV + kb + 2304 + g * 64, NSA_LDQ, klo, chunk * 64 + 64,
              [&](int kk) { return kk <= t && t - kk < 512; }, [&](int) { return 0.f; }, o, m, l);
        { const float g2 = 1.0f / (1.0f + expf(-GATE[row * 48 + 32 + head])) / l; bf16* op = O + row * DM + head * 64;
#pragma unroll
          for (int c = 0; c < 8; ++c) { const v4u p = *(const v4u*)(op + 8 * c); v4u w;
              w.x = pk2(bflo(p.x) + g2 * o[8 * c], bfhi(p.x) + g2 * o[8 * c + 1]); w.y = pk2(bflo(p.y) + g2 * o[8 * c + 2], bfhi(p.y) + g2 * o[8 * c + 3]);
              w.z = pk2(bflo(p.z) + g2 * o[8 * c + 4], bfhi(p.z) + g2 * o[8 * c + 5]); w.w = pk2(bflo(p.w) + g2 * o[8 * c + 6], bfhi(p.w) + g2 * o[8 * c + 7]);
              *(v4u*)(op + 8 * c) = w; } }
    }
}
__global__ void __launch_bounds__(NTHR, 2) hybrid_fwd(Args args) {
    extern __shared__ __attribute__((aligned(16))) unsigned char lds_raw[];
    Ctx C;
    C.hbuf = args.out; C.ws = args.ws; C.lds = (LAS unsigned char*)lds_raw;
    C.tid = threadIdx.x; C.lane = C.tid & 63; C.wave = __builtin_amdgcn_readfirstlane(C.tid >> 6); C.G = gridDim.x; C.blk = blockIdx.x;
    volatile LAS unsigned* MISC = (volatile LAS unsigned*)(C.lds + MISC_OFF);
    if (C.tid < 32) MISC[C.tid] = 0u;
    if (C.tid == 0) {
#pragma unroll
        for (int i = 0; i < N_IN; ++i) ((LAS unsigned long long*)(C.lds + PTR_OFF))[i] = (unsigned long long)args.in[i];
    }
    __syncthreads();
    const int lo = args.ph_lo, hi = args.ph_hi;
    unsigned* barw = (unsigned*)(C.ws + WS_CTL) + CW_BAR;
    XcdBarrier bar; bar.bar = barw; bar.x = 0; bar.st = nullptr;
    if (hi - lo > 1) bar = xcd_barrier_post(barw, MISC + 8);
    int ph = 0;
#ifndef DBG_ONLY
#define DBG_ONLY -1
#endif
#define PHASE(tag, ...) do { if ((DBG_ONLY < 0 || DBG_ONLY == (tag)) && lo <= ph && ph < hi) { { int t_ = threadIdx.x; asm volatile("" : "+v"(t_)); C.tid = t_; C.lane = t_ & 63; } __VA_ARGS__; if (ph + 1 < hi) xcd_barrier(bar); } ++ph; } while (0)
    bf16* const UO = (bf16*)(C.ws + WS_UO); bf16* const O2 = (bf16*)(C.ws + WS_O2); bf16* const R1 = (bf16*)(C.ws + WS_R1);
    const float* const WQ_ = nullptr; (void)WQ_;

    PHASE(0, phase_p0a(C));
    PHASE(0, phase_p0b(C));
    PHASE(1, phase_n1<0>(C));
    PHASE(2, gemm_qkv(C, UO, (const bf16*)(C.ws + WS_FOXWIN), FOX_NPAD, R1, 3072, 3072, (float*)(C.ws + WS_FLOG), 16));
    PHASE(3, { const PrepSeg segs[2] = {{0, 16, inp(C, I_FOX_QG), 0, QSC}, {1024, 16, inp(C, I_FOX_KG), 0, 1.0f}}; prep_rows<2>(C, R1, 3072, segs); fox_scan(C); });
    PHASE(4, attn_fox_naive(C));
    PHASE(2, gemm_qkv(C, UO, (const bf16*)(C.ws + WS_WOUT), DM, R1, DM, DM, nullptr, 0));
    PHASE(5, phase_n2<0>(C, R1));
    PHASE(6, phase_s(C));
    PHASE(7, gemm_moe1(C, 0));
    PHASE(8, gemm_moe2(C, 0));
    PHASE(1, phase_n1<1>(C));
    PHASE(2, gemm_qkv(C, UO, (const bf16*)(C.ws + WS_NSAWIN), NSA_NPAD, R1, NSA_LDQ, NSA_LDQ, (float*)(C.ws + WS_GATE), 48));
    PHASE(3, { const PrepSeg segs[3] = {{0, 16, inp(C, I_NSA_QG), 1, QSC}, {1536, 4, inp(C, I_NSA_KG) + 64, 1, 1.0f}, {2048, 4, inp(C, I_NSA_KG) + 128, 1, 1.0f}}; prep_rows<3>(C, R1, NSA_LDQ, segs); nsa_compress(C); });
    PHASE(9, nsa_cmp_select(C));
    PHASE(10, attn_nsa_naive(C));
    PHASE(2, gemm_qkv(C, UO, (const bf16*)(C.ws + WS_WOUT + 2 * MiB), DM, R1, DM, DM, nullptr, 0));
    PHASE(5, phase_n2<1>(C, R1));
    PHASE(6, phase_s(C));
    PHASE(7, gemm_moe1(C, 1));
    PHASE(8, gemm_moe2(C, 1));
    PHASE(1, phase_n1<2>(C));
#pragma unroll
    for (int gi = 0; gi < 3; ++gi) {
        const int dil = (gi == 0) ? 1 : (gi == 1) ? 4 : 16;
        PHASE(2, gemm_qkv(C, UO, (const bf16*)(C.ws + WS_DILWIN) + (size_t)gi * 3072 * DM, 3072, R1, 3072, 3072, nullptr, 0));
        PHASE(3, { const PrepSeg segs[2] = {{0, 16, inp(C, I_DIL_QG), 1, QSC}, {1024, 16, inp(C, I_DIL_KG), 1, 1.0f}}; prep_rows<2>(C, R1, 3072, segs); });
        PHASE(11, attn_dil_naive(C, gi, dil));
    }
    PHASE(2, gemm_qkv(C, O2, (const bf16*)(C.ws + WS_WOUT + 4 * MiB), DM, R1, DM, DM, nullptr, 0));
    PHASE(5, phase_n2<2>(C, R1));
    PHASE(6, phase_s(C));
    PHASE(7, gemm_moe1(C, 2));
    PHASE(8, gemm_moe2(C, 2));
    PHASE(1, phase_n1<3>(C));
    PHASE(2, gemm_qkv(C, UO, (const bf16*)(C.ws + WS_DIFFWIN), 3072, R1, 3072, 3072, nullptr, 0));
    PHASE(3, { const PrepSeg segs[2] = {{0, 16, inp(C, I_DIFF_QG), 1, QSC}, {1024, 16, inp(C, I_DIFF_KG), 1, 1.0f}}; prep_rows<2>(C, R1, 3072, segs); });
    PHASE(12, attn_diff_naive(C));
    PHASE(13, diff_combine(C));
    PHASE(2, gemm_qkv(C, UO, (const bf16*)(C.ws + WS_WOUT + 6 * MiB), DM, R1, DM, DM, nullptr, 0));
    PHASE(5, phase_n2<3>(C, R1));
    PHASE(6, phase_s(C));
    PHASE(7, gemm_moe1(C, 3));
    PHASE(8, gemm_moe2(C, 3));
    PHASE(1, phase_final(C));
#undef PHASE
}
constexpr int N_PHASES = 2 + 9 + 10 + 15 + 10 + 1;

#ifndef MK_PER_PHASE
#define MK_PER_PHASE 0
#endif
extern "C" void kernel_launch(void* const* d_in, const int* in_sizes, int n_in, void* d_out, int out_size, void* d_ws, size_t ws_size, hipStream_t stream) {
    static int grid = 0;
    if (grid == 0) {
        if (n_in != N_IN || out_size != T * DM || ws_size < WS_END) { fprintf(stderr, "kernel_launch: unexpected shapes (n_in %d out %d ws %zu)\n", n_in, out_size, ws_size); grid = -1; return; }
        int dev = 0, cus = 0, per_cu = 0;
        if (hipGetDevice(&dev) != hipSuccess || hipDeviceGetAttribute(&cus, hipDeviceAttributeMultiprocessorCount, dev) != hipSuccess) { grid = -1; return; }
        if (hipFuncSetAttribute((const void*)hybrid_fwd, hipFuncAttributeMaxDynamicSharedMemorySize, LDS_BYTES) != hipSuccess) { fprintf(stderr, "kernel_launch: hipFuncSetAttribute failed\n"); grid = -1; return; }
        if (hipOccupancyMaxActiveBlocksPerMultiprocessor(&per_cu, (const void*)hybrid_fwd, NTHR, LDS_BYTES) != hipSuccess || per_cu < 1) fprintf(stderr, "kernel_launch: occupancy query reports %d\n", per_cu);
        (void)hipGetLastError();
        grid = (cus >= 256) ? 256 : (cus >= 128) ? 128 : 64;
    }
    if (grid < 0) return;
    (void)hipMemsetAsync((char*)d_ws + WS_CTL, 0, CTL_ZERO_BYTES, stream);
    Args a{};
    for (int i = 0; i < N_IN; ++i) a.in[i] = (const float*)d_in[i];
    a.out = (float*)d_out; a.ws = (unsigned char*)d_ws;
#if MK_PER_PHASE
    for (int p = 0; p < N_PHASES; ++p) { a.ph_lo = p; a.ph_hi = p + 1; hipLaunchKernelGGL(hybrid_fwd, dim3(grid), dim3(NTHR), LDS_BYTES, stream, a); }
#else
    a.ph_lo = 0; a.ph_hi = N_PHASES;
    hipLaunchKernelGGL(hybrid_fwd, dim3(grid), dim3(NTHR), LDS_BYTES, stream, a);
#endif
    const hipError_t le = hipPeekAtLastError();
    if (le != hipSuccess) fprintf(stderr, "kernel_launch: launch failed: %s\n", hipGetErrorName(le));
}
```

```cpp
#include <hip/hip_runtime.h>
#include <cstdio>
#include <cstdint>
namespace pg8 {
#define PG8_LAS __attribute__((address_space(3)))
typedef unsigned short bf16_t;
typedef short bf16x8 __attribute__((ext_vector_type(8)));
typedef float f32x4 __attribute__((ext_vector_type(4)));
typedef unsigned u32x4 __attribute__((ext_vector_type(4)));
constexpr int BM = 256, BK = 64, HALF = 128, HTB = HALF * BK * 2  , STAGE_BYTES = 8 * HTB, NXCD = 8, WGM = 8;

__host__ __device__ __forceinline__ int lds_byte(int r, int c) { const int st = (r >> 4) * 2 + (c >> 5), rr = r & 15, cc = c & 31, ob = rr * 64 + cc * 2; return st * 1024 + (ob ^ (((ob >> 9) & 1) << 5)); }
__host__ __device__ __forceinline__ void stage_rc(int b, int& R, int& C) { const int st = b / 1024, sb = b % 1024, swz = sb ^ (((sb >> 9) & 1) << 5); R = (st >> 1) * 16 + swz / 64; C = (st & 1) * 32 + (swz % 64) / 2; }
__host__ __device__ __forceinline__ int perm32(int rho) { const int n = rho >> 4, i = rho & 15; return 8 * (i >> 2) + 4 * n + (i & 3); }

struct Unit { int pm, pn; };
struct Gemm { const bf16_t* A; const bf16_t* Bt; int M, N, K; };

struct StaticOrder {
    int nM, nN, nwg, G, c;
    __host__ __device__ void init(int M, int N, int G_, int c_) { nM = M / BM; nN = N / BM; nwg = nM * nN; G = G_; c = c_; }
    __host__ __device__ bool next(int i, Unit& u) const {
        const long L = (long)i * G + c; if (L >= nwg) return false;
        int wgid = (int)L; { const int q = nwg / NXCD, r = nwg % NXCD, xcd = wgid % NXCD, off = wgid / NXCD; wgid = (xcd < r ? xcd * (q + 1) : r * (q + 1) + (xcd - r) * q) + off; }
        const int nig = WGM * nN, gid = wgid / nig, fm = gid * WGM, gsz = (nM - fm) < WGM ? (nM - fm) : WGM;
        u.pm = fm + ((wgid % nig) % gsz); u.pn = (wgid % nig) / gsz; return true;
    }
    __device__ __forceinline__ void a_ready(const Unit&) const {}
    __device__ __forceinline__ void done(const Unit&) const {}
};
__device__ __forceinline__ unsigned cvt_pk_bf16(float lo, float hi) { unsigned r; asm volatile("v_cvt_pk_bf16_f32 %0, %1, %2" : "=v"(r) : "v"(lo), "v"(hi)); return r; }
typedef float f32x2 __attribute__((ext_vector_type(2)));
struct EpiStore {
    static constexpr bool PERM = true, AFTER_DRAIN = false;
    bf16_t* O; int ldc; int ntn; int n_main; float* tail; int tail_n;
    __device__ __forceinline__ void operator()(const f32x4 (&acc)[2][2][4][2], const Unit& u, int wr, int wc, int fr, int fq) const {
        const int row0 = u.pm * BM + wr * 64 + fr; const int ct = u.pn % ntn;
#pragma unroll
        for (int bj = 0; bj < 2; ++bj) {
            const int col = ct * BM + bj * HALF + wc * 32 + 8 * fq;
            if (col < n_main) {
#pragma unroll
                for (int ai = 0; ai < 2; ++ai)
#pragma unroll
                    for (int m = 0; m < 4; ++m) { const f32x4 v0 = acc[ai][bj][m][0], v1 = acc[ai][bj][m][1];
                        u32x4 w; w.x = cvt_pk_bf16(v0[0], v0[1]); w.y = cvt_pk_bf16(v0[2], v0[3]); w.z = cvt_pk_bf16(v1[0], v1[1]); w.w = cvt_pk_bf16(v1[2], v1[3]);
                        *(u32x4*)(O + (size_t)(row0 + ai * HALF + m * 16) * ldc + col) = w; }
            } else if (col - n_main < tail_n) {
#pragma unroll
                for (int ai = 0; ai < 2; ++ai)
#pragma unroll
                    for (int m = 0; m < 4; ++m) { float* p = tail + (size_t)(row0 + ai * HALF + m * 16) * tail_n + (col - n_main);
                        *(f32x4*)p = acc[ai][bj][m][0]; *(f32x4*)(p + 4) = acc[ai][bj][m][1]; }
            }
        }
    }
};
struct EpiSwiGLU {
    static constexpr bool PERM = true, AFTER_DRAIN = false;
    bf16_t* H; int ntn;
    __device__ __forceinline__ void operator()(const f32x4 (&acc)[2][2][4][2], const Unit& u, int wr, int wc, int fr, int fq) const {
        const int row0 = u.pm * BM + wr * 64 + fr; const int ct = u.pn % ntn;
        typedef unsigned u32x2v __attribute__((ext_vector_type(2)));
#pragma unroll
        for (int bj = 0; bj < 2; ++bj) {
            const int hc = ct * 128 + bj * 64 + wc * 16 + 4 * fq;
#pragma unroll
            for (int ai = 0; ai < 2; ++ai)
#pragma unroll
                for (int m = 0; m < 4; ++m) { const f32x4 g = acc[ai][bj][m][0], up = acc[ai][bj][m][1]; float r[4];
#pragma unroll
                    for (int i = 0; i < 4; ++i) { const float e = __builtin_amdgcn_exp2f(-g[i] * 1.4426950408889634f); r[i] = g[i] * __builtin_amdgcn_rcpf(1.0f + e) * up[i]; }
                    u32x2v w; w.x = cvt_pk_bf16(r[0], r[1]); w.y = cvt_pk_bf16(r[2], r[3]);
                    *(u32x2v*)(H + (size_t)(row0 + ai * HALF + m * 16) * 512 + hc) = w; }
        }
    }
};
struct MoeOrder {
    const int* tile_e; int ntiles, NT, G, c;
    __device__ __forceinline__ bool next(int i, Unit& u) const {
        const int L = i * G + c; if (L >= ntiles * NT) return false;
        const int pm = L / NT, j = L % NT; u.pm = pm; u.pn = tile_e[pm] * NT + j; return true;
    }
    __device__ __forceinline__ void a_ready(const Unit&) const {}
    __device__ __forceinline__ void done(const Unit&) const {}
};
template <class Epi, class Sched, bool ALIGN_EPI = false, bool SP2 = false>
__device__ __forceinline__ void gemm_phase(PG8_LAS unsigned char* lds, const Gemm g, const Sched& S, const Epi& E) {
    int tid_ = threadIdx.x; asm volatile("" : "+v"(tid_));
    const int tid = tid_, wid = __builtin_amdgcn_readfirstlane(tid >> 6), lane = tid & 63, wr = wid >> 2, wc = wid & 3, fr = lane & 15, fq = lane >> 4;
    const int K = g.K, nt = K / BK;
    unsigned voffA[2], voffB[2];
#pragma unroll
    for (int i = 0; i < 2; ++i) { int R, C; stage_rc(tid * 16 + i * 8192, R, C); const int Rb = Epi::PERM ? ((R & ~31) + perm32(R & 31)) : R;
        voffA[i] = (unsigned)(R * K + C) * 2u; voffB[i] = (unsigned)(Rb * K + C) * 2u; }
    const size_t kstep = (size_t)(BK * 2);
    const size_t hstep = (size_t)HALF * K * 2;
    const size_t tstep = 2 * hstep;
    const unsigned ldsw = (unsigned)wid * 1024u;
    const int aoff = lds_byte(wr * 64 + fr, fq * 8), boff = lds_byte(wc * 32 + fr, fq * 8);
#define PG8_SA(b, h) (((b) * 2 + (h)) * HTB)
#define PG8_SB(b, h) ((4 + (b) * 2 + (h)) * HTB)
#define PG8_STAGE(bufoff, gbase, voff) do { _Pragma("unroll") for (int _i = 0; _i < 2; ++_i) \
        __builtin_amdgcn_global_load_lds((const unsigned*)((const char*)(gbase) + (voff)[_i]), (PG8_LAS unsigned*)(lds + (bufoff) + ldsw + _i * 8192), 16, 0, 0); } while (0)
#define PG8_LDA(dst, b, h) do { _Pragma("unroll") for (int m = 0; m < 4; ++m) _Pragma("unroll") for (int k = 0; k < 2; ++k) dst[m][k] = *(const PG8_LAS bf16x8*)(lds + PG8_SA(b, h) + aoff + m * 2048 + k * 1024); } while (0)
#define PG8_LDB(dst, b, h) do { _Pragma("unroll") for (int n = 0; n < 2; ++n) _Pragma("unroll") for (int k = 0; k < 2; ++k) dst[n][k] = *(const PG8_LAS bf16x8*)(lds + PG8_SB(b, h) + boff + n * 2048 + k * 1024); } while (0)
#define PG8_MMA(ai, bj, At, Bt) do { __builtin_amdgcn_s_setprio(1); _Pragma("unroll") for (int m = 0; m < 4; ++m) _Pragma("unroll") for (int n = 0; n < 2; ++n) _Pragma("unroll") for (int k = 0; k < 2; ++k) \
        acc[ai][bj][m][n] = __builtin_amdgcn_mfma_f32_16x16x32_bf16(Bt[n][k], At[m][k], acc[ai][bj][m][n], 0, 0, 0); __builtin_amdgcn_s_setprio(0); } while (0)
#define PG8_WAIT_V(n) asm volatile("s_waitcnt vmcnt(" #n ")" ::: "memory")
#define PG8_WAIT_L(n) asm volatile("s_waitcnt lgkmcnt(" #n ")" ::: "memory")
#define PG8_BAR __builtin_amdgcn_s_barrier()
#define PG8_SCHED __builtin_amdgcn_sched_barrier(0)
    Unit cur, nxt; int ui = 0;
    if (!S.next(0, cur)) return;
    f32x4 acc[2][2][4][2];
#pragma unroll
    for (int a = 0; a < 2; ++a)
#pragma unroll
        for (int b = 0; b < 2; ++b)
#pragma unroll
            for (int m = 0; m < 4; ++m)
#pragma unroll
                for (int n = 0; n < 2; ++n) acc[a][b][m][n] = (f32x4){0.f, 0.f, 0.f, 0.f};
    bf16x8 At[4][2], B0[2][2], B1[2][2];
    const char* cA = (const char*)g.A + (size_t)cur.pm * tstep; const char* cB = (const char*)g.Bt + (size_t)cur.pn * tstep;
    S.a_ready(cur);
    if constexpr (SP2) {
        PG8_STAGE(PG8_SB(0, 0), cB, voffB); PG8_STAGE(PG8_SB(0, 1), cB + hstep, voffB); PG8_STAGE(PG8_SA(0, 0), cA, voffA); PG8_STAGE(PG8_SA(0, 1), cA + hstep, voffA);
        if (wr == 1) PG8_BAR;
        PG8_WAIT_V(2); PG8_BAR;
        PG8_STAGE(PG8_SB(1, 0), cB + kstep, voffB); PG8_STAGE(PG8_SA(1, 0), cA + kstep, voffA); PG8_STAGE(PG8_SB(1, 1), cB + hstep + kstep, voffB);
        PG8_WAIT_V(6); PG8_BAR;
    } else {
        PG8_STAGE(PG8_SB(0, 0), cB, voffB); PG8_STAGE(PG8_SA(0, 0), cA, voffA); PG8_STAGE(PG8_SB(0, 1), cB + hstep, voffB); PG8_STAGE(PG8_SA(0, 1), cA + hstep, voffA);
        if (wr == 1) PG8_BAR;
        PG8_WAIT_V(4); PG8_BAR;
        PG8_STAGE(PG8_SB(1, 0), cB + kstep, voffB); PG8_STAGE(PG8_SA(1, 0), cA + kstep, voffA); PG8_STAGE(PG8_SB(1, 1), cB + hstep + kstep, voffB);
        PG8_WAIT_V(6); PG8_BAR;
    }
    for (;;) {
        const bool has_next = S.next(ui + 1, nxt);
        const char* nA = has_next ? (const char*)g.A + (size_t)nxt.pm * tstep : cA; const char* nB = has_next ? (const char*)g.Bt + (size_t)nxt.pn * tstep : cB;
        for (int t = 0; t < nt; t += 2) {
            const bool last = (t == nt - 2);
            const char* a1 = cA + (size_t)(t + 1) * kstep;
            const char* a2 = last ? nA : cA + (size_t)(t + 2) * kstep; const char* b2 = last ? nB : cB + (size_t)(t + 2) * kstep;
            const char* a3 = a2 + kstep; const char* b3 = b2 + kstep;
            if (last && has_next) S.a_ready(nxt);
            if constexpr (SP2) {
            PG8_LDB(B0, 0, 0); PG8_LDB(B1, 0, 1); PG8_SCHED; PG8_LDA(At, 0, 0); PG8_STAGE(PG8_SA(1, 1), a1 + hstep, voffA);
            PG8_WAIT_V(8); PG8_WAIT_L(0); PG8_BAR; PG8_MMA(0, 0, At, B0); PG8_MMA(0, 1, At, B1); PG8_BAR; PG8_SCHED;
            PG8_LDA(At, 0, 1); PG8_STAGE(PG8_SB(0, 0), b2, voffB); PG8_STAGE(PG8_SB(0, 1), b2 + hstep, voffB); PG8_STAGE(PG8_SA(0, 0), a2, voffA);
            PG8_WAIT_V(8); PG8_WAIT_L(0); PG8_BAR; PG8_MMA(1, 0, At, B0); PG8_MMA(1, 1, At, B1); PG8_BAR; PG8_SCHED;
            PG8_LDB(B0, 1, 0); PG8_LDB(B1, 1, 1); PG8_SCHED; PG8_LDA(At, 1, 0); PG8_STAGE(PG8_SA(0, 1), a2 + hstep, voffA);
            PG8_WAIT_V(8); PG8_WAIT_L(0); PG8_BAR; PG8_MMA(0, 0, At, B0); PG8_MMA(0, 1, At, B1); PG8_BAR; PG8_SCHED;
            PG8_LDA(At, 1, 1); PG8_STAGE(PG8_SB(1, 0), b3, voffB); PG8_STAGE(PG8_SB(1, 1), b3 + hstep, voffB); PG8_STAGE(PG8_SA(1, 0), a3, voffA);
            PG8_WAIT_V(8); PG8_WAIT_L(0); PG8_BAR; PG8_MMA(1, 0, At, B0); PG8_MMA(1, 1, At, B1); PG8_BAR; PG8_SCHED;
            } else {
            PG8_LDB(B0, 0, 0); PG8_SCHED; PG8_LDA(At, 0, 0); PG8_STAGE(PG8_SA(1, 1), a1 + hstep, voffA);
            PG8_WAIT_L(8); PG8_BAR; PG8_WAIT_L(0); PG8_MMA(0, 0, At, B0); PG8_BAR; PG8_SCHED;
            PG8_LDB(B1, 0, 1); PG8_STAGE(PG8_SB(0, 0), b2, voffB);
            PG8_BAR; PG8_WAIT_L(0); PG8_MMA(0, 1, At, B1); PG8_BAR;
            PG8_LDA(At, 0, 1); PG8_STAGE(PG8_SA(0, 0), a2, voffA);
            PG8_BAR; PG8_WAIT_L(0); PG8_MMA(1, 0, At, B0); PG8_BAR; PG8_SCHED;
            PG8_STAGE(PG8_SB(0, 1), b2 + hstep, voffB);
            PG8_WAIT_V(6); PG8_BAR; PG8_MMA(1, 1, At, B1); PG8_BAR;
            PG8_LDB(B0, 1, 0); PG8_SCHED; PG8_LDA(At, 1, 0); PG8_STAGE(PG8_SA(0, 1), a2 + hstep, voffA);
            PG8_WAIT_L(8); PG8_BAR; PG8_WAIT_L(0); PG8_MMA(0, 0, At, B0); PG8_BAR; PG8_SCHED;
            PG8_LDB(B1, 1, 1); PG8_STAGE(PG8_SB(1, 0), b3, voffB);
            PG8_BAR; PG8_WAIT_L(0); PG8_MMA(0, 1, At, B1); PG8_BAR;
            PG8_LDA(At, 1, 1); PG8_STAGE(PG8_SA(1, 0), a3, voffA);
            PG8_BAR; PG8_WAIT_L(0); PG8_MMA(1, 0, At, B0); PG8_BAR; PG8_SCHED;
            PG8_STAGE(PG8_SB(1, 1), b3 + hstep, voffB);
            PG8_WAIT_V(6); PG8_BAR; PG8_MMA(1, 1, At, B1); PG8_BAR;
            }
        }
        if constexpr (ALIGN_EPI) { if (wr == 0) PG8_BAR; }
        if constexpr (!Epi::AFTER_DRAIN) { E(acc, cur, wr, wc, fr, fq); S.done(cur); }
        if (!has_next) break;
#pragma unroll
        for (int a = 0; a < 2; ++a)
#pragma unroll
            for (int b = 0; b < 2; ++b)
#pragma unroll
                for (int m = 0; m < 4; ++m)
#pragma unroll
                    for (int n = 0; n < 2; ++n) acc[a][b][m][n] = (f32x4){0.f, 0.f, 0.f, 0.f};
        cur = nxt; cA = nA; cB = nB; ++ui;
        if constexpr (ALIGN_EPI) { if (wr == 1) PG8_BAR; }
    }
    PG8_WAIT_V(0);
    if constexpr (!ALIGN_EPI) { if (wr == 0) PG8_BAR; }
    PG8_BAR;
    if constexpr (Epi::AFTER_DRAIN) { E.fused(acc, cur, wr, wc, fr, fq, lds, wid, lane); S.done(cur); }
#undef PG8_SA
#undef PG8_SB
#undef PG8_STAGE
#undef PG8_LDA
#undef PG8_LDB
#undef PG8_MMA
#undef PG8_WAIT_V
#undef PG8_WAIT_L
#undef PG8_BAR
#undef PG8_SCHED
}
}
#define GAS __attribute__((address_space(1)))
#define LAS __attribute__((address_space(3)))
#define DI __device__ __forceinline__
typedef unsigned short bf16;
typedef unsigned v4u __attribute__((ext_vector_type(4)));
typedef unsigned v2u __attribute__((ext_vector_type(2)));
typedef float f32x4 __attribute__((ext_vector_type(4)));
typedef float f32x2 __attribute__((ext_vector_type(2)));
typedef GAS unsigned gu32;
#define LDS_WAIT() asm volatile("s_waitcnt lgkmcnt(0)" ::: "memory")
#define VM_WAIT() asm volatile("s_waitcnt vmcnt(0)" ::: "memory")
DI unsigned f2bf(float f) { unsigned u = __builtin_bit_cast(unsigned, f); return (u + 0x7fffu + ((u >> 16) & 1u)) >> 16; }
DI unsigned pk2(float lo, float hi) { return f2bf(lo) | (f2bf(hi) << 16); }
DI float bflo(unsigned u) { return __builtin_bit_cast(float, u << 16); }
DI float bfhi(unsigned u) { return __builtin_bit_cast(float, u & 0xffff0000u); }
DI float wave_sum(float v) {
#pragma unroll
    for (int o = 1; o < 64; o <<= 1) v += __shfl_xor(v, o);
    return v;
}
DI float wave_max(float v) {
#pragma unroll
    for (int o = 1; o < 64; o <<= 1) v = fmaxf(v, __shfl_xor(v, o));
    return v;
}
#define XB_TMO      128
#define XB_XCNT(j)  (256  + 64 * (j))
#define XB_XSUB(j)  (1280 + 64 * (j))
#define XB_XGEN(j)  (2304 + 64 * (j))
#define XB_TOP      3328
#define XB_TOPGEN   3392
#define XCD_BAR_WORDS 3456
#define XB_SPIN_CAP (1u << 18)

__device__ __forceinline__ unsigned xb_ld(unsigned* p)              { return __hip_atomic_load(p, __ATOMIC_RELAXED, __HIP_MEMORY_SCOPE_AGENT); }
__device__ __forceinline__ unsigned xb_add(unsigned* p, unsigned v) { return __hip_atomic_fetch_add(p, v, __ATOMIC_RELAXED, __HIP_MEMORY_SCOPE_AGENT); }
__device__ __forceinline__ unsigned xb_xcc_id() { return (unsigned)__builtin_amdgcn_s_getreg((3 << 11) | 20) & 0xFu; }
#define XB_SPIN(cond, bar) do { unsigned _sp = 0; while (cond) { __builtin_amdgcn_s_sleep(1); \
    if ((++_sp & 255u) == 0u) { if (xb_ld(&(bar)[XB_TMO])) break; if (_sp > XB_SPIN_CAP) { atomicAdd(&(bar)[XB_TMO], 1u); break; } } } } while (0)

struct XcdBarrier {
    unsigned* bar; unsigned x;
    volatile LAS unsigned* st;
};

__device__ __forceinline__ XcdBarrier xcd_barrier_post(unsigned* bar, volatile LAS unsigned* st) {
    XcdBarrier b; b.bar = bar; b.x = xb_xcc_id(); b.st = st;
    if (threadIdx.x == 0) (void)xb_add(&bar[XB_XCNT(b.x)], 1u);
    return b;
}
__device__ __forceinline__ void xcd_barrier_complete(unsigned* bar, unsigned x, unsigned& nloc, unsigned& nx) {
    const unsigned G = gridDim.x * gridDim.y * gridDim.z;
    unsigned sum, cnt, mine, sp = 0u;
    for (;;) {
        sum = 0u; cnt = 0u; mine = 0u;
#pragma unroll
        for (unsigned j = 0; j < 16; ++j) { const unsigned c = xb_ld(&bar[XB_XCNT(j)]); sum += c; cnt += (c > 0u) ? 1u : 0u; mine = (j == x) ? c : mine; }
        if (sum == G) break;
        __builtin_amdgcn_s_sleep(1);
        if ((++sp & 255u) == 0u) { if (xb_ld(&bar[XB_TMO])) break; if (sp > XB_SPIN_CAP) { atomicAdd(&bar[XB_TMO], 1u); break; } }
    }
    nloc = mine > 0u ? mine : 1u; nx = cnt > 0u ? cnt : 1u;
}

__device__ __forceinline__ void xcd_barrier(const XcdBarrier& b) {
    asm volatile("s_waitcnt vmcnt(0)" ::: "memory");
    __syncthreads();
    if (threadIdx.x == 0) {
        unsigned* bar = b.bar;
        __builtin_amdgcn_s_waitcnt(0);
        unsigned nloc = b.st[0], nx = b.st[1];
        if (nloc == 0u) { xcd_barrier_complete(bar, b.x, nloc, nx); b.st[0] = nloc; b.st[1] = nx; }
        const unsigned old = xb_add(&bar[XB_XSUB(b.x)], 1u);
        const unsigned gen = old / nloc;
        if (old + 1u == (gen + 1u) * nloc) {
            __builtin_amdgcn_fence(__ATOMIC_RELEASE, "agent");
            asm volatile("s_waitcnt vmcnt(0)" ::: "memory");
            const unsigned og = xb_add(&bar[XB_TOP], 1u);
            const unsigned tg = og / nx;
            if (og + 1u == (tg + 1u) * nx) xb_add(&bar[XB_TOPGEN], 1u);
            else XB_SPIN(xb_ld(&bar[XB_TOPGEN]) == tg, bar);
            __builtin_amdgcn_fence(__ATOMIC_ACQUIRE, "agent");
            xb_add(&bar[XB_XGEN(b.x)], 1u);
            asm volatile("s_waitcnt vmcnt(0)" ::: "memory");
        } else {
            XB_SPIN(xb_ld(&bar[XB_XGEN(b.x)]) == gen, bar);
            __builtin_amdgcn_fence(__ATOMIC_ACQUIRE, "agent");
            asm volatile("s_waitcnt vmcnt(0)" ::: "memory");
        }
    }
    __syncthreads();
}
constexpr int BATCH = 8, SEQ = 4096, DM = 1024, T = BATCH * SEQ, HD = 64;
constexpr int NWAVES = 8, NTHR = 512;
constexpr float EPS = 1e-6f, LOG2E = 1.4426950408889634f, QSC = 0.125f * LOG2E;
enum { I_X = 0, I_C, I_FOX_WIN, I_FOX_BF, I_FOX_QG, I_FOX_KG, I_FOX_WOUT, I_NSA_WIN, I_NSA_QG, I_NSA_KG, I_NSA_POS, I_NSA_W1, I_NSA_W2, I_NSA_WOUT,
       I_DIL_WIN, I_DIL_QG, I_DIL_KG, I_DIL_WOUT, I_DIFF_WIN, I_DIFF_QG, I_DIFF_KG, I_DIFF_LAM, I_DIFF_SG, I_DIFF_WOUT,
       I_NORM_GAIN, I_ADA_W, I_ADA_B, I_ROUTER_W, I_ROUTER_B, I_MOE_WG, I_MOE_WU, I_MOE_WD, N_IN };
constexpr size_t MiB = 1u << 20;
constexpr size_t WS_CTL = 0, CTL_ZERO_BYTES = 1 * MiB;
constexpr size_t WS_MODP = 1 * MiB, WS_MOD = 7 * MiB, WS_ROPE = 8 * MiB, WS_FLOG = 9 * MiB, WS_CUM = 11 * MiB, WS_GATE = 13 * MiB, WS_LSE = 19 * MiB, WS_SELM = 21 * MiB;
constexpr size_t WS_KC = 22 * MiB, WS_VC = 22 * MiB + 512 * 1024;
constexpr size_t WS_EIDX = 23 * MiB, WS_WTS = WS_EIDX + 256 * 1024, WS_LRANK = WS_WTS + 256 * 1024, WS_ROWOF = WS_LRANK + 256 * 1024;
constexpr size_t WS_HIST = 24 * MiB, WS_TILEE = WS_HIST + 64 * 1024, WS_NTILES = WS_TILEE + 4096;
constexpr size_t WS_FOXWIN = 32 * MiB, WS_NSAWIN = 39 * MiB, WS_DILWIN = 45 * MiB, WS_DIFFWIN = 63 * MiB, WS_WOUT = 69 * MiB;
constexpr size_t WS_MOEW = 80 * MiB, MOEW_LAYER = 48 * MiB, MOEW_D_OFF = 32 * MiB;
constexpr size_t WS_UO = 272 * MiB, WS_O2 = 336 * MiB, WS_R1 = 400 * MiB, WS_HID = WS_R1 + 136 * MiB, WS_END = 608 * MiB;
constexpr int CW_BAR = 4096;
constexpr int LDS_BYTES = 147456, MISC_OFF = 131072 + 320;
constexpr int FOX_NPAD = 3328, NSA_NPAD = 2816;

struct Args { const float* in[N_IN]; float* out; unsigned char* ws; int ph_lo, ph_hi; };
struct Ctx {
    float* hbuf; unsigned char* ws; LAS unsigned char* lds;
    int tid, lane, wave, G, blk;
};
constexpr int PTR_OFF = 131072 + 1024;
DI const float* inp(const Ctx& C, int i) {
    const unsigned long long v = ((const LAS unsigned long long*)(C.lds + PTR_OFF))[i];
    const unsigned lo = __builtin_amdgcn_readfirstlane((unsigned)v), hi = __builtin_amdgcn_readfirstlane((unsigned)(v >> 32));
    return (const float*)(((unsigned long long)hi << 32) | lo);
}

DI void conv_item(const float* W0, const float* W1, int K, int Nsrc, int ldn, bf16* WT, int mode, int nblk, int item, LAS float* scr, int lane) {
    const int kb = item / nblk, nb = item % nblk, k0 = 64 * kb, n0 = 32 * nb;
    const int n = n0 + (lane & 31);
    const float* src; bool valid;
    if (mode == 0) { valid = n < Nsrc; src = W0 + n; }
    else { const int j = n >> 3, i = n & 7; valid = true; src = ((i < 4) ? W0 : W1) + 4 * j + (i & 3); }
#pragma unroll 8
    for (int i = 0; i < 32; ++i) { const int kk = 2 * i + (lane >> 5); scr[kk * 33 + (lane & 31)] = valid ? src[(size_t)(k0 + kk) * ldn] : 0.f; }
    LDS_WAIT(); asm volatile("" ::: "memory");
    const int c = lane & 7;
#pragma unroll
    for (int j = 0; j < 4; ++j) { const int nn = (lane >> 3) + 8 * j; const LAS float* s = scr + (8 * c) * 33 + nn;
        v4u o; o.x = pk2(s[0 * 33], s[1 * 33]); o.y = pk2(s[2 * 33], s[3 * 33]); o.z = pk2(s[4 * 33], s[5 * 33]); o.w = pk2(s[6 * 33], s[7 * 33]);
        *(v4u*)(WT + (size_t)(n0 + nn) * K + k0 + 8 * c) = o; }
    LDS_WAIT(); asm volatile("" ::: "memory");
}
DI void sincos_d(double x, float& s, float& c) {
    const double k = __builtin_rint(x * 0.6366197723675814);
    double r = __builtin_fma(-k, 1.5707963267948966, x); r = __builtin_fma(-k, 6.123233995736766e-17, r);
    const int q = ((int)k) & 3; const double r2 = r * r;
    double sp = 1.0 / 6227020800.0; sp = sp * r2 - 1.0 / 39916800.0; sp = sp * r2 + 1.0 / 362880.0; sp = sp * r2 - 1.0 / 5040.0; sp = sp * r2 + 1.0 / 120.0; sp = sp * r2 - 1.0 / 6.0; sp = sp * r2 + 1.0; sp *= r;
    double cp = -1.0 / 87178291200.0; cp = cp * r2 + 1.0 / 479001600.0; cp = cp * r2 - 1.0 / 3628800.0; cp = cp * r2 + 1.0 / 40320.0; cp = cp * r2 - 1.0 / 720.0; cp = cp * r2 + 1.0 / 24.0; cp = cp * r2 - 0.5; cp = cp * r2 + 1.0;
    const double ss = (q == 0) ? sp : (q == 1) ? cp : (q == 2) ? -sp : -cp;
    const double cc = (q == 0) ? cp : (q == 1) ? -sp : (q == 2) ? -cp : sp;
    s = (float)ss; c = (float)cc;
}
DI void phase_p0a(Ctx& C) {
    const int gw = C.blk * NWAVES + C.wave, NGW = C.G * NWAVES;
    LAS float* cond = (LAS float*)C.lds;
    for (int i = C.tid; i < BATCH * DM; i += NTHR) { const float v = inp(C, I_C)[i]; cond[i] = v / (1.0f + expf(-v)); }
    __syncthreads();
    float* MODP = (float*)(C.ws + WS_MODP);
    for (int it = gw; it < 4 * 96 * 8; it += NGW) {
        const int l = it / 768, rem = it % 768, cg = rem / 8, kc = rem % 8, col = cg * 64 + C.lane;
        float acc[8];
#pragma unroll
        for (int b = 0; b < 8; ++b) acc[b] = 0.f;
        const float* w = inp(C, I_ADA_W) + ((size_t)l * DM + kc * 128) * 6144 + col;
#pragma unroll 4
        for (int k = 0; k < 128; ++k) { const float wv = w[(size_t)k * 6144];
#pragma unroll
            for (int b = 0; b < 8; ++b) acc[b] += cond[b * DM + kc * 128 + k] * wv; }
#pragma unroll
        for (int b = 0; b < 8; ++b) MODP[(((size_t)kc * 4 + l) * 8 + b) * 6144 + col] = acc[b];
    }
    __syncthreads();
    { f32x2* ROPE = (f32x2*)(C.ws + WS_ROPE);
      for (int i = C.blk * NTHR + C.tid; i < SEQ * 32; i += C.G * NTHR) { const int t = i >> 5, f = i & 31;
          const float inv = exp2f(-(float)f * (13.287712379549449f / 32.0f)); const float ang = (float)t * inv; float s, c; sincos_d((double)ang, s, c); ROPE[i] = (f32x2){c, s}; } }
    LAS float* scr = (LAS float*)(C.lds + C.wave * 16384);
    constexpr int I_FOXIN = 16 * (FOX_NPAD / 32), I_NSAIN = 16 * (NSA_NPAD / 32), I_DILIN = 16 * (9216 / 32), I_DIFFIN = 16 * (3072 / 32), I_WO = 16 * 32, I_GU = 16 * 32, I_D = 8 * 32;
    constexpr int NITEMS = I_FOXIN + I_NSAIN + I_DILIN + I_DIFFIN + 4 * I_WO + 64 * I_GU + 64 * I_D;
    for (int it = gw; it < NITEMS; it += NGW) {
        int r = it;
        if (r < I_FOXIN) { conv_item(inp(C, I_FOX_WIN), nullptr, DM, 3088, 3088, (bf16*)(C.ws + WS_FOXWIN), 0, FOX_NPAD / 32, r, scr, C.lane); continue; } r -= I_FOXIN;
        if (r < I_NSAIN) { conv_item(inp(C, I_NSA_WIN), nullptr, DM, 2608, 2608, (bf16*)(C.ws + WS_NSAWIN), 0, NSA_NPAD / 32, r, scr, C.lane); continue; } r -= I_NSAIN;
        if (r < I_DILIN) { conv_item(inp(C, I_DIL_WIN), nullptr, DM, 9216, 9216, (bf16*)(C.ws + WS_DILWIN), 0, 9216 / 32, r, scr, C.lane); continue; } r -= I_DILIN;
        if (r < I_DIFFIN) { conv_item(inp(C, I_DIFF_WIN), nullptr, DM, 3072, 3072, (bf16*)(C.ws + WS_DIFFWIN), 0, 3072 / 32, r, scr, C.lane); continue; } r -= I_DIFFIN;
        if (r < 4 * I_WO) { const int m = r / I_WO; const float* src = (m == 0) ? inp(C, I_FOX_WOUT) : (m == 1) ? inp(C, I_NSA_WOUT) : (m == 2) ? inp(C, I_DIL_WOUT) : inp(C, I_DIFF_WOUT);
            conv_item(src, nullptr, DM, DM, DM, (bf16*)(C.ws + WS_WOUT + (size_t)m * 2 * MiB), 0, 32, r % I_WO, scr, C.lane); continue; } r -= 4 * I_WO;
        if (r < 64 * I_GU) { const int le = r / I_GU, l = le / 16, e = le % 16;
            conv_item(inp(C, I_MOE_WG) + (size_t)le * DM * 512, inp(C, I_MOE_WU) + (size_t)le * DM * 512, DM, 1024, 512, (bf16*)(C.ws + WS_MOEW + (size_t)l * MOEW_LAYER + (size_t)e * 2 * MiB), 1, 32, r % I_GU, scr, C.lane); continue; } r -= 64 * I_GU;
        { const int le = r / I_D, l = le / 16, e = le % 16;
            conv_item(inp(C, I_MOE_WD) + (size_t)le * 512 * DM, nullptr, 512, DM, DM, (bf16*)(C.ws + WS_MOEW + (size_t)l * MOEW_LAYER + MOEW_D_OFF + (size_t)e * MiB), 0, 32, r % I_D, scr, C.lane); }
    }
}
DI void phase_p0b(Ctx& C) {
    const float* MODP = (const float*)(C.ws + WS_MODP); float* MOD = (float*)(C.ws + WS_MOD);
    for (int i = C.blk * NTHR + C.tid; i < 4 * 8 * 6144; i += C.G * NTHR) { const int l = i / (8 * 6144), col = i % 6144;
        float s = inp(C, I_ADA_B)[l * 6144 + col];
#pragma unroll
        for (int kc = 0; kc < 8; ++kc) s += MODP[(size_t)kc * (4 * 8 * 6144) + i];
        MOD[i] = s; }
}
DI void ld_row_f32(const float* p, int lane, f32x4 (&v)[4]) {
#pragma unroll
    for (int j = 0; j < 4; ++j) v[j] = *(const f32x4*)(p + 4 * lane + 256 * j);
}
DI void st_row_f32(float* p, int lane, const f32x4 (&v)[4]) {
#pragma unroll
    for (int j = 0; j < 4; ++j) *(f32x4*)(p + 4 * lane + 256 * j) = v[j];
}
DI void ld_row_bf16(const bf16* p, int lane, f32x4 (&v)[4]) {
#pragma unroll
    for (int j = 0; j < 4; ++j) { const v2u w = *(const v2u*)(p + 4 * lane + 256 * j); v[j] = (f32x4){bflo(w.x), bfhi(w.x), bflo(w.y), bfhi(w.y)}; }
}
DI void st_row_bf16(bf16* p, int lane, const f32x4 (&v)[4]) {
#pragma unroll
    for (int j = 0; j < 4; ++j) { v2u w; w.x = pk2(v[j].x, v[j].y); w.y = pk2(v[j].z, v[j].w); *(v2u*)(p + 4 * lane + 256 * j) = w; }
}
DI void norm_mod(const f32x4 (&h)[4], const float* gain, const float* sc, const float* sh, int lane, f32x4 (&u)[4]) {
    float ss = 0.f;
#pragma unroll
    for (int j = 0; j < 4; ++j) ss += (h[j].x * h[j].x + h[j].y * h[j].y) + (h[j].z * h[j].z + h[j].w * h[j].w);
    const float r = 1.0f / sqrtf(wave_sum(ss) * (1.0f / DM) + EPS);
#pragma unroll
    for (int j = 0; j < 4; ++j) { const f32x4 g = *(const f32x4*)(gain + 4 * lane + 256 * j), s1 = *(const f32x4*)(sc + 4 * lane + 256 * j), s0 = *(const f32x4*)(sh + 4 * lane + 256 * j);
        u[j] = (h[j] * r) * g * (s1 + 1.0f) + s0; }
}
DI void moe_combine(Ctx& C, int LP, int row, int b, f32x4 (&h)[4]) {
    const int* ROWOF = (const int*)(C.ws + WS_ROWOF); const float* WTS = (const float*)(C.ws + WS_WTS); const bf16* YS = (const bf16*)(C.ws + WS_R1);
    const float* g2 = (const float*)(C.ws + WS_MOD) + ((size_t)(LP * 8 + b) * 6 + 5) * DM;
    const int r0 = ROWOF[2 * row], r1 = ROWOF[2 * row + 1]; const float w0 = WTS[2 * row], w1 = WTS[2 * row + 1];
    f32x4 y0[4], y1[4]; ld_row_bf16(YS + (size_t)r0 * DM, C.lane, y0); ld_row_bf16(YS + (size_t)r1 * DM, C.lane, y1);
#pragma unroll
    for (int j = 0; j < 4; ++j) { const f32x4 g = *(const f32x4*)(g2 + 4 * C.lane + 256 * j); h[j] += g * (y0[j] * w0 + y1[j] * w1); }
}
template <int L> DI void phase_n1(Ctx& C) {
    const int RPB = T / C.G, RPW = RPB / NWAVES;
    const float* MOD = (const float*)(C.ws + WS_MOD); bf16* U = (bf16*)(C.ws + WS_UO);
    for (int i = 0; i < RPW; ++i) {
        const int row = C.blk * RPB + C.wave * RPW + i, b = row / SEQ;
        f32x4 h[4], u[4];
        if (L == 0) ld_row_f32(inp(C, I_X) + (size_t)row * DM, C.lane, h);
        else { ld_row_f32(C.hbuf + (size_t)row * DM, C.lane, h); moe_combine(C, L - 1, row, b, h); }
        st_row_f32(C.hbuf + (size_t)row * DM, C.lane, h);
        norm_mod(h, inp(C, I_NORM_GAIN) + (L * 2 + 0) * DM, MOD + ((size_t)(L * 8 + b) * 6 + 1) * DM, MOD + ((size_t)(L * 8 + b) * 6 + 0) * DM, C.lane, u);
        st_row_bf16(U + (size_t)row * DM, C.lane, u);
    }
}
DI void phase_final(Ctx& C) {
    const int RPB = T / C.G, RPW = RPB / NWAVES;
    for (int i = 0; i < RPW; ++i) {
        const int row = C.blk * RPB + C.wave * RPW + i, b = row / SEQ;
        f32x4 h[4]; ld_row_f32(C.hbuf + (size_t)row * DM, C.lane, h); moe_combine(C, 3, row, b, h); st_row_f32(C.hbuf + (size_t)row * DM, C.lane, h);
    }
}
template <int L> DI void phase_n2(Ctx& C, const bf16* Y) {
    const int RPB = T / C.G, RPW = RPB / NWAVES;
    const float* MOD = (const float*)(C.ws + WS_MOD); bf16* U = (bf16*)(C.ws + WS_UO);
    LAS float* wT = (LAS float*)C.lds; LAS int* hist = (LAS int*)(C.lds + 65536);
    for (int idx = C.tid; idx < DM * 16; idx += NTHR) wT[(idx & 15) * DM + (idx >> 4)] = inp(C, I_ROUTER_W)[idx];
    if (C.tid < 16) hist[C.tid] = 0;
    __syncthreads();
    int* EIDX = (int*)(C.ws + WS_EIDX); float* WTS = (float*)(C.ws + WS_WTS); int* LRANK = (int*)(C.ws + WS_LRANK);
    for (int i = 0; i < RPW; ++i) {
        const int row = C.blk * RPB + C.wave * RPW + i, b = row / SEQ;
        f32x4 h[4], y[4], u[4]; ld_row_f32(C.hbuf + (size_t)row * DM, C.lane, h); ld_row_bf16(Y + (size_t)row * DM, C.lane, y);
        const float* g1 = MOD + ((size_t)(L * 8 + b) * 6 + 2) * DM;
#pragma unroll
        for (int j = 0; j < 4; ++j) h[j] += *(const f32x4*)(g1 + 4 * C.lane + 256 * j) * y[j];
        st_row_f32(C.hbuf + (size_t)row * DM, C.lane, h);
        norm_mod(h, inp(C, I_NORM_GAIN) + (L * 2 + 1) * DM, MOD + ((size_t)(L * 8 + b) * 6 + 4) * DM, MOD + ((size_t)(L * 8 + b) * 6 + 3) * DM, C.lane, u);
        st_row_bf16(U + (size_t)row * DM, C.lane, u);
        float sc[16], sel[16];
#pragma unroll
        for (int e = 0; e < 16; ++e) { float a = 0.f;
#pragma unroll
            for (int j = 0; j < 4; ++j) { const f32x4 w = *(const LAS f32x4*)(wT + e * DM + 256 * j + 4 * C.lane); a += (u[j].x * w.x + u[j].y * w.y) + (u[j].z * w.z + u[j].w * w.w); }
            a = wave_sum(a); sc[e] = 1.0f / (1.0f + expf(-a)); sel[e] = sc[e] + inp(C, I_ROUTER_B)[e]; }
        float bs = -INFINITY, bw0 = 0.f, bw1 = 0.f; int be0 = 0, be1 = 1;
#pragma unroll
        for (int g = 0; g < 4; ++g) {
            const float a0 = sel[4 * g], a1 = sel[4 * g + 1], a2 = sel[4 * g + 2], a3 = sel[4 * g + 3];
            const float c0 = sc[4 * g], c1 = sc[4 * g + 1], c2 = sc[4 * g + 2], c3 = sc[4 * g + 3];
            int i1 = 0; float v1 = a0, s1 = c0;
            if (a1 > v1) { v1 = a1; s1 = c1; i1 = 1; } if (a2 > v1) { v1 = a2; s1 = c2; i1 = 2; } if (a3 > v1) { v1 = a3; s1 = c3; i1 = 3; }
            int i2 = -1; float v2 = -INFINITY, s2 = 0.f;
            if (i1 != 0 && a0 > v2) { v2 = a0; s2 = c0; i2 = 0; } if (i1 != 1 && a1 > v2) { v2 = a1; s2 = c1; i2 = 1; }
            if (i1 != 2 && a2 > v2) { v2 = a2; s2 = c2; i2 = 2; } if (i1 != 3 && a3 > v2) { v2 = a3; s2 = c3; i2 = 3; }
            const float gs = v1 + v2;
            if (gs > bs) { bs = gs; be0 = 4 * g + i1; be1 = 4 * g + i2; bw0 = s1; bw1 = s2; }
        }
        if (C.lane == 0) {
            const float inv = 1.0f / (bw0 + bw1);
            EIDX[2 * row] = be0; EIDX[2 * row + 1] = be1; WTS[2 * row] = bw0 * inv; WTS[2 * row + 1] = bw1 * inv;
            LRANK[2 * row] = __hip_atomic_fetch_add(hist + be0, 1, __ATOMIC_RELAXED, __HIP_MEMORY_SCOPE_WORKGROUP);
            LRANK[2 * row + 1] = __hip_atomic_fetch_add(hist + be1, 1, __ATOMIC_RELAXED, __HIP_MEMORY_SCOPE_WORKGROUP);
        }
    }
    __syncthreads();
    if (C.tid < 16) ((int*)(C.ws + WS_HIST))[C.blk * 16 + C.tid] = hist[C.tid];
    __syncthreads();
}
DI void phase_s(Ctx& C) {
    const int RPB = T / C.G, RPW = RPB / NWAVES;
    LAS int* tot = (LAS int*)C.lds; LAS int* before = tot + 16; LAS int* base = tot + 32;
    if (C.tid < 48) tot[C.tid] = 0;
    __syncthreads();
    const int* HIST = (const int*)(C.ws + WS_HIST);
    for (int idx = C.tid; idx < C.G * 16; idx += NTHR) { const int bb = idx >> 4, e = idx & 15; const int c = HIST[idx];
        __hip_atomic_fetch_add(tot + e, c, __ATOMIC_RELAXED, __HIP_MEMORY_SCOPE_WORKGROUP);
        if (bb < C.blk) __hip_atomic_fetch_add(before + e, c, __ATOMIC_RELAXED, __HIP_MEMORY_SCOPE_WORKGROUP); }
    __syncthreads();
    if (C.tid == 0) { int ps = 0; int* TILEE = (int*)(C.ws + WS_TILEE);
        for (int e = 0; e < 16; ++e) { base[e] = ps + before[e]; const int pe = (tot[e] + 255) & ~255;
            if (C.blk == 0) for (int tl = ps >> 8; tl < ((ps + pe) >> 8); ++tl) TILEE[tl] = e;
            ps += pe; }
        if (C.blk == 0) *(int*)(C.ws + WS_NTILES) = ps >> 8; }
    __syncthreads();
    const int* EIDX = (const int*)(C.ws + WS_EIDX); const int* LRANK = (const int*)(C.ws + WS_LRANK); int* ROWOF = (int*)(C.ws + WS_ROWOF);
    const bf16* U = (const bf16*)(C.ws + WS_UO); bf16* XS = (bf16*)(C.ws + WS_R1);
    for (int i = 0; i < RPW; ++i) {
        const int row = C.blk * RPB + C.wave * RPW + i;
        const int d0 = base[EIDX[2 * row]] + LRANK[2 * row], d1 = base[EIDX[2 * row + 1]] + LRANK[2 * row + 1];
        if (C.lane == 0) { ROWOF[2 * row] = d0; ROWOF[2 * row + 1] = d1; }
        const v4u a = *(const v4u*)(U + (size_t)row * DM + 8 * C.lane), bq = *(const v4u*)(U + (size_t)row * DM + 512 + 8 * C.lane);
        *(v4u*)(XS + (size_t)d0 * DM + 8 * C.lane) = a; *(v4u*)(XS + (size_t)d0 * DM + 512 + 8 * C.lane) = bq;
        *(v4u*)(XS + (size_t)d1 * DM + 8 * C.lane) = a; *(v4u*)(XS + (size_t)d1 * DM + 512 + 8 * C.lane) = bq;
    }
    __syncthreads();
}
DI void gemm_qkv(Ctx& C, const bf16* A, const bf16* Bt, int Npad, bf16* O, int ldc, int n_main, float* tail, int tail_n) {
    pg8::Gemm g{A, Bt, T, Npad, DM}; pg8::StaticOrder S; S.init(T, Npad, C.G, C.blk);
    pg8::EpiStore E{O, ldc, 1 << 20, n_main, tail, tail_n};
    pg8::gemm_phase<pg8::EpiStore, pg8::StaticOrder, true, true>(C.lds, g, S, E);
}
DI void gemm_moe1(Ctx& C, int L) {
    const int ntiles = *(const int*)(C.ws + WS_NTILES);
    pg8::Gemm g{(const bf16*)(C.ws + WS_R1), (const bf16*)(C.ws + WS_MOEW + (size_t)L * MOEW_LAYER), ntiles * 256, 16 * 1024, DM};
    pg8::MoeOrder S{(const int*)(C.ws + WS_TILEE), ntiles, 4, C.G, C.blk};
    pg8::EpiSwiGLU E{(bf16*)(C.ws + WS_HID), 4};
    pg8::gemm_phase<pg8::EpiSwiGLU, pg8::MoeOrder, true, true>(C.lds, g, S, E);
}
DI void gemm_moe2(Ctx& C, int L) {
    const int ntiles = *(const int*)(C.ws + WS_NTILES);
    pg8::Gemm g{(const bf16*)(C.ws + WS_HID), (const bf16*)(C.ws + WS_MOEW + (size_t)L * MOEW_LAYER + MOEW_D_OFF), ntiles * 256, 16 * 1024, 512};
    pg8::MoeOrder S{(const int*)(C.ws + WS_TILEE), ntiles, 4, C.G, C.blk};
    pg8::EpiStore E{(bf16*)(C.ws + WS_R1), DM, 4, DM, nullptr, 0};
    pg8::gemm_phase<pg8::EpiStore, pg8::MoeOrder, true, true>(C.lds, g, S, E);
}
struct PrepSeg { int col0, nvec; const float* gain; int rope; float scale; };
template <int NSEG> DI void prep_rows(Ctx& C, bf16* QKV, int ldq, const PrepSeg (&segs)[NSEG]) {
    const int gw = C.blk * NWAVES + C.wave, NGW = C.G * NWAVES, sub = C.lane & 7;
    const f32x2* ROPE = (const f32x2*)(C.ws + WS_ROPE);
    for (int row = gw; row < T; row += NGW) {
        const int t = row % SEQ;
#pragma unroll
        for (int sg = 0; sg < NSEG; ++sg) {
            for (int v0 = 0; v0 < segs[sg].nvec; v0 += 8) {
                const int vec = v0 + (C.lane >> 3); const bool act = vec < segs[sg].nvec; const int vv = act ? vec : 0;
                bf16* p = QKV + (size_t)row * ldq + segs[sg].col0 + vv * 64 + sub * 8;
                const v4u w = *(const v4u*)p;
                float x[8] = {bflo(w.x), bfhi(w.x), bflo(w.y), bfhi(w.y), bflo(w.z), bfhi(w.z), bflo(w.w), bfhi(w.w)};
                float ss = 0.f;
#pragma unroll
                for (int e = 0; e < 8; ++e) ss += x[e] * x[e];
                ss += __shfl_xor(ss, 1); ss += __shfl_xor(ss, 2); ss += __shfl_xor(ss, 4);
                const float r = 1.0f / sqrtf(ss * (1.0f / 64.0f) + EPS);
                const f32x4 g0 = *(const f32x4*)(segs[sg].gain + sub * 8), g1 = *(const f32x4*)(segs[sg].gain + sub * 8 + 4);
                const float gg[8] = {g0.x, g0.y, g0.z, g0.w, g1.x, g1.y, g1.z, g1.w};
#pragma unroll
                for (int e = 0; e < 8; ++e) x[e] = x[e] * r * gg[e];
                if (segs[sg].rope) {
#pragma unroll
                    for (int e = 0; e < 8; ++e) { const float pr = __shfl_xor(x[e], 4); const f32x2 cs = ROPE[t * 32 + (sub & 3) * 8 + e];
                        x[e] = (sub < 4) ? (x[e] * cs.x - pr * cs.y) : (pr * cs.y + x[e] * cs.x); }
                }
                const float sc = segs[sg].scale;
                v4u o; o.x = pk2(x[0] * sc, x[1] * sc); o.y = pk2(x[2] * sc, x[3] * sc); o.z = pk2(x[4] * sc, x[5] * sc); o.w = pk2(x[6] * sc, x[7] * sc);
                if (act) *(v4u*)p = o;
            }
        }
    }
}
DI float log_sigmoid(float x) { return (x < 0.f) ? (x - log1pf(expf(x))) : (-log1pf(expf(-x))); }
DI void fox_scan(Ctx& C) {
    const int gw = C.blk * NWAVES + C.wave, NGW = C.G * NWAVES;
    const float* FLOG = (const float*)(C.ws + WS_FLOG); float* CUM = (float*)(C.ws + WS_CUM);
    for (int task = gw; task < BATCH * 16; task += NGW) {
        const int b = task / 16, h = task % 16; const float bf = inp(C, I_FOX_BF)[h];
        const float* src = FLOG + ((size_t)b * SEQ + 64 * C.lane) * 16 + h;
        float run = 0.f;
        for (int i = 0; i < 64; ++i) run += log_sigmoid(src[(size_t)i * 16] + bf);
        float inc = run;
#pragma unroll
        for (int o = 1; o < 64; o <<= 1) { const float v = __shfl_up(inc, o); if (C.lane >= o) inc += v; }
        float acc = inc - run;
        float* dst = CUM + ((size_t)b * 16 + h) * SEQ + 64 * C.lane;
        for (int i = 0; i < 64; ++i) { acc += log_sigmoid(src[(size_t)i * 16] + bf); dst[i] = acc * LOG2E; }
    }
}
template <class AllowF, class BiasF>
DI void nattn(const bf16* qptr, const bf16* kbase, size_t kstride, const bf16* vbase, size_t vstride, int klo, int khi, AllowF allow, BiasF bias, float (&o)[64], float& m, float& l) {
    unsigned q[32];
#pragma unroll
    for (int c = 0; c < 8; ++c) { const v4u w = *(const v4u*)(qptr + 8 * c); q[4 * c] = w.x; q[4 * c + 1] = w.y; q[4 * c + 2] = w.z; q[4 * c + 3] = w.w; }
    m = -1e30f; l = 0.f;
#pragma unroll
    for (int d = 0; d < 64; ++d) o[d] = 0.f;
    for (int kk = klo; kk < khi; ++kk) {
        const bool ok = allow(kk);
        if (!__any(ok)) continue;
        const v4u* kp = (const v4u*)(kbase + (size_t)kk * kstride);
        float s = 0.f;
#pragma unroll
        for (int c = 0; c < 8; ++c) { const v4u w = kp[c];
            s += bflo(q[4 * c]) * bflo(w.x) + bfhi(q[4 * c]) * bfhi(w.x) + bflo(q[4 * c + 1]) * bflo(w.y) + bfhi(q[4 * c + 1]) * bfhi(w.y) + bflo(q[4 * c + 2]) * bflo(w.z) + bfhi(q[4 * c + 2]) * bfhi(w.z) + bflo(q[4 * c + 3]) * bflo(w.w) + bfhi(q[4 * c + 3]) * bfhi(w.w); }
        s += bias(kk);
        if (ok) {
            const float mn = fmaxf(m, s), a = exp2f(m - mn), p = exp2f(s - mn);
            l = l * a + p; m = mn;
            const v4u* vp = (const v4u*)(vbase + (size_t)kk * vstride);
#pragma unroll
            for (int c = 0; c < 8; ++c) { const v4u w = vp[c];
                o[8 * c] = o[8 * c] * a + p * bflo(w.x); o[8 * c + 1] = o[8 * c + 1] * a + p * bfhi(w.x); o[8 * c + 2] = o[8 * c + 2] * a + p * bflo(w.y); o[8 * c + 3] = o[8 * c + 3] * a + p * bfhi(w.y);
                o[8 * c + 4] = o[8 * c + 4] * a + p * bflo(w.z); o[8 * c + 5] = o[8 * c + 5] * a + p * bfhi(w.z); o[8 * c + 6] = o[8 * c + 6] * a + p * bflo(w.w); o[8 * c + 7] = o[8 * c + 7] * a + p * bfhi(w.w); }
        }
    }
}
DI void st_o64(bf16* p, const float (&o)[64], float sc) {
#pragma unroll
    for (int c = 0; c < 8; ++c) { v4u w; w.x = pk2(o[8 * c] * sc, o[8 * c + 1] * sc); w.y = pk2(o[8 * c + 2] * sc, o[8 * c + 3] * sc); w.z = pk2(o[8 * c + 4] * sc, o[8 * c + 5] * sc); w.w = pk2(o[8 * c + 6] * sc, o[8 * c + 7] * sc); *(v4u*)(p + 8 * c) = w; }
}
DI void attn_fox_naive(Ctx& C) {
    const int gw = C.blk * NWAVES + C.wave, NGW = C.G * NWAVES;
    const bf16* QKV = (const bf16*)(C.ws + WS_R1); bf16* O = (bf16*)(C.ws + WS_UO); const float* CUM = (const float*)(C.ws + WS_CUM);
    for (int task = gw; task < BATCH * 16 * 64; task += NGW) {
        const int chunk = task / 128, bh = task % 128, b = bh / 16, h = bh % 16, t = chunk * 64 + C.lane; const size_t row = (size_t)b * SEQ + t;
        const float* cum = CUM + (size_t)bh * SEQ; const float cq = cum[t];
        float o[64], m, l;
        nattn(QKV + row * 3072 + h * 64, QKV + (size_t)b * SEQ * 3072 + 1024 + h * 64, 3072, QKV + (size_t)b * SEQ * 3072 + 2048 + h * 64, 3072, 0, chunk * 64 + 64,
              [&](int kk) { return kk <= t; }, [&](int kk) { return cq - cum[kk]; }, o, m, l);
        st_o64(O + row * DM + h * 64, o, 1.0f / l);
    }
}
DI void attn_diff_naive(Ctx& C) {
    const int gw = C.blk * NWAVES + C.wave, NGW = C.G * NWAVES;
    const bf16* QKV = (const bf16*)(C.ws + WS_R1);
    for (int task = gw; task < BATCH * 16 * 64 * 2; task += NGW) {
        const int half = task & 1, t2 = task >> 1, chunk = t2 / 128, bh = t2 % 128, b = bh / 16, hh = bh % 16, t = chunk * 64 + C.lane; const size_t row = (size_t)b * SEQ + t;
        bf16* O = (bf16*)(C.ws + ((hh & 1) ? WS_O2 : WS_UO));
        float o[64], m, l;
        nattn(QKV + row * 3072 + hh * 64, QKV + (size_t)b * SEQ * 3072 + 1024 + hh * 64, 3072, QKV + (size_t)b * SEQ * 3072 + 2048 + (hh >> 1) * 128 + half * 64, 3072, 0, chunk * 64 + 64,
              [&](int kk) { return kk <= t; }, [&](int) { return 0.f; }, o, m, l);
        st_o64(O + row * DM + (hh >> 1) * 128 + half * 64, o, 1.0f / l);
    }
}
DI void diff_combine(Ctx& C) {
    const int gw = C.blk * NWAVES + C.wave, NGW = C.G * NWAVES;
    const float lam_init = 0.8f - 0.6f * expf(-0.3f * 3.0f);
    const float* lm = inp(C, I_DIFF_LAM);
    const float s01 = wave_sum(lm[C.lane] * lm[64 + C.lane]), s23 = wave_sum(lm[128 + C.lane] * lm[192 + C.lane]);
    const float lam = expf(s01) - expf(s23) + lam_init;
    bf16* O0 = (bf16*)(C.ws + WS_UO); const bf16* O1 = (const bf16*)(C.ws + WS_O2);
    for (int row = gw; row < T; row += NGW) {
        f32x4 a[4], bq[4]; ld_row_bf16(O0 + (size_t)row * DM, C.lane, a); ld_row_bf16(O1 + (size_t)row * DM, C.lane, bq);
#pragma unroll
        for (int j = 0; j < 4; ++j) { f32x4 d = a[j] - bq[j] * lam; float ss = (d.x * d.x + d.y * d.y) + (d.z * d.z + d.w * d.w);
            ss += __shfl_xor(ss, 1); ss += __shfl_xor(ss, 2); ss += __shfl_xor(ss, 4); ss += __shfl_xor(ss, 8); ss += __shfl_xor(ss, 16);
            const float r = (1.0f - lam_init) / sqrtf(ss * (1.0f / 128.0f) + EPS);
            const f32x4 g = *(const f32x4*)(inp(C, I_DIFF_SG) + ((4 * C.lane) & 127)); a[j] = d * r * g; }
        st_row_bf16(O0 + (size_t)row * DM, C.lane, a);
    }
}
DI void attn_dil_naive(Ctx& C, int gi, int dil) {
    const int gw = C.blk * NWAVES + C.wave, NGW = C.G * NWAVES;
    const bf16* QKV = (const bf16*)(C.ws + WS_R1); bf16* O = (bf16*)(C.ws + WS_O2); float* LSE = (float*)(C.ws + WS_LSE);
    const int sublen = SEQ / dil, nchunk = sublen / 64;
    for (int task = gw; task < BATCH * 16 * 64; task += NGW) {
        const int bh = task % 128, w = task / 128, b = bh / 16, h = bh % 16, r = w / nchunk, chunk = w % nchunk, u = chunk * 64 + C.lane;
        const size_t row = (size_t)b * SEQ + (size_t)u * dil + r; const size_t row0 = (size_t)b * SEQ + r;
        float o[64], m, l;
        const int klo = (chunk * 64 - 128) > 0 ? (chunk * 64 - 128) : 0;
        nattn(QKV + row * 3072 + h * 64, QKV + row0 * 3072 + 1024 + h * 64, (size_t)dil * 3072, QKV + row0 * 3072 + 2048 + h * 64, (size_t)dil * 3072, klo, chunk * 64 + 64,
              [&](int kk) { return kk <= u && u - kk <= 128; }, [&](int) { return 0.f; }, o, m, l);
        const float inv = 1.0f / l; float lse = m + log2f(l);
        bf16* op = O + row * DM + h * 64;
        if (gi == 0) { st_o64(op, o, inv); LSE[row * 16 + h] = lse; }
        else {
            const float lo = LSE[row * 16 + h], mx = fmaxf(lo, lse), ea = exp2f(lo - mx), eb = exp2f(lse - mx), rs = 1.0f / (ea + eb), fa = ea * rs, fb = eb * rs * inv;
#pragma unroll
            for (int c = 0; c < 8; ++c) { const v4u w = *(const v4u*)(op + 8 * c);
                o[8 * c] = bflo(w.x) * fa + o[8 * c] * fb; o[8 * c + 1] = bfhi(w.x) * fa + o[8 * c + 1] * fb; o[8 * c + 2] = bflo(w.y) * fa + o[8 * c + 2] * fb; o[8 * c + 3] = bfhi(w.y) * fa + o[8 * c + 3] * fb;
                o[8 * c + 4] = bflo(w.z) * fa + o[8 * c + 4] * fb; o[8 * c + 5] = bfhi(w.z) * fa + o[8 * c + 5] * fb; o[8 * c + 6] = bflo(w.w) * fa + o[8 * c + 6] * fb; o[8 * c + 7] = bfhi(w.w) * fa + o[8 * c + 7] * fb; }
            st_o64(op, o, 1.0f); LSE[row * 16 + h] = mx + log2f(ea + eb);
        }
    }
}
constexpr int NSA_LDQ = 2560;
DI void nsa_compress(Ctx& C) {
    const bf16* QKV = (const bf16*)(C.ws + WS_R1); const f32x2* ROPE = (const f32x2*)(C.ws + WS_ROPE);
    LAS float* vec = (LAS float*)C.lds;
    LAS float* part = (LAS float*)(C.lds + 65536);
    LAS float* hid = (LAS float*)(C.lds + 65536 + 8192);
    float* KC = (float*)(C.ws + WS_KC); float* VC = (float*)(C.ws + WS_VC);
    for (int task = C.blk; task < 1024; task += C.G) {
        const int which = task / 512, r = task % 512, b = r / 64, g = (r / 16) % 4, n0 = (r % 16) * 4;
        const int col = (which == 0 ? 1024 : 1280) + g * 64;
        const float* pos = inp(C, I_NSA_POS) + which * 4096;
        for (int idx = C.tid; idx < 16384; idx += NTHR) { const int tsk = idx >> 12, rem = idx & 4095, l = rem >> 6, d = rem & 63;
            const unsigned short raw = QKV[((size_t)b * SEQ + (n0 + tsk) * 64 + l) * NSA_LDQ + col + d];
            vec[idx] = __builtin_bit_cast(float, (unsigned)raw << 16) + pos[rem]; }
        __syncthreads();
        { const int j = C.tid & 127, pt = C.tid >> 7; float a0 = 0.f, a1 = 0.f, a2 = 0.f, a3 = 0.f;
          const float* w1 = inp(C, I_NSA_W1) + ((size_t)which * 4096 + pt * 1024) * 128 + j; const LAS float* vv = vec + pt * 1024;
#pragma unroll 8
          for (int k = 0; k < 1024; ++k) { const float w = w1[(size_t)k * 128]; a0 += vv[k] * w; a1 += vv[4096 + k] * w; a2 += vv[8192 + k] * w; a3 += vv[12288 + k] * w; }
          part[(pt * 4 + 0) * 128 + j] = a0; part[(pt * 4 + 1) * 128 + j] = a1; part[(pt * 4 + 2) * 128 + j] = a2; part[(pt * 4 + 3) * 128 + j] = a3; }
        __syncthreads();
        { const int tsk = C.tid >> 7, j = C.tid & 127; const float s = (part[(0 * 4 + tsk) * 128 + j] + part[(1 * 4 + tsk) * 128 + j]) + (part[(2 * 4 + tsk) * 128 + j] + part[(3 * 4 + tsk) * 128 + j]);
          hid[tsk * 128 + j] = s / (1.0f + expf(-s)); }
        __syncthreads();
        if (C.tid < 256) { const int tsk = C.tid >> 6, d = C.tid & 63; float o = 0.f;
            const float* w2 = inp(C, I_NSA_W2) + (size_t)which * 128 * 64 + d;
#pragma unroll 8
            for (int j = 0; j < 128; ++j) o += hid[tsk * 128 + j] * w2[j * 64];
            const size_t oi = (((size_t)b * 4 + g) * 64 + n0 + tsk) * 64 + d;
            if (which == 1) VC[oi] = o;
            else { const float ss = wave_sum(o * o); float y = o / sqrtf(ss * (1.0f / 64.0f) + EPS) * inp(C, I_NSA_KG)[d];
                const float pr = __shfl_xor(y, 32); const f32x2 cs = ROPE[((n0 + tsk) * 64 + 63) * 32 + (d & 31)];
                KC[oi] = (d < 32) ? (y * cs.x - pr * cs.y) : (pr * cs.y + y * cs.x); } }
        __syncthreads();
    }
}
DI float rdl(float v, int l) { return __builtin_bit_cast(float, __builtin_amdgcn_readlane(__builtin_bit_cast(int, v), l)); }
DI void nsa_cmp_select(Ctx& C) {
    const bf16* QKV = (const bf16*)(C.ws + WS_R1); bf16* OC = (bf16*)(C.ws + WS_O2); const float* GATE = (const float*)(C.ws + WS_GATE);
    const float* KC = (const float*)(C.ws + WS_KC); const float* VC = (const float*)(C.ws + WS_VC); unsigned long long* SELM = (unsigned long long*)(C.ws + WS_SELM);
    LAS float* kcT = (LAS float*)C.lds;
    LAS float* vcl = (LAS float*)(C.lds + 16384);
    for (int task = C.blk; task < BATCH * 4 * 8; task += C.G) {
        const int b = task / 32, g = (task / 8) % 4, cur = (task % 8) * 8 + C.wave;
        __syncthreads();
        for (int idx = C.tid; idx < 4096; idx += NTHR) { const int j = idx >> 6, d = idx & 63; kcT[d * 64 + j] = KC[((size_t)b * 4 + g) * 4096 + idx]; vcl[idx] = VC[((size_t)b * 4 + g) * 4096 + idx]; }
        __syncthreads();
        for (int tt = 0; tt < 64; ++tt) {
            const int t = cur * 64 + tt; const size_t row = (size_t)b * SEQ + t; const int nvalid = cur + (tt == 63 ? 1 : 0);
            const bool valid = C.lane < nvalid;
            float imp = 0.f;
#pragma unroll 1
            for (int p = 0; p < 4; ++p) {
                const int head = g * 4 + p;
                const float qv = __builtin_bit_cast(float, (unsigned)QKV[row * NSA_LDQ + head * 64 + C.lane] << 16);
                float s = 0.f;
#pragma unroll 8
                for (int d = 0; d < 64; ++d) s += rdl(qv, d) * kcT[d * 64 + C.lane];
                const float mx = wave_max(valid ? s : -1e30f); const float e = valid ? exp2f(s - mx) : 0.f;
                const float den = fmaxf(wave_sum(e), 1e-30f); const float pj = e / den;
                imp += pj;
                float o = 0.f;
#pragma unroll 8
                for (int j = 0; j < 64; ++j) o += rdl(pj, j) * vcl[j * 64 + C.lane];
                const float g0 = 1.0f / (1.0f + expf(-GATE[row * 48 + head]));
                OC[row * DM + head * 64 + C.lane] = (bf16)f2bf(g0 * o);
            }
            const float v = (C.lane > cur) ? -1.0f : ((C.lane == 0 || C.lane == cur || C.lane == cur - 1) ? 5.0f : imp);
            int rank = 0;
#pragma unroll 8
            for (int j = 0; j < 64; ++j) { const float vj = rdl(v, j); rank += (vj > v || (vj == v && j < C.lane)) ? 1 : 0; }
            unsigned long long mask = __ballot(rank < 16);
            if (cur < 63) mask &= ((2ull << cur) - 1ull);
            if (C.lane == 0) SELM[((size_t)b * 4 + g) * SEQ + t] = mask;
        }
    }
    __syncthreads();
}
DI void attn_nsa_naive(Ctx& C) {
    const int gw = C.blk * NWAVES + C.wave, NGW = C.G * NWAVES;
    const bf16* QKV = (const bf16*)(C.ws + WS_R1); bf16* O = (bf16*)(C.ws + WS_UO); const bf16* OC = (const bf16*)(C.ws + WS_O2); const float* GATE = (const float*)(C.ws + WS_GATE);
    const unsigned long long* SELM = (const unsigned long long*)(C.ws + WS_SELM);
    for (int task = gw; task < BATCH * 16 * 64; task += NGW) {
        const int chunk = task / 128, bh = task % 128, b = bh / 16, head = bh % 16, g = head >> 2, t = chunk * 64 + C.lane; const size_t row = (size_t)b * SEQ + t;
        const size_t kb = (size_t)b * SEQ * NSA_LDQ;
        const unsigned long long mask = SELM[((size_t)b * 4 + g) * SEQ + t];
        float o[64], m, l;
        nattn(QKV + row * NSA_LDQ + head * 64, QKV + kb + 1536 + g * 64, NSA_LDQ, QKV + kb + 1792 + g * 64, NSA_LDQ, 0, chunk * 64 + 64,
              [&](int kk) { return ((mask >> (kk >> 6)) & 1ull) != 0ull && kk <= t; }, [&](int) { return 0.f; }, o, m, l);
        { const float g1 = 1.0f / (1.0f + expf(-GATE[row * 48 + 16 + head])) / l; const bf16* ocp = OC + row * DM + head * 64; bf16* op = O + row * DM + head * 64;
#pragma unroll
          for (int c = 0; c < 8; ++c) { const v4u w = *(const v4u*)(ocp + 8 * c); v4u r;
              r.x = pk2(bflo(w.x) + g1 * o[8 * c], bfhi(w.x) + g1 * o[8 * c + 1]); r.y = pk2(bflo(w.y) + g1 * o[8 * c + 2], bfhi(w.y) + g1 * o[8 * c + 3]);
              r.z = pk2(bflo(w.z) + g1 * o[8 * c + 4], bfhi(w.z) + g1 * o[8 * c + 5]); r.w = pk2(bflo(w.w) + g1 * o[8 * c + 6], bfhi(w.w) + g1 * o[8 * c + 7]); *(v4u*)(op + 8 * c) = r; } }
    }
    asm volatile("s_waitcnt vmcnt(0)" ::: "memory");
    for (int task = gw; task < BATCH * 16 * 64; task += NGW) {
        const int chunk = task / 128, bh = task % 128, b = bh / 16, head = bh % 16, g = head >> 2, t = chunk * 64 + C.lane; const size_t row = (size_t)b * SEQ + t;
        const size_t kb = (size_t)b * SEQ * NSA_LDQ;
        float o[64], m, l;
        const int klo = (chunk * 64 - 511) > 0 ? (chunk * 64 - 511) : 0;
        nattn(QKV + row * NSA_LDQ + head * 64, QKV + kb + 2048 + g * 64, NSA_LDQ, QKV + kb + 2304 + g * 64, NSA_LDQ, klo, chunk * 64 + 64,
              [&](int kk) { return kk <= t && t - kk < 512; }, [&](int) { return 0.f; }, o, m, l);
        { const float g2 = 1.0f / (1.0f + expf(-GATE[row * 48 + 32 + head])) / l; bf16* op = O + row * DM + head * 64;
#pragma unroll
          for (int c = 0; c < 8; ++c) { const v4u p = *(const v4u*)(op + 8 * c); v4u w;
              w.x = pk2(bflo(p.x) + g2 * o[8 * c], bfhi(p.x) + g2 * o[8 * c + 1]); w.y = pk2(bflo(p.y) + g2 * o[8 * c + 2], bfhi(p.y) + g2 * o[8 * c + 3]);
              w.z = pk2(bflo(p.z) + g2 * o[8 * c + 4], bfhi(p.z) + g2 * o[8 * c + 5]); w.w = pk2(bflo(p.w) + g2 * o[8 * c + 6], bfhi(p.w) + g2 * o[8 * c + 7]);
              *(v4u*)(op + 8 * c) = w; } }
    }
}
typedef short bf16x8 __attribute__((ext_vector_type(8)));
typedef short s16x4 __attribute__((ext_vector_type(4)));
typedef float f32x16 __attribute__((ext_vector_type(16)));
typedef __bf16 bf16x2_t __attribute__((ext_vector_type(2)));
namespace fa {
DI int crow(int i, int h) { return (i & 3) + 8 * (i >> 2) + 4 * h; }
DI void glds16(const void* gsrc, unsigned lds_dst) { unsigned keep;
    asm volatile("s_mov_b32 %0, m0\n\ts_mov_b32 m0, %2\n\ts_nop 0\n\tglobal_load_lds_dwordx4 %1, off\n\ts_mov_b32 m0, %0" : "=&s"(keep) : "v"(gsrc), "s"(lds_dst) : "memory"); }
#define FA_WAIT_BAR(N) asm volatile("s_waitcnt vmcnt(" #N ") lgkmcnt(0)\n\ts_barrier" ::: "memory")
DI unsigned cvtpk(float lo, float hi) { f32x2 v = {lo, hi}; bf16x2_t b = __builtin_convertvector(v, bf16x2_t); return __builtin_bit_cast(unsigned, b); }
DI float xmax32(float v) { float a = v, b = v; asm volatile("s_nop 1\n\tv_permlane32_swap_b32 %0, %1\n\ts_nop 1" : "+v"(a), "+v"(b)); return fmaxf(a, b); }
DI float xsum32(float v) { float a = v, b = v; asm volatile("s_nop 1\n\tv_permlane32_swap_b32 %0, %1\n\ts_nop 1" : "+v"(a), "+v"(b)); return a + b; }
typedef short v4i16_t __attribute__((ext_vector_type(4)));
DI s16x4 vtr(LAS const char* p) { return __builtin_bit_cast(s16x4, __builtin_amdgcn_ds_read_tr16_b64_v4i16((LAS v4i16_t*)p)); }
constexpr int KSLOT = 8192, KRING = 3 * KSLOT;
template <int DV, class Pre>
DI void tile(LAS const char* ks, LAS const char* vs, const bf16x8 (&qf)[4], int lane, Pre pre, f32x16 (&o)[DV / 32], float& m, float& l) {
    const int r = lane & 31, h = lane >> 5;
    f32x16 p0, p1;
#pragma unroll
    for (int i = 0; i < 16; ++i) { p0[i] = 0.f; p1[i] = 0.f; }
    LAS const char* kb = ks + h * 1024 + r * 16;
#pragma unroll
    for (int d0 = 0; d0 < 4; ++d0) {
        const bf16x8 a0 = *(LAS const bf16x8*)(kb + d0 * 2048), a1 = *(LAS const bf16x8*)(kb + d0 * 2048 + 512);
        p0 = __builtin_amdgcn_mfma_f32_32x32x16_bf16(a0, qf[d0], p0, 0, 0, 0);
        p1 = __builtin_amdgcn_mfma_f32_32x32x16_bf16(a1, qf[d0], p1, 0, 0, 0);
    }
    pre(p0, p1);
    float mx = fmaxf(p0[0], p1[0]);
#pragma unroll
    for (int i = 1; i < 16; ++i) mx = fmaxf(mx, fmaxf(p0[i], p1[i]));
    mx = xmax32(mx);
    const float mn = fmaxf(m, mx);
    if (__any(mn > m)) { const float a = __builtin_amdgcn_exp2f(m - mn); l *= a;
#pragma unroll
        for (int b = 0; b < DV / 32; ++b)
#pragma unroll
            for (int i = 0; i < 16; ++i) o[b][i] *= a; }
    m = mn;
    float sum = 0.f;
#pragma unroll
    for (int i = 0; i < 16; ++i) { p0[i] = __builtin_amdgcn_exp2f(p0[i] - mn); p1[i] = __builtin_amdgcn_exp2f(p1[i] - mn); sum += p0[i] + p1[i]; }
    l += sum;
    bf16x8 pf[4];
#pragma unroll
    for (int s = 0; s < 2; ++s) {
        v4u w0, w1;
        w0.x = cvtpk(p0[8 * s], p0[8 * s + 1]); w0.y = cvtpk(p0[8 * s + 2], p0[8 * s + 3]); w0.z = cvtpk(p0[8 * s + 4], p0[8 * s + 5]); w0.w = cvtpk(p0[8 * s + 6], p0[8 * s + 7]);
        w1.x = cvtpk(p1[8 * s], p1[8 * s + 1]); w1.y = cvtpk(p1[8 * s + 2], p1[8 * s + 3]); w1.z = cvtpk(p1[8 * s + 4], p1[8 * s + 5]); w1.w = cvtpk(p1[8 * s + 6], p1[8 * s + 7]);
        pf[s] = __builtin_bit_cast(bf16x8, w0); pf[2 + s] = __builtin_bit_cast(bf16x8, w1);
    }
    LAS const char* vb = vs + ((lane >> 4) & 1) * 32 + (lane & 3) * 8 + (4 * h + ((lane & 15) >> 2)) * 64;
#pragma unroll
    for (int b = 0; b < DV / 32; ++b)
#pragma unroll
        for (int kq = 0; kq < 4; ++kq) {
            const s16x4 lo = vtr(vb + (b * 4 + kq) * 1024), hi = vtr(vb + (b * 4 + kq) * 1024 + 512);
            const bf16x8 vf = {lo[0], lo[1], lo[2], lo[3], hi[0], hi[1], hi[2], hi[3]};
            o[b] = __builtin_amdgcn_mfma_f32_32x32x16_bf16(vf, pf[kq], o[b], 0, 0, 0);
        }
}
template <int DV, class KP, class VP, class Act, class Pre>
DI void loop(LAS char* shm, int wid, int lane, const bf16x8 (&qf)[4], int ntiles, KP kp, VP vp, Act act, Pre pre, f32x16 (&o)[DV / 32], float& m, float& l) {
    constexpr int VSLOT = DV * 128;
    const unsigned ldsK = (unsigned)(size_t)shm, ldsV = ldsK + KRING;
#define FA_ISSUE(i, s) do { glds16(kp(i), (unsigned)__builtin_amdgcn_readfirstlane(ldsK + (s) * KSLOT + wid * 1024)); \
        _Pragma("unroll") for (int pc_ = 0; pc_ < DV / 64; ++pc_) glds16(vp((i), wid + 8 * pc_), (unsigned)__builtin_amdgcn_readfirstlane(ldsV + (s) * VSLOT + (wid + 8 * pc_) * 1024)); } while (0)
    if (ntiles > 0) FA_ISSUE(0, 0);
    if (ntiles > 1) FA_ISSUE(1, 1);
    int sc = 0, sn2 = 2;
    for (int i = 0; i < ntiles; ++i) {
        if (i + 1 < ntiles) { if (DV == 64) FA_WAIT_BAR(2); else FA_WAIT_BAR(3); } else FA_WAIT_BAR(0);
        if (i + 2 < ntiles) FA_ISSUE(i + 2, sn2);
        if (act(i)) tile<DV>((LAS const char*)shm + sc * KSLOT, (LAS const char*)shm + KRING + sc * VSLOT, qf, lane, [&](f32x16& p0, f32x16& p1) { pre(i, p0, p1); }, o, m, l);
        sc = (sc == 2) ? 0 : sc + 1; sn2 = (sn2 == 2) ? 0 : sn2 + 1;
    }
    FA_WAIT_BAR(0);
#undef FA_ISSUE
}
template <int DV>
DI void store_o(bf16* orow, int h, const f32x16 (&o)[DV / 32], float sc) {
#pragma unroll
    for (int b = 0; b < DV / 32; ++b)
#pragma unroll
        for (int g4 = 0; g4 < 4; ++g4) { v2u w; w.x = cvtpk(o[b][4 * g4] * sc, o[b][4 * g4 + 1] * sc); w.y = cvtpk(o[b][4 * g4 + 2] * sc, o[b][4 * g4 + 3] * sc);
            *(v2u*)(orow + 32 * b + 8 * g4 + 4 * h) = w; }
}
}
constexpr int FA_CUM_OFF = 98304;
DI void attn_fox_fast(Ctx& C) {
    const int vblk = (C.blk % 8) * (C.G / 8) + C.blk / 8;
    const bf16* QKV = (const bf16*)(C.ws + WS_R1); bf16* O = (bf16*)(C.ws + WS_UO); const float* CUM = (const float*)(C.ws + WS_CUM);
    const int lane = C.lane, wid = C.wave, r = lane & 31, h2 = lane >> 5;
    LAS float* cumL = (LAS float*)(C.lds + FA_CUM_OFF);
    const int nunits = BATCH * 16 * 16, per = (nunits + C.G - 1) / C.G;
    for (int ui = 0; ui < per; ++ui) {
        const int u = vblk * per + ui; if (u >= nunits) break;
        const int bh = u / 16, k16 = u % 16, pair = k16 >> 1, qblk = (k16 & 1) ? (15 - pair) : pair;
        const int b = bh / 16, hd = bh % 16;
        const float* cum = CUM + (size_t)bh * SEQ;
        const int nt = 4 * qblk + 4;
        for (int i = C.tid; i < nt * 16; i += NTHR) *(LAS f32x4*)(cumL + 4 * i) = *(const f32x4*)(cum + 4 * i);
        const int tq = 256 * qblk + 32 * wid + r; const size_t row = (size_t)b * SEQ + tq;
        bf16x8 qf[4];
#pragma unroll
        for (int d0 = 0; d0 < 4; ++d0) qf[d0] = *(const bf16x8*)(QKV + row * 3072 + hd * 64 + d0 * 16 + h2 * 8);
        const float cq = cum[tq];
        const bf16* kbase = QKV + (size_t)b * SEQ * 3072 + 1024 + hd * 64 + (size_t)lane * 3072 + wid * 8;
        const bf16* vbase = QKV + (size_t)b * SEQ * 3072 + 2048 + hd * 64 + (size_t)(16 * (wid & 3) + (lane >> 2)) * 3072 + (wid >> 2) * 32 + (lane & 3) * 8;
        const int jdiag = 4 * qblk + (wid >> 1), qloc = 32 * (wid & 1) + r;
        f32x16 o[2]; float m = -1e30f, l = 0.f;
#pragma unroll
        for (int i = 0; i < 16; ++i) { o[0][i] = 0.f; o[1][i] = 0.f; }
        asm volatile("s_waitcnt lgkmcnt(0)" ::: "memory"); __builtin_amdgcn_s_barrier();
        fa::loop<64>((LAS char*)C.lds, wid, lane, qf, nt,
            [&](int i) { return kbase + (size_t)(nt - 1 - i) * 64 * 3072; },
            [&](int i, int) { return vbase + (size_t)(nt - 1 - i) * 64 * 3072; },
            [&](int i) { return (nt - 1 - i) <= jdiag; },
            [&](int i, f32x16& p0, f32x16& p1) { const int j = nt - 1 - i; const LAS float* cl = cumL + 64 * j + 4 * h2;
#pragma unroll
                for (int g4 = 0; g4 < 4; ++g4) { const f32x4 c0 = *(const LAS f32x4*)(cl + 8 * g4), c1 = *(const LAS f32x4*)(cl + 32 + 8 * g4);
                    p0[4 * g4] += cq - c0.x; p0[4 * g4 + 1] += cq - c0.y; p0[4 * g4 + 2] += cq - c0.z; p0[4 * g4 + 3] += cq - c0.w;
                    p1[4 * g4] += cq - c1.x; p1[4 * g4 + 1] += cq - c1.y; p1[4 * g4 + 2] += cq - c1.z; p1[4 * g4 + 3] += cq - c1.w; }
                if (j == jdiag) {
#pragma unroll
                    for (int ii = 0; ii < 16; ++ii) { const int kv = fa::crow(ii, h2); if (kv > qloc) p0[ii] = -INFINITY; if (kv + 32 > qloc) p1[ii] = -INFINITY; } } },
            o, m, l);
        l = fa::xsum32(l);
        fa::store_o<64>(O + row * DM + hd * 64, h2, o, 1.0f / l);
    }
}
__global__ void __launch_bounds__(NTHR, 2) hybrid_fwd(Args args) {
    extern __shared__ __attribute__((aligned(16))) unsigned char lds_raw[];
    Ctx C;
    C.hbuf = args.out; C.ws = args.ws; C.lds = (LAS unsigned char*)lds_raw;
    C.tid = threadIdx.x; C.lane = C.tid & 63; C.wave = __builtin_amdgcn_readfirstlane(C.tid >> 6); C.G = gridDim.x; C.blk = blockIdx.x;
    volatile LAS unsigned* MISC = (volatile LAS unsigned*)(C.lds + MISC_OFF);
    if (C.tid < 32) MISC[C.tid] = 0u;
    if (C.tid == 0) {
#pragma unroll
        for (int i = 0; i < N_IN; ++i) ((LAS unsigned long long*)(C.lds + PTR_OFF))[i] = (unsigned long long)args.in[i];
    }
    __syncthreads();
    const int lo = args.ph_lo, hi = args.ph_hi;
    unsigned* barw = (unsigned*)(C.ws + WS_CTL) + CW_BAR;
    XcdBarrier bar; bar.bar = barw; bar.x = 0; bar.st = nullptr;
    if (hi - lo > 1) bar = xcd_barrier_post(barw, MISC + 8);
    int ph = 0;
#ifndef DBG_ONLY
#define DBG_ONLY -1
#endif
#define PHASE(tag, ...) do { if ((DBG_ONLY < 0 || DBG_ONLY == (tag)) && lo <= ph && ph < hi) { { int t_ = threadIdx.x; asm volatile("" : "+v"(t_)); C.tid = t_; C.lane = t_ & 63; } __VA_ARGS__; if (ph + 1 < hi) xcd_barrier(bar); } ++ph; } while (0)
    bf16* const UO = (bf16*)(C.ws + WS_UO); bf16* const O2 = (bf16*)(C.ws + WS_O2); bf16* const R1 = (bf16*)(C.ws + WS_R1);
    const float* const WQ_ = nullptr; (void)WQ_;

    PHASE(0, phase_p0a(C));
    PHASE(0, phase_p0b(C));
    PHASE(1, phase_n1<0>(C));
    PHASE(2, gemm_qkv(C, UO, (const bf16*)(C.ws + WS_FOXWIN), FOX_NPAD, R1, 3072, 3072, (float*)(C.ws + WS_FLOG), 16));
    PHASE(3, { const PrepSeg segs[2] = {{0, 16, inp(C, I_FOX_QG), 0, QSC}, {1024, 16, inp(C, I_FOX_KG), 0, 1.0f}}; prep_rows<2>(C, R1, 3072, segs); fox_scan(C); });
    PHASE(4, attn_fox_fast(C));
    PHASE(2, gemm_qkv(C, UO, (const bf16*)(C.ws + WS_WOUT), DM, R1, DM, DM, nullptr, 0));
    PHASE(5, phase_n2<0>(C, R1));
    PHASE(6, phase_s(C));
    PHASE(7, gemm_moe1(C, 0));
    PHASE(8, gemm_moe2(C, 0));
    PHASE(1, phase_n1<1>(C));
    PHASE(2, gemm_qkv(C, UO, (const bf16*)(C.ws + WS_NSAWIN), NSA_NPAD, R1, NSA_LDQ, NSA_LDQ, (float*)(C.ws + WS_GATE), 48));
    PHASE(3, { const PrepSeg segs[3] = {{0, 16, inp(C, I_NSA_QG), 1, QSC}, {1536, 4, inp(C, I_NSA_KG) + 64, 1, 1.0f}, {2048, 4, inp(C, I_NSA_KG) + 128, 1, 1.0f}}; prep_rows<3>(C, R1, NSA_LDQ, segs); nsa_compress(C); });
    PHASE(9, nsa_cmp_select(C));
    PHASE(10, attn_nsa_naive(C));
    PHASE(2, gemm_qkv(C, UO, (const bf16*)(C.ws + WS_WOUT + 2 * MiB), DM, R1, DM, DM, nullptr, 0));
    PHASE(5, phase_n2<1>(C, R1));
    PHASE(6, phase_s(C));
    PHASE(7, gemm_moe1(C, 1));
    PHASE(8, gemm_moe2(C, 1));
    PHASE(1, phase_n1<2>(C));
#pragma unroll
    for (int gi = 0; gi < 3; ++gi) {
        const int dil = (gi == 0) ? 1 : (gi == 1) ? 4 : 16;
        PHASE(2, gemm_qkv(C, UO, (const bf16*)(C.ws + WS_DILWIN) + (size_t)gi * 3072 * DM, 3072, R1, 3072, 3072, nullptr, 0));
        PHASE(3, { const PrepSeg segs[2] = {{0, 16, inp(C, I_DIL_QG), 1, QSC}, {1024, 16, inp(C, I_DIL_KG), 1, 1.0f}}; prep_rows<2>(C, R1, 3072, segs); });
        PHASE(11, attn_dil_naive(C, gi, dil));
    }
    PHASE(2, gemm_qkv(C, O2, (const bf16*)(C.ws + WS_WOUT + 4 * MiB), DM, R1, DM, DM, nullptr, 0));
    PHASE(5, phase_n2<2>(C, R1));
    PHASE(6, phase_s(C));
    PHASE(7, gemm_moe1(C, 2));
    PHASE(8, gemm_moe2(C, 2));
    PHASE(1, phase_n1<3>(C));
    PHASE(2, gemm_qkv(C, UO, (const bf16*)(C.ws + WS_DIFFWIN), 3072, R1, 3072, 3072, nullptr, 0));
    PHASE(3, { const PrepSeg segs[2] = {{0, 16, inp(C, I_DIFF_QG), 1, QSC}, {1024, 16, inp(C, I_DIFF_KG), 1, 1.0f}}; prep_rows<2>(C, R1, 3072, segs); });
    PHASE(12, attn_diff_naive(C));
    PHASE(13, diff_combine(C));
    PHASE(2, gemm_qkv(C, UO, (const bf16*)(C.ws + WS_WOUT + 6 * MiB), DM, R1, DM, DM, nullptr, 0));
    PHASE(5, phase_n2<3>(C, R1));
    PHASE(6, phase_s(C));
    PHASE(7, gemm_moe1(C, 3));
    PHASE(8, gemm_moe2(C, 3));
    PHASE(1, phase_final(C));
#undef PHASE
}
constexpr int N_PHASES = 2 + 9 + 10 + 15 + 10 + 1;

#ifndef MK_PER_PHASE
#define MK_PER_PHASE 0
#endif
extern "C" void kernel_launch(void* const* d_in, const int* in_sizes, int n_in, void* d_out, int out_size, void* d_ws, size_t ws_size, hipStream_t stream) {
    static int grid = 0;
    if (grid == 0) {
        if (n_in != N_IN || out_size != T * DM || ws_size < WS_END) { fprintf(stderr, "kernel_launch: unexpected shapes (n_in %d out %d ws %zu)\n", n_in, out_size, ws_size); grid = -1; return; }
        int dev = 0, cus = 0, per_cu = 0;
        if (hipGetDevice(&dev) != hipSuccess || hipDeviceGetAttribute(&cus, hipDeviceAttributeMultiprocessorCount, dev) != hipSuccess) { grid = -1; return; }
        if (hipFuncSetAttribute((const void*)hybrid_fwd, hipFuncAttributeMaxDynamicSharedMemorySize, LDS_BYTES) != hipSuccess) { fprintf(stderr, "kernel_launch: hipFuncSetAttribute failed\n"); grid = -1; return; }
        if (hipOccupancyMaxActiveBlocksPerMultiprocessor(&per_cu, (const void*)hybrid_fwd, NTHR, LDS_BYTES) != hipSuccess || per_cu < 1) fprintf(stderr, "kernel_launch: occupancy query reports %d\n", per_cu);
        (void)hipGetLastError();
        grid = (cus >= 256) ? 256 : (cus >= 128) ? 128 : 64;
    }
    if (grid < 0) return;
    (void)hipMemsetAsync((char*)d_ws + WS_CTL, 0, CTL_ZERO_BYTES, stream);
    Args a{};
    for (int i = 0; i < N_IN; ++i) a.in[i] = (const float*)d_in[i];
    a.out = (float*)d_out; a.ws = (unsigned char*)d_ws;
#if MK_PER_PHASE
    for (int p = 0; p < N_PHASES; ++p) { a.ph_lo = p; a.ph_hi = p + 1; hipLaunchKernelGGL(hybrid_fwd, dim3(grid), dim3(NTHR), LDS_BYTES, stream, a); }
#else
    a.ph_lo = 0; a.ph_hi = N_PHASES;
    hipLaunchKernelGGL(hybrid_fwd, dim3(grid), dim3(NTHR), LDS_BYTES, stream, a);
#endif
    const hipError_t le = hipPeekAtLastError();
    if (le != hipSuccess) fprintf(stderr, "kernel_launch: launch failed: %s\n", hipGetErrorName(le));
}
```

```cpp
#include <hip/hip_runtime.h>
#include <cstdio>
#include <cstdint>
namespace pg8 {
#define PG8_LAS __attribute__((address_space(3)))
typedef unsigned short bf16_t;
typedef short bf16x8 __attribute__((ext_vector_type(8)));
typedef float f32x4 __attribute__((ext_vector_type(4)));
typedef unsigned u32x4 __attribute__((ext_vector_type(4)));
constexpr int BM = 256, BK = 64, HALF = 128, HTB = HALF * BK * 2  , STAGE_BYTES = 8 * HTB, NXCD = 8, WGM = 8;

__host__ __device__ __forceinline__ int lds_byte(int r, int c) { const int st = (r >> 4) * 2 + (c >> 5), rr = r & 15, cc = c & 31, ob = rr * 64 + cc * 2; return st * 1024 + (ob ^ (((ob >> 9) & 1) << 5)); }
__host__ __device__ __forceinline__ void stage_rc(int b, int& R, int& C) { const int st = b / 1024, sb = b % 1024, swz = sb ^ (((sb >> 9) & 1) << 5); R = (st >> 1) * 16 + swz / 64; C = (st & 1) * 32 + (swz % 64) / 2; }
__host__ __device__ __forceinline__ int perm32(int rho) { const int n = rho >> 4, i = rho & 15; return 8 * (i >> 2) + 4 * n + (i & 3); }

struct Unit { int pm, pn; };
struct Gemm { const bf16_t* A; const bf16_t* Bt; int M, N, K; };

struct StaticOrder {
    int nM, nN, nwg, G, c;
    __host__ __device__ void init(int M, int N, int G_, int c_) { nM = M / BM; nN = N / BM; nwg = nM * nN; G = G_; c = c_; }
    __host__ __device__ bool next(int i, Unit& u) const {
        const long L = (long)i * G + c; if (L >= nwg) return false;
        int wgid = (int)L; { const int q = nwg / NXCD, r = nwg % NXCD, xcd = wgid % NXCD, off = wgid / NXCD; wgid = (xcd < r ? xcd * (q + 1) : r * (q + 1) + (xcd - r) * q) + off; }
        const int nig = WGM * nN, gid = wgid / nig, fm = gid * WGM, gsz = (nM - fm) < WGM ? (nM - fm) : WGM;
        u.pm = fm + ((wgid % nig) % gsz); u.pn = (wgid % nig) / gsz; return true;
    }
    __device__ __forceinline__ void a_ready(const Unit&) const {}
    __device__ __forceinline__ void done(const Unit&) const {}
};
__device__ __forceinline__ unsigned cvt_pk_bf16(float lo, float hi) { unsigned r; asm volatile("v_cvt_pk_bf16_f32 %0, %1, %2" : "=v"(r) : "v"(lo), "v"(hi)); return r; }
typedef float f32x2 __attribute__((ext_vector_type(2)));
struct EpiStore {
    static constexpr bool PERM = true, AFTER_DRAIN = false;
    bf16_t* O; int ldc; int ntn; int n_main; float* tail; int tail_n;
    __device__ __forceinline__ void operator()(const f32x4 (&acc)[2][2][4][2], const Unit& u, int wr, int wc, int fr, int fq) const {
        const int row0 = u.pm * BM + wr * 64 + fr; const int ct = u.pn % ntn;
#pragma unroll
        for (int bj = 0; bj < 2; ++bj) {
            const int col = ct * BM + bj * HALF + wc * 32 + 8 * fq;
            if (col < n_main) {
#pragma unroll
                for (int ai = 0; ai < 2; ++ai)
#pragma unroll
                    for (int m = 0; m < 4; ++m) { const f32x4 v0 = acc[ai][bj][m][0], v1 = acc[ai][bj][m][1];
                        u32x4 w; w.x = cvt_pk_bf16(v0[0], v0[1]); w.y = cvt_pk_bf16(v0[2], v0[3]); w.z = cvt_pk_bf16(v1[0], v1[1]); w.w = cvt_pk_bf16(v1[2], v1[3]);
                        *(u32x4*)(O + (size_t)(row0 + ai * HALF + m * 16) * ldc + col) = w; }
            } else if (col - n_main < tail_n) {
#pragma unroll
                for (int ai = 0; ai < 2; ++ai)
#pragma unroll
                    for (int m = 0; m < 4; ++m) { float* p = tail + (size_t)(row0 + ai * HALF + m * 16) * tail_n + (col - n_main);
                        *(f32x4*)p = acc[ai][bj][m][0]; *(f32x4*)(p + 4) = acc[ai][bj][m][1]; }
            }
        }
    }
};
struct EpiSwiGLU {
    static constexpr bool PERM = true, AFTER_DRAIN = false;
    bf16_t* H; int ntn;
    __device__ __forceinline__ void operator()(const f32x4 (&acc)[2][2][4][2], const Unit& u, int wr, int wc, int fr, int fq) const {
        const int row0 = u.pm * BM + wr * 64 + fr; const int ct = u.pn % ntn;
        typedef unsigned u32x2v __attribute__((ext_vector_type(2)));
#pragma unroll
        for (int bj = 0; bj < 2; ++bj) {
            const int hc = ct * 128 + bj * 64 + wc * 16 + 4 * fq;
#pragma unroll
            for (int ai = 0; ai < 2; ++ai)
#pragma unroll
                for (int m = 0; m < 4; ++m) { const f32x4 g = acc[ai][bj][m][0], up = acc[ai][bj][m][1]; float r[4];
#pragma unroll
                    for (int i = 0; i < 4; ++i) { const float e = __builtin_amdgcn_exp2f(-g[i] * 1.4426950408889634f); r[i] = g[i] * __builtin_amdgcn_rcpf(1.0f + e) * up[i]; }
                    u32x2v w; w.x = cvt_pk_bf16(r[0], r[1]); w.y = cvt_pk_bf16(r[2], r[3]);
                    *(u32x2v*)(H + (size_t)(row0 + ai * HALF + m * 16) * 512 + hc) = w; }
        }
    }
};
struct MoeOrder {
    const int* tile_e; int ntiles, NT, G, c;
    __device__ __forceinline__ bool next(int i, Unit& u) const {
        const int L = i * G + c; if (L >= ntiles * NT) return false;
        const int pm = L / NT, j = L % NT; u.pm = pm; u.pn = tile_e[pm] * NT + j; return true;
    }
    __device__ __forceinline__ void a_ready(const Unit&) const {}
    __device__ __forceinline__ void done(const Unit&) const {}
};
template <class Epi, class Sched, bool ALIGN_EPI = false, bool SP2 = false>
__device__ __forceinline__ void gemm_phase(PG8_LAS unsigned char* lds, const Gemm g, const Sched& S, const Epi& E) {
    int tid_ = threadIdx.x; asm volatile("" : "+v"(tid_));
    const int tid = tid_, wid = __builtin_amdgcn_readfirstlane(tid >> 6), lane = tid & 63, wr = wid >> 2, wc = wid & 3, fr = lane & 15, fq = lane >> 4;
    const int K = g.K, nt = K / BK;
    unsigned voffA[2], voffB[2];
#pragma unroll
    for (int i = 0; i < 2; ++i) { int R, C; stage_rc(tid * 16 + i * 8192, R, C); const int Rb = Epi::PERM ? ((R & ~31) + perm32(R & 31)) : R;
        voffA[i] = (unsigned)(R * K + C) * 2u; voffB[i] = (unsigned)(Rb * K + C) * 2u; }
    const size_t kstep = (size_t)(BK * 2);
    const size_t hstep = (size_t)HALF * K * 2;
    const size_t tstep = 2 * hstep;
    const unsigned ldsw = (unsigned)wid * 1024u;
    const int aoff = lds_byte(wr * 64 + fr, fq * 8), boff = lds_byte(wc * 32 + fr, fq * 8);
#define PG8_SA(b, h) (((b) * 2 + (h)) * HTB)
#define PG8_SB(b, h) ((4 + (b) * 2 + (h)) * HTB)
#define PG8_STAGE(bufoff, gbase, voff) do { _Pragma("unroll") for (int _i = 0; _i < 2; ++_i) \
        __builtin_amdgcn_global_load_lds((const unsigned*)((const char*)(gbase) + (voff)[_i]), (PG8_LAS unsigned*)(lds + (bufoff) + ldsw + _i * 8192), 16, 0, 0); } while (0)
#define PG8_LDA(dst, b, h) do { _Pragma("unroll") for (int m = 0; m < 4; ++m) _Pragma("unroll") for (int k = 0; k < 2; ++k) dst[m][k] = *(const PG8_LAS bf16x8*)(lds + PG8_SA(b, h) + aoff + m * 2048 + k * 1024); } while (0)
#define PG8_LDB(dst, b, h) do { _Pragma("unroll") for (int n = 0; n < 2; ++n) _Pragma("unroll") for (int k = 0; k < 2; ++k) dst[n][k] = *(const PG8_LAS bf16x8*)(lds + PG8_SB(b, h) + boff + n * 2048 + k * 1024); } while (0)
#define PG8_MMA(ai, bj, At, Bt) do { __builtin_amdgcn_s_setprio(1); _Pragma("unroll") for (int m = 0; m < 4; ++m) _Pragma("unroll") for (int n = 0; n < 2; ++n) _Pragma("unroll") for (int k = 0; k < 2; ++k) \
        acc[ai][bj][m][n] = __builtin_amdgcn_mfma_f32_16x16x32_bf16(Bt[n][k], At[m][k], acc[ai][bj][m][n], 0, 0, 0); __builtin_amdgcn_s_setprio(0); } while (0)
#define PG8_WAIT_V(n) asm volatile("s_waitcnt vmcnt(" #n ")" ::: "memory")
#define PG8_WAIT_L(n) asm volatile("s_waitcnt lgkmcnt(" #n ")" ::: "memory")
#define PG8_BAR __builtin_amdgcn_s_barrier()
#define PG8_SCHED __builtin_amdgcn_sched_barrier(0)
    Unit cur, nxt; int ui = 0;
    if (!S.next(0, cur)) return;
    f32x4 acc[2][2][4][2];
#pragma unroll
    for (int a = 0; a < 2; ++a)
#pragma unroll
        for (int b = 0; b < 2; ++b)
#pragma unroll
            for (int m = 0; m < 4; ++m)
#pragma unroll
                for (int n = 0; n < 2; ++n) acc[a][b][m][n] = (f32x4){0.f, 0.f, 0.f, 0.f};
    bf16x8 At[4][2], B0[2][2], B1[2][2];
    const char* cA = (const char*)g.A + (size_t)cur.pm * tstep; const char* cB = (const char*)g.Bt + (size_t)cur.pn * tstep;
    S.a_ready(cur);
    if constexpr (SP2) {
        PG8_STAGE(PG8_SB(0, 0), cB, voffB); PG8_STAGE(PG8_SB(0, 1), cB + hstep, voffB); PG8_STAGE(PG8_SA(0, 0), cA, voffA); PG8_STAGE(PG8_SA(0, 1), cA + hstep, voffA);
        if (wr == 1) PG8_BAR;
        PG8_WAIT_V(2); PG8_BAR;
        PG8_STAGE(PG8_SB(1, 0), cB + kstep, voffB); PG8_STAGE(PG8_SA(1, 0), cA + kstep, voffA); PG8_STAGE(PG8_SB(1, 1), cB + hstep + kstep, voffB);
        PG8_WAIT_V(6); PG8_BAR;
    } else {
        PG8_STAGE(PG8_SB(0, 0), cB, voffB); PG8_STAGE(PG8_SA(0, 0), cA, voffA); PG8_STAGE(PG8_SB(0, 1), cB + hstep, voffB); PG8_STAGE(PG8_SA(0, 1), cA + hstep, voffA);
        if (wr == 1) PG8_BAR;
        PG8_WAIT_V(4); PG8_BAR;
        PG8_STAGE(PG8_SB(1, 0), cB + kstep, voffB); PG8_STAGE(PG8_SA(1, 0), cA + kstep, voffA); PG8_STAGE(PG8_SB(1, 1), cB + hstep + kstep, voffB);
        PG8_WAIT_V(6); PG8_BAR;
    }
    for (;;) {
        const bool has_next = S.next(ui + 1, nxt);
        const char* nA = has_next ? (const char*)g.A + (size_t)nxt.pm * tstep : cA; const char* nB = has_next ? (const char*)g.Bt + (size_t)nxt.pn * tstep : cB;
        for (int t = 0; t < nt; t += 2) {
            const bool last = (t == nt - 2);
            const char* a1 = cA + (size_t)(t + 1) * kstep;
            const char* a2 = last ? nA : cA + (size_t)(t + 2) * kstep; const char* b2 = last ? nB : cB + (size_t)(t + 2) * kstep;
            const char* a3 = a2 + kstep; const char* b3 = b2 + kstep;
            if (last && has_next) S.a_ready(nxt);
            if constexpr (SP2) {
            PG8_LDB(B0, 0, 0); PG8_LDB(B1, 0, 1); PG8_SCHED; PG8_LDA(At, 0, 0); PG8_STAGE(PG8_SA(1, 1), a1 + hstep, voffA);
            PG8_WAIT_V(8); PG8_WAIT_L(0); PG8_BAR; PG8_MMA(0, 0, At, B0); PG8_MMA(0, 1, At, B1); PG8_BAR; PG8_SCHED;
            PG8_LDA(At, 0, 1); PG8_STAGE(PG8_SB(0, 0), b2, voffB); PG8_STAGE(PG8_SB(0, 1), b2 + hstep, voffB); PG8_STAGE(PG8_SA(0, 0), a2, voffA);
            PG8_WAIT_V(8); PG8_WAIT_L(0); PG8_BAR; PG8_MMA(1, 0, At, B0); PG8_MMA(1, 1, At, B1); PG8_BAR; PG8_SCHED;
            PG8_LDB(B0, 1, 0); PG8_LDB(B1, 1, 1); PG8_SCHED; PG8_LDA(At, 1, 0); PG8_STAGE(PG8_SA(0, 1), a2 + hstep, voffA);
            PG8_WAIT_V(8); PG8_WAIT_L(0); PG8_BAR; PG8_MMA(0, 0, At, B0); PG8_MMA(0, 1, At, B1); PG8_BAR; PG8_SCHED;
            PG8_LDA(At, 1, 1); PG8_STAGE(PG8_SB(1, 0), b3, voffB); PG8_STAGE(PG8_SB(1, 1), b3 + hstep, voffB); PG8_STAGE(PG8_SA(1, 0), a3, voffA);
            PG8_WAIT_V(8); PG8_WAIT_L(0); PG8_BAR; PG8_MMA(1, 0, At, B0); PG8_MMA(1, 1, At, B1); PG8_BAR; PG8_SCHED;
            } else {
            PG8_LDB(B0, 0, 0); PG8_SCHED; PG8_LDA(At, 0, 0); PG8_STAGE(PG8_SA(1, 1), a1 + hstep, voffA);
            PG8_WAIT_L(8); PG8_BAR; PG8_WAIT_L(0); PG8_MMA(0, 0, At, B0); PG8_BAR; PG8_SCHED;
            PG8_LDB(B1, 0, 1); PG8_STAGE(PG8_SB(0, 0), b2, voffB);
            PG8_BAR; PG8_WAIT_L(0); PG8_MMA(0, 1, At, B1); PG8_BAR;
            PG8_LDA(At, 0, 1); PG8_STAGE(PG8_SA(0, 0), a2, voffA);
            PG8_BAR; PG8_WAIT_L(0); PG8_MMA(1, 0, At, B0); PG8_BAR; PG8_SCHED;
            PG8_STAGE(PG8_SB(0, 1), b2 + hstep, voffB);
            PG8_WAIT_V(6); PG8_BAR; PG8_MMA(1, 1, At, B1); PG8_BAR;
            PG8_LDB(B0, 1, 0); PG8_SCHED; PG8_LDA(At, 1, 0); PG8_STAGE(PG8_SA(0, 1), a2 + hstep, voffA);
            PG8_WAIT_L(8); PG8_BAR; PG8_WAIT_L(0); PG8_MMA(0, 0, At, B0); PG8_BAR; PG8_SCHED;
            PG8_LDB(B1, 1, 1); PG8_STAGE(PG8_SB(1, 0), b3, voffB);
            PG8_BAR; PG8_WAIT_L(0); PG8_MMA(0, 1, At, B1); PG8_BAR;
            PG8_LDA(At, 1, 1); PG8_STAGE(PG8_SA(1, 0), a3, voffA);
            PG8_BAR; PG8_WAIT_L(0); PG8_MMA(1, 0, At, B0); PG8_BAR; PG8_SCHED;
            PG8_STAGE(PG8_SB(1, 1), b3 + hstep, voffB);
            PG8_WAIT_V(6); PG8_BAR; PG8_MMA(1, 1, At, B1); PG8_BAR;
            }
        }
        if constexpr (ALIGN_EPI) { if (wr == 0) PG8_BAR; }
        if constexpr (!Epi::AFTER_DRAIN) { E(acc, cur, wr, wc, fr, fq); S.done(cur); }
        if (!has_next) break;
#pragma unroll
        for (int a = 0; a < 2; ++a)
#pragma unroll
            for (int b = 0; b < 2; ++b)
#pragma unroll
                for (int m = 0; m < 4; ++m)
#pragma unroll
                    for (int n = 0; n < 2; ++n) acc[a][b][m][n] = (f32x4){0.f, 0.f, 0.f, 0.f};
        cur = nxt; cA = nA; cB = nB; ++ui;
        if constexpr (ALIGN_EPI) { if (wr == 1) PG8_BAR; }
    }
    PG8_WAIT_V(0);
    if constexpr (!ALIGN_EPI) { if (wr == 0) PG8_BAR; }
    PG8_BAR;
    if constexpr (Epi::AFTER_DRAIN) { E.fused(acc, cur, wr, wc, fr, fq, lds, wid, lane); S.done(cur); }
#undef PG8_SA
#undef PG8_SB
#undef PG8_STAGE
#undef PG8_LDA
#undef PG8_LDB
#undef PG8_MMA
#undef PG8_WAIT_V
#undef PG8_WAIT_L
#undef PG8_BAR
#undef PG8_SCHED
}
}
#define GAS __attribute__((address_space(1)))
#define LAS __attribute__((address_space(3)))
#define DI __device__ __forceinline__
typedef unsigned short bf16;
typedef unsigned v4u __attribute__((ext_vector_type(4)));
typedef unsigned v2u __attribute__((ext_vector_type(2)));
typedef float f32x4 __attribute__((ext_vector_type(4)));
typedef float f32x2 __attribute__((ext_vector_type(2)));
typedef GAS unsigned gu32;
#define LDS_WAIT() asm volatile("s_waitcnt lgkmcnt(0)" ::: "memory")
#define VM_WAIT() asm volatile("s_waitcnt vmcnt(0)" ::: "memory")
DI unsigned f2bf(float f) { unsigned u = __builtin_bit_cast(unsigned, f); return (u + 0x7fffu + ((u >> 16) & 1u)) >> 16; }
DI unsigned pk2(float lo, float hi) { return f2bf(lo) | (f2bf(hi) << 16); }
DI float bflo(unsigned u) { return __builtin_bit_cast(float, u << 16); }
DI float bfhi(unsigned u) { return __builtin_bit_cast(float, u & 0xffff0000u); }
DI float wave_sum(float v) {
#pragma unroll
    for (int o = 1; o < 64; o <<= 1) v += __shfl_xor(v, o);
    return v;
}
DI float wave_max(float v) {
#pragma unroll
    for (int o = 1; o < 64; o <<= 1) v = fmaxf(v, __shfl_xor(v, o));
    return v;
}
#define XB_TMO      128
#define XB_XCNT(j)  (256  + 64 * (j))
#define XB_XSUB(j)  (1280 + 64 * (j))
#define XB_XGEN(j)  (2304 + 64 * (j))
#define XB_TOP      3328
#define XB_TOPGEN   3392
#define XCD_BAR_WORDS 3456
#define XB_SPIN_CAP (1u << 18)

__device__ __forceinline__ unsigned xb_ld(unsigned* p)              { return __hip_atomic_load(p, __ATOMIC_RELAXED, __HIP_MEMORY_SCOPE_AGENT); }
__device__ __forceinline__ unsigned xb_add(unsigned* p, unsigned v) { return __hip_atomic_fetch_add(p, v, __ATOMIC_RELAXED, __HIP_MEMORY_SCOPE_AGENT); }
__device__ __forceinline__ unsigned xb_xcc_id() { return (unsigned)__builtin_amdgcn_s_getreg((3 << 11) | 20) & 0xFu; }
#define XB_SPIN(cond, bar) do { unsigned _sp = 0; while (cond) { __builtin_amdgcn_s_sleep(1); \
    if ((++_sp & 255u) == 0u) { if (xb_ld(&(bar)[XB_TMO])) break; if (_sp > XB_SPIN_CAP) { atomicAdd(&(bar)[XB_TMO], 1u); break; } } } } while (0)

struct XcdBarrier {
    unsigned* bar; unsigned x;
    volatile LAS unsigned* st;
};

__device__ __forceinline__ XcdBarrier xcd_barrier_post(unsigned* bar, volatile LAS unsigned* st) {
    XcdBarrier b; b.bar = bar; b.x = xb_xcc_id(); b.st = st;
    if (threadIdx.x == 0) (void)xb_add(&bar[XB_XCNT(b.x)], 1u);
    return b;
}
__device__ __forceinline__ void xcd_barrier_complete(unsigned* bar, unsigned x, unsigned& nloc, unsigned& nx) {
    const unsigned G = gridDim.x * gridDim.y * gridDim.z;
    unsigned sum, cnt, mine, sp = 0u;
    for (;;) {
        sum = 0u; cnt = 0u; mine = 0u;
#pragma unroll
        for (unsigned j = 0; j < 16; ++j) { const unsigned c = xb_ld(&bar[XB_XCNT(j)]); sum += c; cnt += (c > 0u) ? 1u : 0u; mine = (j == x) ? c : mine; }
        if (sum == G) break;
        __builtin_amdgcn_s_sleep(1);
        if ((++sp & 255u) == 0u) { if (xb_ld(&bar[XB_TMO])) break; if (sp > XB_SPIN_CAP) { atomicAdd(&bar[XB_TMO], 1u); break; } }
    }
    nloc = mine > 0u ? mine : 1u; nx = cnt > 0u ? cnt : 1u;
}

__device__ __forceinline__ void xcd_barrier(const XcdBarrier& b) {
    asm volatile("s_waitcnt vmcnt(0)" ::: "memory");
    __syncthreads();
    if (threadIdx.x == 0) {
        unsigned* bar = b.bar;
        __builtin_amdgcn_s_waitcnt(0);
        unsigned nloc = b.st[0], nx = b.st[1];
        if (nloc == 0u) { xcd_barrier_complete(bar, b.x, nloc, nx); b.st[0] = nloc; b.st[1] = nx; }
        const unsigned old = xb_add(&bar[XB_XSUB(b.x)], 1u);
        const unsigned gen = old / nloc;
        if (old + 1u == (gen + 1u) * nloc) {
            __builtin_amdgcn_fence(__ATOMIC_RELEASE, "agent");
            asm volatile("s_waitcnt vmcnt(0)" ::: "memory");
            const unsigned og = xb_add(&bar[XB_TOP], 1u);
            const unsigned tg = og / nx;
            if (og + 1u == (tg + 1u) * nx) xb_add(&bar[XB_TOPGEN], 1u);
            else XB_SPIN(xb_ld(&bar[XB_TOPGEN]) == tg, bar);
            __builtin_amdgcn_fence(__ATOMIC_ACQUIRE, "agent");
            xb_add(&bar[XB_XGEN(b.x)], 1u);
            asm volatile("s_waitcnt vmcnt(0)" ::: "memory");
        } else {
            XB_SPIN(xb_ld(&bar[XB_XGEN(b.x)]) == gen, bar);
            __builtin_amdgcn_fence(__ATOMIC_ACQUIRE, "agent");
            asm volatile("s_waitcnt vmcnt(0)" ::: "memory");
        }
    }
    __syncthreads();
}
constexpr int BATCH = 8, SEQ = 4096, DM = 1024, T = BATCH * SEQ, HD = 64;
constexpr int NWAVES = 8, NTHR = 512;
constexpr float EPS = 1e-6f, LOG2E = 1.4426950408889634f, QSC = 0.125f * LOG2E;
enum { I_X = 0, I_C, I_FOX_WIN, I_FOX_BF, I_FOX_QG, I_FOX_KG, I_FOX_WOUT, I_NSA_WIN, I_NSA_QG, I_NSA_KG, I_NSA_POS, I_NSA_W1, I_NSA_W2, I_NSA_WOUT,
       I_DIL_WIN, I_DIL_QG, I_DIL_KG, I_DIL_WOUT, I_DIFF_WIN, I_DIFF_QG, I_DIFF_KG, I_DIFF_LAM, I_DIFF_SG, I_DIFF_WOUT,
       I_NORM_GAIN, I_ADA_W, I_ADA_B, I_ROUTER_W, I_ROUTER_B, I_MOE_WG, I_MOE_WU, I_MOE_WD, N_IN };
constexpr size_t MiB = 1u << 20;
constexpr size_t WS_CTL = 0, CTL_ZERO_BYTES = 1 * MiB;
constexpr size_t WS_MODP = 1 * MiB, WS_MOD = 7 * MiB, WS_ROPE = 8 * MiB, WS_FLOG = 9 * MiB, WS_CUM = 11 * MiB, WS_GATE = 13 * MiB, WS_LSE = 19 * MiB, WS_SELM = 21 * MiB;
constexpr size_t WS_KC = 22 * MiB, WS_VC = 22 * MiB + 512 * 1024;
constexpr size_t WS_EIDX = 23 * MiB, WS_WTS = WS_EIDX + 256 * 1024, WS_LRANK = WS_WTS + 256 * 1024, WS_ROWOF = WS_LRANK + 256 * 1024;
constexpr size_t WS_HIST = 24 * MiB, WS_TILEE = WS_HIST + 64 * 1024, WS_NTILES = WS_TILEE + 4096;
constexpr size_t WS_FOXWIN = 32 * MiB, WS_NSAWIN = 39 * MiB, WS_DILWIN = 45 * MiB, WS_DIFFWIN = 63 * MiB, WS_WOUT = 69 * MiB;
constexpr size_t WS_MOEW = 80 * MiB, MOEW_LAYER = 48 * MiB, MOEW_D_OFF = 32 * MiB;
constexpr size_t WS_UO = 272 * MiB, WS_O2 = 336 * MiB, WS_R1 = 400 * MiB, WS_HID = WS_R1 + 136 * MiB, WS_END = 608 * MiB;
constexpr int CW_BAR = 4096;
constexpr int LDS_BYTES = 147456, MISC_OFF = 131072 + 320;
constexpr int FOX_NPAD = 3328, NSA_NPAD = 2816;

struct Args { const float* in[N_IN]; float* out; unsigned char* ws; int ph_lo, ph_hi; };
struct Ctx {
    float* hbuf; unsigned char* ws; LAS unsigned char* lds;
    int tid, lane, wave, G, blk;
};
constexpr int PTR_OFF = 131072 + 1024;
DI const float* inp(const Ctx& C, int i) {
    const unsigned long long v = ((const LAS unsigned long long*)(C.lds + PTR_OFF))[i];
    const unsigned lo = __builtin_amdgcn_readfirstlane((unsigned)v), hi = __builtin_amdgcn_readfirstlane((unsigned)(v >> 32));
    return (const float*)(((unsigned long long)hi << 32) | lo);
}

DI void conv_item(const float* W0, const float* W1, int K, int Nsrc, int ldn, bf16* WT, int mode, int nblk, int item, LAS float* scr, int lane) {
    const int kb = item / nblk, nb = item % nblk, k0 = 64 * kb, n0 = 32 * nb;
    const int n = n0 + (lane & 31);
    const float* src; bool valid;
    if (mode == 0) { valid = n < Nsrc; src = W0 + n; }
    else { const int j = n >> 3, i = n & 7; valid = true; src = ((i < 4) ? W0 : W1) + 4 * j + (i & 3); }
#pragma unroll 8
    for (int i = 0; i < 32; ++i) { const int kk = 2 * i + (lane >> 5); scr[kk * 33 + (lane & 31)] = valid ? src[(size_t)(k0 + kk) * ldn] : 0.f; }
    LDS_WAIT(); asm volatile("" ::: "memory");
    const int c = lane & 7;
#pragma unroll
    for (int j = 0; j < 4; ++j) { const int nn = (lane >> 3) + 8 * j; const LAS float* s = scr + (8 * c) * 33 + nn;
        v4u o; o.x = pk2(s[0 * 33], s[1 * 33]); o.y = pk2(s[2 * 33], s[3 * 33]); o.z = pk2(s[4 * 33], s[5 * 33]); o.w = pk2(s[6 * 33], s[7 * 33]);
        *(v4u*)(WT + (size_t)(n0 + nn) * K + k0 + 8 * c) = o; }
    LDS_WAIT(); asm volatile("" ::: "memory");
}
DI void sincos_d(double x, float& s, float& c) {
    const double k = __builtin_rint(x * 0.6366197723675814);
    double r = __builtin_fma(-k, 1.5707963267948966, x); r = __builtin_fma(-k, 6.123233995736766e-17, r);
    const int q = ((int)k) & 3; const double r2 = r * r;
    double sp = 1.0 / 6227020800.0; sp = sp * r2 - 1.0 / 39916800.0; sp = sp * r2 + 1.0 / 362880.0; sp = sp * r2 - 1.0 / 5040.0; sp = sp * r2 + 1.0 / 120.0; sp = sp * r2 - 1.0 / 6.0; sp = sp * r2 + 1.0; sp *= r;
    double cp = -1.0 / 87178291200.0; cp = cp * r2 + 1.0 / 479001600.0; cp = cp * r2 - 1.0 / 3628800.0; cp = cp * r2 + 1.0 / 40320.0; cp = cp * r2 - 1.0 / 720.0; cp = cp * r2 + 1.0 / 24.0; cp = cp * r2 - 0.5; cp = cp * r2 + 1.0;
    const double ss = (q == 0) ? sp : (q == 1) ? cp : (q == 2) ? -sp : -cp;
    const double cc = (q == 0) ? cp : (q == 1) ? -sp : (q == 2) ? -cp : sp;
    s = (float)ss; c = (float)cc;
}
DI void phase_p0a(Ctx& C) {
    const int gw = C.blk * NWAVES + C.wave, NGW = C.G * NWAVES;
    LAS float* cond = (LAS float*)C.lds;
    for (int i = C.tid; i < BATCH * DM; i += NTHR) { const float v = inp(C, I_C)[i]; cond[i] = v / (1.0f + expf(-v)); }
    __syncthreads();
    float* MODP = (float*)(C.ws + WS_MODP);
    for (int it = gw; it < 4 * 96 * 8; it += NGW) {
        const int l = it / 768, rem = it % 768, cg = rem / 8, kc = rem % 8, col = cg * 64 + C.lane;
        float acc[8];
#pragma unroll
        for (int b = 0; b < 8; ++b) acc[b] = 0.f;
        const float* w = inp(C, I_ADA_W) + ((size_t)l * DM + kc * 128) * 6144 + col;
#pragma unroll 4
        for (int k = 0; k < 128; ++k) { const float wv = w[(size_t)k * 6144];
#pragma unroll
            for (int b = 0; b < 8; ++b) acc[b] += cond[b * DM + kc * 128 + k] * wv; }
#pragma unroll
        for (int b = 0; b < 8; ++b) MODP[(((size_t)kc * 4 + l) * 8 + b) * 6144 + col] = acc[b];
    }
    __syncthreads();
    { f32x2* ROPE = (f32x2*)(C.ws + WS_ROPE);
      for (int i = C.blk * NTHR + C.tid; i < SEQ * 32; i += C.G * NTHR) { const int t = i >> 5, f = i & 31;
          const float inv = exp2f(-(float)f * (13.287712379549449f / 32.0f)); const float ang = (float)t * inv; float s, c; sincos_d((double)ang, s, c); ROPE[i] = (f32x2){c, s}; } }
    LAS float* scr = (LAS float*)(C.lds + C.wave * 16384);
    constexpr int I_FOXIN = 16 * (FOX_NPAD / 32), I_NSAIN = 16 * (NSA_NPAD / 32), I_DILIN = 16 * (9216 / 32), I_DIFFIN = 16 * (3072 / 32), I_WO = 16 * 32, I_GU = 16 * 32, I_D = 8 * 32;
    constexpr int NITEMS = I_FOXIN + I_NSAIN + I_DILIN + I_DIFFIN + 4 * I_WO + 64 * I_GU + 64 * I_D;
    for (int it = gw; it < NITEMS; it += NGW) {
        int r = it;
        if (r < I_FOXIN) { conv_item(inp(C, I_FOX_WIN), nullptr, DM, 3088, 3088, (bf16*)(C.ws + WS_FOXWIN), 0, FOX_NPAD / 32, r, scr, C.lane); continue; } r -= I_FOXIN;
        if (r < I_NSAIN) { conv_item(inp(C, I_NSA_WIN), nullptr, DM, 2608, 2608, (bf16*)(C.ws + WS_NSAWIN), 0, NSA_NPAD / 32, r, scr, C.lane); continue; } r -= I_NSAIN;
        if (r < I_DILIN) { conv_item(inp(C, I_DIL_WIN), nullptr, DM, 9216, 9216, (bf16*)(C.ws + WS_DILWIN), 0, 9216 / 32, r, scr, C.lane); continue; } r -= I_DILIN;
        if (r < I_DIFFIN) { conv_item(inp(C, I_DIFF_WIN), nullptr, DM, 3072, 3072, (bf16*)(C.ws + WS_DIFFWIN), 0, 3072 / 32, r, scr, C.lane); continue; } r -= I_DIFFIN;
        if (r < 4 * I_WO) { const int m = r / I_WO; const float* src = (m == 0) ? inp(C, I_FOX_WOUT) : (m == 1) ? inp(C, I_NSA_WOUT) : (m == 2) ? inp(C, I_DIL_WOUT) : inp(C, I_DIFF_WOUT);
            conv_item(src, nullptr, DM, DM, DM, (bf16*)(C.ws + WS_WOUT + (size_t)m * 2 * MiB), 0, 32, r % I_WO, scr, C.lane); continue; } r -= 4 * I_WO;
        if (r < 64 * I_GU) { const int le = r / I_GU, l = le / 16, e = le % 16;
            conv_item(inp(C, I_MOE_WG) + (size_t)le * DM * 512, inp(C, I_MOE_WU) + (size_t)le * DM * 512, DM, 1024, 512, (bf16*)(C.ws + WS_MOEW + (size_t)l * MOEW_LAYER + (size_t)e * 2 * MiB), 1, 32, r % I_GU, scr, C.lane); continue; } r -= 64 * I_GU;
        { const int le = r / I_D, l = le / 16, e = le % 16;
            conv_item(inp(C, I_MOE_WD) + (size_t)le * 512 * DM, nullptr, 512, DM, DM, (bf16*)(C.ws + WS_MOEW + (size_t)l * MOEW_LAYER + MOEW_D_OFF + (size_t)e * MiB), 0, 32, r % I_D, scr, C.lane); }
    }
}
DI void phase_p0b(Ctx& C) {
    const float* MODP = (const float*)(C.ws + WS_MODP); float* MOD = (float*)(C.ws + WS_MOD);
    for (int i = C.blk * NTHR + C.tid; i < 4 * 8 * 6144; i += C.G * NTHR) { const int l = i / (8 * 6144), col = i % 6144;
        float s = inp(C, I_ADA_B)[l * 6144 + col];
#pragma unroll
        for (int kc = 0; kc < 8; ++kc) s += MODP[(size_t)kc * (4 * 8 * 6144) + i];
        MOD[i] = s; }
}
DI void ld_row_f32(const float* p, int lane, f32x4 (&v)[4]) {
#pragma unroll
    for (int j = 0; j < 4; ++j) v[j] = *(const f32x4*)(p + 4 * lane + 256 * j);
}
DI void st_row_f32(float* p, int lane, const f32x4 (&v)[4]) {
#pragma unroll
    for (int j = 0; j < 4; ++j) *(f32x4*)(p + 4 * lane + 256 * j) = v[j];
}
DI void ld_row_bf16(const bf16* p, int lane, f32x4 (&v)[4]) {
#pragma unroll
    for (int j = 0; j < 4; ++j) { const v2u w = *(const v2u*)(p + 4 * lane + 256 * j); v[j] = (f32x4){bflo(w.x), bfhi(w.x), bflo(w.y), bfhi(w.y)}; }
}
DI void st_row_bf16(bf16* p, int lane, const f32x4 (&v)[4]) {
#pragma unroll
    for (int j = 0; j < 4; ++j) { v2u w; w.x = pk2(v[j].x, v[j].y); w.y = pk2(v[j].z, v[j].w); *(v2u*)(p + 4 * lane + 256 * j) = w; }
}
DI void norm_mod(const f32x4 (&h)[4], const float* gain, const float* sc, const float* sh, int lane, f32x4 (&u)[4]) {
    float ss = 0.f;
#pragma unroll
    for (int j = 0; j < 4; ++j) ss += (h[j].x * h[j].x + h[j].y * h[j].y) + (h[j].z * h[j].z + h[j].w * h[j].w);
    const float r = 1.0f / sqrtf(wave_sum(ss) * (1.0f / DM) + EPS);
#pragma unroll
    for (int j = 0; j < 4; ++j) { const f32x4 g = *(const f32x4*)(gain + 4 * lane + 256 * j), s1 = *(const f32x4*)(sc + 4 * lane + 256 * j), s0 = *(const f32x4*)(sh + 4 * lane + 256 * j);
        u[j] = (h[j] * r) * g * (s1 + 1.0f) + s0; }
}
DI void moe_combine(Ctx& C, int LP, int row, int b, f32x4 (&h)[4]) {
    const int* ROWOF = (const int*)(C.ws + WS_ROWOF); const float* WTS = (const float*)(C.ws + WS_WTS); const bf16* YS = (const bf16*)(C.ws + WS_R1);
    const float* g2 = (const float*)(C.ws + WS_MOD) + ((size_t)(LP * 8 + b) * 6 + 5) * DM;
    const int r0 = ROWOF[2 * row], r1 = ROWOF[2 * row + 1]; const float w0 = WTS[2 * row], w1 = WTS[2 * row + 1];
    f32x4 y0[4], y1[4]; ld_row_bf16(YS + (size_t)r0 * DM, C.lane, y0); ld_row_bf16(YS + (size_t)r1 * DM, C.lane, y1);
#pragma unroll
    for (int j = 0; j < 4; ++j) { const f32x4 g = *(const f32x4*)(g2 + 4 * C.lane + 256 * j); h[j] += g * (y0[j] * w0 + y1[j] * w1); }
}
template <int L> DI void phase_n1(Ctx& C) {
    const int RPB = T / C.G, RPW = RPB / NWAVES;
    const float* MOD = (const float*)(C.ws + WS_MOD); bf16* U = (bf16*)(C.ws + WS_UO);
    for (int i = 0; i < RPW; ++i) {
        const int row = C.blk * RPB + C.wave * RPW + i, b = row / SEQ;
        f32x4 h[4], u[4];
        if (L == 0) ld_row_f32(inp(C, I_X) + (size_t)row * DM, C.lane, h);
        else { ld_row_f32(C.hbuf + (size_t)row * DM, C.lane, h); moe_combine(C, L - 1, row, b, h); }
        st_row_f32(C.hbuf + (size_t)row * DM, C.lane, h);
        norm_mod(h, inp(C, I_NORM_GAIN) + (L * 2 + 0) * DM, MOD + ((size_t)(L * 8 + b) * 6 + 1) * DM, MOD + ((size_t)(L * 8 + b) * 6 + 0) * DM, C.lane, u);
        st_row_bf16(U + (size_t)row * DM, C.lane, u);
    }
}
DI void phase_final(Ctx& C) {
    const int RPB = T / C.G, RPW = RPB / NWAVES;
    for (int i = 0; i < RPW; ++i) {
        const int row = C.blk * RPB + C.wave * RPW + i, b = row / SEQ;
        f32x4 h[4]; ld_row_f32(C.hbuf + (size_t)row * DM, C.lane, h); moe_combine(C, 3, row, b, h); st_row_f32(C.hbuf + (size_t)row * DM, C.lane, h);
    }
}
template <int L> DI void phase_n2(Ctx& C, const bf16* Y) {
    const int RPB = T / C.G, RPW = RPB / NWAVES;
    const float* MOD = (const float*)(C.ws + WS_MOD); bf16* U = (bf16*)(C.ws + WS_UO);
    LAS float* wT = (LAS float*)C.lds; LAS int* hist = (LAS int*)(C.lds + 65536);
    for (int idx = C.tid; idx < DM * 16; idx += NTHR) wT[(idx & 15) * DM + (idx >> 4)] = inp(C, I_ROUTER_W)[idx];
    if (C.tid < 16) hist[C.tid] = 0;
    __syncthreads();
    int* EIDX = (int*)(C.ws + WS_EIDX); float* WTS = (float*)(C.ws + WS_WTS); int* LRANK = (int*)(C.ws + WS_LRANK);
    for (int i = 0; i < RPW; ++i) {
        const int row = C.blk * RPB + C.wave * RPW + i, b = row / SEQ;
        f32x4 h[4], y[4], u[4]; ld_row_f32(C.hbuf + (size_t)row * DM, C.lane, h); ld_row_bf16(Y + (size_t)row * DM, C.lane, y);
        const float* g1 = MOD + ((size_t)(L * 8 + b) * 6 + 2) * DM;
#pragma unroll
        for (int j = 0; j < 4; ++j) h[j] += *(const f32x4*)(g1 + 4 * C.lane + 256 * j) * y[j];
        st_row_f32(C.hbuf + (size_t)row * DM, C.lane, h);
        norm_mod(h, inp(C, I_NORM_GAIN) + (L * 2 + 1) * DM, MOD + ((size_t)(L * 8 + b) * 6 + 4) * DM, MOD + ((size_t)(L * 8 + b) * 6 + 3) * DM, C.lane, u);
        st_row_bf16(U + (size_t)row * DM, C.lane, u);
        float sc[16], sel[16];
#pragma unroll
        for (int e = 0; e < 16; ++e) { float a = 0.f;
#pragma unroll
            for (int j = 0; j < 4; ++j) { const f32x4 w = *(const LAS f32x4*)(wT + e * DM + 256 * j + 4 * C.lane); a += (u[j].x * w.x + u[j].y * w.y) + (u[j].z * w.z + u[j].w * w.w); }
            a = wave_sum(a); sc[e] = 1.0f / (1.0f + expf(-a)); sel[e] = sc[e] + inp(C, I_ROUTER_B)[e]; }
        float bs = -INFINITY, bw0 = 0.f, bw1 = 0.f; int be0 = 0, be1 = 1;
#pragma unroll
        for (int g = 0; g < 4; ++g) {
            const float a0 = sel[4 * g], a1 = sel[4 * g + 1], a2 = sel[4 * g + 2], a3 = sel[4 * g + 3];
            const float c0 = sc[4 * g], c1 = sc[4 * g + 1], c2 = sc[4 * g + 2], c3 = sc[4 * g + 3];
            int i1 = 0; float v1 = a0, s1 = c0;
            if (a1 > v1) { v1 = a1; s1 = c1; i1 = 1; } if (a2 > v1) { v1 = a2; s1 = c2; i1 = 2; } if (a3 > v1) { v1 = a3; s1 = c3; i1 = 3; }
            int i2 = -1; float v2 = -INFINITY, s2 = 0.f;
            if (i1 != 0 && a0 > v2) { v2 = a0; s2 = c0; i2 = 0; } if (i1 != 1 && a1 > v2) { v2 = a1; s2 = c1; i2 = 1; }
            if (i1 != 2 && a2 > v2) { v2 = a2; s2 = c2; i2 = 2; } if (i1 != 3 && a3 > v2) { v2 = a3; s2 = c3; i2 = 3; }
            const float gs = v1 + v2;
            if (gs > bs) { bs = gs; be0 = 4 * g + i1; be1 = 4 * g + i2; bw0 = s1; bw1 = s2; }
        }
        if (C.lane == 0) {
            const float inv = 1.0f / (bw0 + bw1);
            EIDX[2 * row] = be0; EIDX[2 * row + 1] = be1; WTS[2 * row] = bw0 * inv; WTS[2 * row + 1] = bw1 * inv;
            LRANK[2 * row] = __hip_atomic_fetch_add(hist + be0, 1, __ATOMIC_RELAXED, __HIP_MEMORY_SCOPE_WORKGROUP);
            LRANK[2 * row + 1] = __hip_atomic_fetch_add(hist + be1, 1, __ATOMIC_RELAXED, __HIP_MEMORY_SCOPE_WORKGROUP);
        }
    }
    __syncthreads();
    if (C.tid < 16) ((int*)(C.ws + WS_HIST))[C.blk * 16 + C.tid] = hist[C.tid];
    __syncthreads();
}
DI void phase_s(Ctx& C) {
    const int RPB = T / C.G, RPW = RPB / NWAVES;
    LAS int* tot = (LAS int*)C.lds; LAS int* before = tot + 16; LAS int* base = tot + 32;
    if (C.tid < 48) tot[C.tid] = 0;
    __syncthreads();
    const int* HIST = (const int*)(C.ws + WS_HIST);
    for (int idx = C.tid; idx < C.G * 16; idx += NTHR) { const int bb = idx >> 4, e = idx & 15; const int c = HIST[idx];
        __hip_atomic_fetch_add(tot + e, c, __ATOMIC_RELAXED, __HIP_MEMORY_SCOPE_WORKGROUP);
        if (bb < C.blk) __hip_atomic_fetch_add(before + e, c, __ATOMIC_RELAXED, __HIP_MEMORY_SCOPE_WORKGROUP); }
    __syncthreads();
    if (C.tid == 0) { int ps = 0; int* TILEE = (int*)(C.ws + WS_TILEE);
        for (int e = 0; e < 16; ++e) { base[e] = ps + before[e]; const int pe = (tot[e] + 255) & ~255;
            if (C.blk == 0) for (int tl = ps >> 8; tl < ((ps + pe) >> 8); ++tl) TILEE[tl] = e;
            ps += pe; }
        if (C.blk == 0) *(int*)(C.ws + WS_NTILES) = ps >> 8; }
    __syncthreads();
    const int* EIDX = (const int*)(C.ws + WS_EIDX); const int* LRANK = (const int*)(C.ws + WS_LRANK); int* ROWOF = (int*)(C.ws + WS_ROWOF);
    const bf16* U = (const bf16*)(C.ws + WS_UO); bf16* XS = (bf16*)(C.ws + WS_R1);
    for (int i = 0; i < RPW; ++i) {
        const int row = C.blk * RPB + C.wave * RPW + i;
        const int d0 = base[EIDX[2 * row]] + LRANK[2 * row], d1 = base[EIDX[2 * row + 1]] + LRANK[2 * row + 1];
        if (C.lane == 0) { ROWOF[2 * row] = d0; ROWOF[2 * row + 1] = d1; }
        const v4u a = *(const v4u*)(U + (size_t)row * DM + 8 * C.lane), bq = *(const v4u*)(U + (size_t)row * DM + 512 + 8 * C.lane);
        *(v4u*)(XS + (size_t)d0 * DM + 8 * C.lane) = a; *(v4u*)(XS + (size_t)d0 * DM + 512 + 8 * C.lane) = bq;
        *(v4u*)(XS + (size_t)d1 * DM + 8 * C.lane) = a; *(v4u*)(XS + (size_t)d1 * DM + 512 + 8 * C.lane) = bq;
    }
    __syncthreads();
}
DI void gemm_qkv(Ctx& C, const bf16* A, const bf16* Bt, int Npad, bf16* O, int ldc, int n_main, float* tail, int tail_n) {
    pg8::Gemm g{A, Bt, T, Npad, DM}; pg8::StaticOrder S; S.init(T, Npad, C.G, C.blk);
    pg8::EpiStore E{O, ldc, 1 << 20, n_main, tail, tail_n};
    pg8::gemm_phase<pg8::EpiStore, pg8::StaticOrder, true, true>(C.lds, g, S, E);
}
DI void gemm_moe1(Ctx& C, int L) {
    const int ntiles = *(const int*)(C.ws + WS_NTILES);
    pg8::Gemm g{(const bf16*)(C.ws + WS_R1), (const bf16*)(C.ws + WS_MOEW + (size_t)L * MOEW_LAYER), ntiles * 256, 16 * 1024, DM};
    pg8::MoeOrder S{(const int*)(C.ws + WS_TILEE), ntiles, 4, C.G, C.blk};
    pg8::EpiSwiGLU E{(bf16*)(C.ws + WS_HID), 4};
    pg8::gemm_phase<pg8::EpiSwiGLU, pg8::MoeOrder, true, true>(C.lds, g, S, E);
}
DI void gemm_moe2(Ctx& C, int L) {
    const int ntiles = *(const int*)(C.ws + WS_NTILES);
    pg8::Gemm g{(const bf16*)(C.ws + WS_HID), (const bf16*)(C.ws + WS_MOEW + (size_t)L * MOEW_LAYER + MOEW_D_OFF), ntiles * 256, 16 * 1024, 512};
    pg8::MoeOrder S{(const int*)(C.ws + WS_TILEE), ntiles, 4, C.G, C.blk};
    pg8::EpiStore E{(bf16*)(C.ws + WS_R1), DM, 4, DM, nullptr, 0};
    pg8::gemm_phase<pg8::EpiStore, pg8::MoeOrder, true, true>(C.lds, g, S, E);
}
struct PrepSeg { int col0, nvec; const float* gain; int rope; float scale; };
template <int NSEG> DI void prep_rows(Ctx& C, bf16* QKV, int ldq, const PrepSeg (&segs)[NSEG]) {
    const int gw = C.blk * NWAVES + C.wave, NGW = C.G * NWAVES, sub = C.lane & 7;
    const f32x2* ROPE = (const f32x2*)(C.ws + WS_ROPE);
    for (int row = gw; row < T; row += NGW) {
        const int t = row % SEQ;
#pragma unroll
        for (int sg = 0; sg < NSEG; ++sg) {
            for (int v0 = 0; v0 < segs[sg].nvec; v0 += 8) {
                const int vec = v0 + (C.lane >> 3); const bool act = vec < segs[sg].nvec; const int vv = act ? vec : 0;
                bf16* p = QKV + (size_t)row * ldq + segs[sg].col0 + vv * 64 + sub * 8;
                const v4u w = *(const v4u*)p;
                float x[8] = {bflo(w.x), bfhi(w.x), bflo(w.y), bfhi(w.y), bflo(w.z), bfhi(w.z), bflo(w.w), bfhi(w.w)};
                float ss = 0.f;
#pragma unroll
                for (int e = 0; e < 8; ++e) ss += x[e] * x[e];
                ss += __shfl_xor(ss, 1); ss += __shfl_xor(ss, 2); ss += __shfl_xor(ss, 4);
                const float r = 1.0f / sqrtf(ss * (1.0f / 64.0f) + EPS);
                const f32x4 g0 = *(const f32x4*)(segs[sg].gain + sub * 8), g1 = *(const f32x4*)(segs[sg].gain + sub * 8 + 4);
                const float gg[8] = {g0.x, g0.y, g0.z, g0.w, g1.x, g1.y, g1.z, g1.w};
#pragma unroll
                for (int e = 0; e < 8; ++e) x[e] = x[e] * r * gg[e];
                if (segs[sg].rope) {
#pragma unroll
                    for (int e = 0; e < 8; ++e) { const float pr = __shfl_xor(x[e], 4); const f32x2 cs = ROPE[t * 32 + (sub & 3) * 8 + e];
                        x[e] = (sub < 4) ? (x[e] * cs.x - pr * cs.y) : (pr * cs.y + x[e] * cs.x); }
                }
                const float sc = segs[sg].scale;
                v4u o; o.x = pk2(x[0] * sc, x[1] * sc); o.y = pk2(x[2] * sc, x[3] * sc); o.z = pk2(x[4] * sc, x[5] * sc); o.w = pk2(x[6] * sc, x[7] * sc);
                if (act) *(v4u*)p = o;
            }
        }
    }
}
DI float log_sigmoid(float x) { return (x < 0.f) ? (x - log1pf(expf(x))) : (-log1pf(expf(-x))); }
DI void fox_scan(Ctx& C) {
    const int gw = C.blk * NWAVES + C.wave, NGW = C.G * NWAVES;
    const float* FLOG = (const float*)(C.ws + WS_FLOG); float* CUM = (float*)(C.ws + WS_CUM);
    for (int task = gw; task < BATCH * 16; task += NGW) {
        const int b = task / 16, h = task % 16; const float bf = inp(C, I_FOX_BF)[h];
        const float* src = FLOG + ((size_t)b * SEQ + 64 * C.lane) * 16 + h;
        float run = 0.f;
        for (int i = 0; i < 64; ++i) run += log_sigmoid(src[(size_t)i * 16] + bf);
        float inc = run;
#pragma unroll
        for (int o = 1; o < 64; o <<= 1) { const float v = __shfl_up(inc, o); if (C.lane >= o) inc += v; }
        float acc = inc - run;
        float* dst = CUM + ((size_t)b * 16 + h) * SEQ + 64 * C.lane;
        for (int i = 0; i < 64; ++i) { acc += log_sigmoid(src[(size_t)i * 16] + bf); dst[i] = acc * LOG2E; }
    }
}
template <class AllowF, class BiasF>
DI void nattn(const bf16* qptr, const bf16* kbase, size_t kstride, const bf16* vbase, size_t vstride, int klo, int khi, AllowF allow, BiasF bias, float (&o)[64], float& m, float& l) {
    unsigned q[32];
#pragma unroll
    for (int c = 0; c < 8; ++c) { const v4u w = *(const v4u*)(qptr + 8 * c); q[4 * c] = w.x; q[4 * c + 1] = w.y; q[4 * c + 2] = w.z; q[4 * c + 3] = w.w; }
    m = -1e30f; l = 0.f;
#pragma unroll
    for (int d = 0; d < 64; ++d) o[d] = 0.f;
    for (int kk = klo; kk < khi; ++kk) {
        const bool ok = allow(kk);
        if (!__any(ok)) continue;
        const v4u* kp = (const v4u*)(kbase + (size_t)kk * kstride);
        float s = 0.f;
#pragma unroll
        for (int c = 0; c < 8; ++c) { const v4u w = kp[c];
            s += bflo(q[4 * c]) * bflo(w.x) + bfhi(q[4 * c]) * bfhi(w.x) + bflo(q[4 * c + 1]) * bflo(w.y) + bfhi(q[4 * c + 1]) * bfhi(w.y) + bflo(q[4 * c + 2]) * bflo(w.z) + bfhi(q[4 * c + 2]) * bfhi(w.z) + bflo(q[4 * c + 3]) * bflo(w.w) + bfhi(q[4 * c + 3]) * bfhi(w.w); }
        s += bias(kk);
        if (ok) {
            const float mn = fmaxf(m, s), a = exp2f(m - mn), p = exp2f(s - mn);
            l = l * a + p; m = mn;
            const v4u* vp = (const v4u*)(vbase + (size_t)kk * vstride);
#pragma unroll
            for (int c = 0; c < 8; ++c) { const v4u w = vp[c];
                o[8 * c] = o[8 * c] * a + p * bflo(w.x); o[8 * c + 1] = o[8 * c + 1] * a + p * bfhi(w.x); o[8 * c + 2] = o[8 * c + 2] * a + p * bflo(w.y); o[8 * c + 3] = o[8 * c + 3] * a + p * bfhi(w.y);
                o[8 * c + 4] = o[8 * c + 4] * a + p * bflo(w.z); o[8 * c + 5] = o[8 * c + 5] * a + p * bfhi(w.z); o[8 * c + 6] = o[8 * c + 6] * a + p * bflo(w.w); o[8 * c + 7] = o[8 * c + 7] * a + p * bfhi(w.w); }
        }
    }
}
DI void st_o64(bf16* p, const float (&o)[64], float sc) {
#pragma unroll
    for (int c = 0; c < 8; ++c) { v4u w; w.x = pk2(o[8 * c] * sc, o[8 * c + 1] * sc); w.y = pk2(o[8 * c + 2] * sc, o[8 * c + 3] * sc); w.z = pk2(o[8 * c + 4] * sc, o[8 * c + 5] * sc); w.w = pk2(o[8 * c + 6] * sc, o[8 * c + 7] * sc); *(v4u*)(p + 8 * c) = w; }
}
DI void attn_fox_naive(Ctx& C) {
    const int gw = C.blk * NWAVES + C.wave, NGW = C.G * NWAVES;
    const bf16* QKV = (const bf16*)(C.ws + WS_R1); bf16* O = (bf16*)(C.ws + WS_UO); const float* CUM = (const float*)(C.ws + WS_CUM);
    for (int task = gw; task < BATCH * 16 * 64; task += NGW) {
        const int chunk = task / 128, bh = task % 128, b = bh / 16, h = bh % 16, t = chunk * 64 + C.lane; const size_t row = (size_t)b * SEQ + t;
        const float* cum = CUM + (size_t)bh * SEQ; const float cq = cum[t];
        float o[64], m, l;
        nattn(QKV + row * 3072 + h * 64, QKV + (size_t)b * SEQ * 3072 + 1024 + h * 64, 3072, QKV + (size_t)b * SEQ * 3072 + 2048 + h * 64, 3072, 0, chunk * 64 + 64,
              [&](int kk) { return kk <= t; }, [&](int kk) { return cq - cum[kk]; }, o, m, l);
        st_o64(O + row * DM + h * 64, o, 1.0f / l);
    }
}
DI void attn_diff_naive(Ctx& C) {
    const int gw = C.blk * NWAVES + C.wave, NGW = C.G * NWAVES;
    const bf16* QKV = (const bf16*)(C.ws + WS_R1);
    for (int task = gw; task < BATCH * 16 * 64 * 2; task += NGW) {
        const int half = task & 1, t2 = task >> 1, chunk = t2 / 128, bh = t2 % 128, b = bh / 16, hh = bh % 16, t = chunk * 64 + C.lane; const size_t row = (size_t)b * SEQ + t;
        bf16* O = (bf16*)(C.ws + ((hh & 1) ? WS_O2 : WS_UO));
        float o[64], m, l;
        nattn(QKV + row * 3072 + hh * 64, QKV + (size_t)b * SEQ * 3072 + 1024 + hh * 64, 3072, QKV + (size_t)b * SEQ * 3072 + 2048 + (hh >> 1) * 128 + half * 64, 3072, 0, chunk * 64 + 64,
              [&](int kk) { return kk <= t; }, [&](int) { return 0.f; }, o, m, l);
        st_o64(O + row * DM + (hh >> 1) * 128 + half * 64, o, 1.0f / l);
    }
}
DI void diff_combine(Ctx& C) {
    const int gw = C.blk * NWAVES + C.wave, NGW = C.G * NWAVES;
    const float lam_init = 0.8f - 0.6f * expf(-0.3f * 3.0f);
    const float* lm = inp(C, I_DIFF_LAM);
    const float s01 = wave_sum(lm[C.lane] * lm[64 + C.lane]), s23 = wave_sum(lm[128 + C.lane] * lm[192 + C.lane]);
    const float lam = expf(s01) - expf(s23) + lam_init;
    bf16* O0 = (bf16*)(C.ws + WS_UO); const bf16* O1 = (const bf16*)(C.ws + WS_O2);
    for (int row = gw; row < T; row += NGW) {
        f32x4 a[4], bq[4]; ld_row_bf16(O0 + (size_t)row * DM, C.lane, a); ld_row_bf16(O1 + (size_t)row * DM, C.lane, bq);
#pragma unroll
        for (int j = 0; j < 4; ++j) { f32x4 d = a[j] - bq[j] * lam; float ss = (d.x * d.x + d.y * d.y) + (d.z * d.z + d.w * d.w);
            ss += __shfl_xor(ss, 1); ss += __shfl_xor(ss, 2); ss += __shfl_xor(ss, 4); ss += __shfl_xor(ss, 8); ss += __shfl_xor(ss, 16);
            const float r = (1.0f - lam_init) / sqrtf(ss * (1.0f / 128.0f) + EPS);
            const f32x4 g = *(const f32x4*)(inp(C, I_DIFF_SG) + ((4 * C.lane) & 127)); a[j] = d * r * g; }
        st_row_bf16(O0 + (size_t)row * DM, C.lane, a);
    }
}
DI void attn_dil_naive(Ctx& C, int gi, int dil) {
    const int gw = C.blk * NWAVES + C.wave, NGW = C.G * NWAVES;
    const bf16* QKV = (const bf16*)(C.ws + WS_R1); bf16* O = (bf16*)(C.ws + WS_O2); float* LSE = (float*)(C.ws + WS_LSE);
    const int sublen = SEQ / dil, nchunk = sublen / 64;
    for (int task = gw; task < BATCH * 16 * 64; task += NGW) {
        const int bh = task % 128, w = task / 128, b = bh / 16, h = bh % 16, r = w / nchunk, chunk = w % nchunk, u = chunk * 64 + C.lane;
        const size_t row = (size_t)b * SEQ + (size_t)u * dil + r; const size_t row0 = (size_t)b * SEQ + r;
        float o[64], m, l;
        const int klo = (chunk * 64 - 128) > 0 ? (chunk * 64 - 128) : 0;
        nattn(QKV + row * 3072 + h * 64, QKV + row0 * 3072 + 1024 + h * 64, (size_t)dil * 3072, QKV + row0 * 3072 + 2048 + h * 64, (size_t)dil * 3072, klo, chunk * 64 + 64,
              [&](int kk) { return kk <= u && u - kk <= 128; }, [&](int) { return 0.f; }, o, m, l);
        const float inv = 1.0f / l; float lse = m + log2f(l);
        bf16* op = O + row * DM + h * 64;
        if (gi == 0) { st_o64(op, o, inv); LSE[row * 16 + h] = lse; }
        else {
            const float lo = LSE[row * 16 + h], mx = fmaxf(lo, lse), ea = exp2f(lo - mx), eb = exp2f(lse - mx), rs = 1.0f / (ea + eb), fa = ea * rs, fb = eb * rs * inv;
#pragma unroll
            for (int c = 0; c < 8; ++c) { const v4u w = *(const v4u*)(op + 8 * c);
                o[8 * c] = bflo(w.x) * fa + o[8 * c] * fb; o[8 * c + 1] = bfhi(w.x) * fa + o[8 * c + 1] * fb; o[8 * c + 2] = bflo(w.y) * fa + o[8 * c + 2] * fb; o[8 * c + 3] = bfhi(w.y) * fa + o[8 * c + 3] * fb;
                o[8 * c + 4] = bflo(w.z) * fa + o[8 * c + 4] * fb; o[8 * c + 5] = bfhi(w.z) * fa + o[8 * c + 5] * fb; o[8 * c + 6] = bflo(w.w) * fa + o[8 * c + 6] * fb; o[8 * c + 7] = bfhi(w.w) * fa + o[8 * c + 7] * fb; }
            st_o64(op, o, 1.0f); LSE[row * 16 + h] = mx + log2f(ea + eb);
        }
    }
}
constexpr int NSA_LDQ = 2560;
DI void nsa_compress(Ctx& C) {
    const bf16* QKV = (const bf16*)(C.ws + WS_R1); const f32x2* ROPE = (const f32x2*)(C.ws + WS_ROPE);
    LAS float* vec = (LAS float*)C.lds;
    LAS float* part = (LAS float*)(C.lds + 65536);
    LAS float* hid = (LAS float*)(C.lds + 65536 + 8192);
    float* KC = (float*)(C.ws + WS_KC); float* VC = (float*)(C.ws + WS_VC);
    for (int task = C.blk; task < 1024; task += C.G) {
        const int which = task / 512, r = task % 512, b = r / 64, g = (r / 16) % 4, n0 = (r % 16) * 4;
        const int col = (which == 0 ? 1024 : 1280) + g * 64;
        const float* pos = inp(C, I_NSA_POS) + which * 4096;
        for (int idx = C.tid; idx < 16384; idx += NTHR) { const int tsk = idx >> 12, rem = idx & 4095, l = rem >> 6, d = rem & 63;
            const unsigned short raw = QKV[((size_t)b * SEQ + (n0 + tsk) * 64 + l) * NSA_LDQ + col + d];
            vec[idx] = __builtin_bit_cast(float, (unsigned)raw << 16) + pos[rem]; }
        __syncthreads();
        { const int j = C.tid & 127, pt = C.tid >> 7; float a0 = 0.f, a1 = 0.f, a2 = 0.f, a3 = 0.f;
          const float* w1 = inp(C, I_NSA_W1) + ((size_t)which * 4096 + pt * 1024) * 128 + j; const LAS float* vv = vec + pt * 1024;
#pragma unroll 8
          for (int k = 0; k < 1024; ++k) { const float w = w1[(size_t)k * 128]; a0 += vv[k] * w; a1 += vv[4096 + k] * w; a2 += vv[8192 + k] * w; a3 += vv[12288 + k] * w; }
          part[(pt * 4 + 0) * 128 + j] = a0; part[(pt * 4 + 1) * 128 + j] = a1; part[(pt * 4 + 2) * 128 + j] = a2; part[(pt * 4 + 3) * 128 + j] = a3; }
        __syncthreads();
        { const int tsk = C.tid >> 7, j = C.tid & 127; const float s = (part[(0 * 4 + tsk) * 128 + j] + part[(1 * 4 + tsk) * 128 + j]) + (part[(2 * 4 + tsk) * 128 + j] + part[(3 * 4 + tsk) * 128 + j]);
          hid[tsk * 128 + j] = s / (1.0f + expf(-s)); }
        __syncthreads();
        if (C.tid < 256) { const int tsk = C.tid >> 6, d = C.tid & 63; float o = 0.f;
            const float* w2 = inp(C, I_NSA_W2) + (size_t)which * 128 * 64 + d;
#pragma unroll 8
            for (int j = 0; j < 128; ++j) o += hid[tsk * 128 + j] * w2[j * 64];
            const size_t oi = (((size_t)b * 4 + g) * 64 + n0 + tsk) * 64 + d;
            if (which == 1) VC[oi] = o;
            else { const float ss = wave_sum(o * o); float y = o / sqrtf(ss * (1.0f / 64.0f) + EPS) * inp(C, I_NSA_KG)[d];
                const float pr = __shfl_xor(y, 32); const f32x2 cs = ROPE[((n0 + tsk) * 64 + 63) * 32 + (d & 31)];
                KC[oi] = (d < 32) ? (y * cs.x - pr * cs.y) : (pr * cs.y + y * cs.x); } }
        __syncthreads();
    }
}
DI float rdl(float v, int l) { return __builtin_bit_cast(float, __builtin_amdgcn_readlane(__builtin_bit_cast(int, v), l)); }
DI void nsa_cmp_select(Ctx& C) {
    const bf16* QKV = (const bf16*)(C.ws + WS_R1); bf16* OC = (bf16*)(C.ws + WS_O2); const float* GATE = (const float*)(C.ws + WS_GATE);
    const float* KC = (const float*)(C.ws + WS_KC); const float* VC = (const float*)(C.ws + WS_VC); unsigned long long* SELM = (unsigned long long*)(C.ws + WS_SELM);
    LAS float* kcT = (LAS float*)C.lds;
    LAS float* vcl = (LAS float*)(C.lds + 16384);
    for (int task = C.blk; task < BATCH * 4 * 8; task += C.G) {
        const int b = task / 32, g = (task / 8) % 4, cur = (task % 8) * 8 + C.wave;
        __syncthreads();
        for (int idx = C.tid; idx < 4096; idx += NTHR) { const int j = idx >> 6, d = idx & 63; kcT[d * 64 + j] = KC[((size_t)b * 4 + g) * 4096 + idx]; vcl[idx] = VC[((size_t)b * 4 + g) * 4096 + idx]; }
        __syncthreads();
        for (int tt = 0; tt < 64; ++tt) {
            const int t = cur * 64 + tt; const size_t row = (size_t)b * SEQ + t; const int nvalid = cur + (tt == 63 ? 1 : 0);
            const bool valid = C.lane < nvalid;
            float imp = 0.f;
#pragma unroll 1
            for (int p = 0; p < 4; ++p) {
                const int head = g * 4 + p;
                const float qv = __builtin_bit_cast(float, (unsigned)QKV[row * NSA_LDQ + head * 64 + C.lane] << 16);
                float s = 0.f;
#pragma unroll 8
                for (int d = 0; d < 64; ++d) s += rdl(qv, d) * kcT[d * 64 + C.lane];
                const float mx = wave_max(valid ? s : -1e30f); const float e = valid ? exp2f(s - mx) : 0.f;
                const float den = fmaxf(wave_sum(e), 1e-30f); const float pj = e / den;
                imp += pj;
                float o = 0.f;
#pragma unroll 8
                for (int j = 0; j < 64; ++j) o += rdl(pj, j) * vcl[j * 64 + C.lane];
                const float g0 = 1.0f / (1.0f + expf(-GATE[row * 48 + head]));
                OC[row * DM + head * 64 + C.lane] = (bf16)f2bf(g0 * o);
            }
            const float v = (C.lane > cur) ? -1.0f : ((C.lane == 0 || C.lane == cur || C.lane == cur - 1) ? 5.0f : imp);
            int rank = 0;
#pragma unroll 8
            for (int j = 0; j < 64; ++j) { const float vj = rdl(v, j); rank += (vj > v || (vj == v && j < C.lane)) ? 1 : 0; }
            unsigned long long mask = __ballot(rank < 16);
            if (cur < 63) mask &= ((2ull << cur) - 1ull);
            if (C.lane == 0) SELM[((size_t)b * 4 + g) * SEQ + t] = mask;
        }
    }
    __syncthreads();
}
DI void attn_nsa_naive(Ctx& C) {
    const int gw = C.blk * NWAVES + C.wave, NGW = C.G * NWAVES;
    const bf16* QKV = (const bf16*)(C.ws + WS_R1); bf16* O = (bf16*)(C.ws + WS_UO); const bf16* OC = (const bf16*)(C.ws + WS_O2); const float* GATE = (const float*)(C.ws + WS_GATE);
    const unsigned long long* SELM = (const unsigned long long*)(C.ws + WS_SELM);
    for (int task = gw; task < BATCH * 16 * 64; task += NGW) {
        const int chunk = task / 128, bh = task % 128, b = bh / 16, head = bh % 16, g = head >> 2, t = chunk * 64 + C.lane; const size_t row = (size_t)b * SEQ + t;
        const size_t kb = (size_t)b * SEQ * NSA_LDQ;
        const unsigned long long mask = SELM[((size_t)b * 4 + g) * SEQ + t];
        float o[64], m, l;
        nattn(QKV + row * NSA_LDQ + head * 64, QKV + kb + 1536 + g * 64, NSA_LDQ, QKV + kb + 1792 + g * 64, NSA_LDQ, 0, chunk * 64 + 64,
              [&](int kk) { return ((mask >> (kk >> 6)) & 1ull) != 0ull && kk <= t; }, [&](int) { return 0.f; }, o, m, l);
        { const float g1 = 1.0f / (1.0f + expf(-GATE[row * 48 + 16 + head])) / l; const bf16* ocp = OC + row * DM + head * 64; bf16* op = O + row * DM + head * 64;
#pragma unroll
          for (int c = 0; c < 8; ++c) { const v4u w = *(const v4u*)(ocp + 8 * c); v4u r;
              r.x = pk2(bflo(w.x) + g1 * o[8 * c], bfhi(w.x) + g1 * o[8 * c + 1]); r.y = pk2(bflo(w.y) + g1 * o[8 * c + 2], bfhi(w.y) + g1 * o[8 * c + 3]);
              r.z = pk2(bflo(w.z) + g1 * o[8 * c + 4], bfhi(w.z) + g1 * o[8 * c + 5]); r.w = pk2(bflo(w.w) + g1 * o[8 * c + 6], bfhi(w.w) + g1 * o[8 * c + 7]); *(v4u*)(op + 8 * c) = r; } }
    }
    asm volatile("s_waitcnt vmcnt(0)" ::: "memory");
    for (int task = gw; task < BATCH * 16 * 64; task += NGW) {
        const int chunk = task / 128, bh = task % 128, b = bh / 16, head = bh % 16, g = head >> 2, t = chunk * 64 + C.lane; const size_t row = (size_t)b * SEQ + t;
        const size_t kb = (size_t)b * SEQ * NSA_LDQ;
        float o[64], m, l;
        const int klo = (chunk * 64 - 511) > 0 ? (chunk * 64 - 511) : 0;
        nattn(QKV + row * NSA_LDQ + head * 64, QKV + kb + 2048 + g * 64, NSA_LDQ, QKV + kb + 2304 + g * 64, NSA_LDQ, klo, chunk * 64 + 64,
              [&](int kk) { return kk <= t && t - kk < 512; }, [&](int) { return 0.f; }, o, m, l);
        { const float g2 = 1.0f / (1.0f + expf(-GATE[row * 48 + 32 + head])) / l; bf16* op = O + row * DM + head * 64;
#pragma unroll
          for (int c = 0; c < 8; ++c) { const v4u p = *(const v4u*)(op + 8 * c); v4u w;
              w.x = pk2(bflo(p.x) + g2 * o[8 * c], bfhi(p.x) + g2 * o[8 * c + 1]); w.y = pk2(bflo(p.y) + g2 * o[8 * c + 2], bfhi(p.y) + g2 * o[8 * c + 3]);
              w.z = pk2(bflo(p.z) + g2 * o[8 * c + 4], bfhi(p.z) + g2 * o[8 * c + 5]); w.w = pk2(bflo(p.w) + g2 * o[8 * c + 6], bfhi(p.w) + g2 * o[8 * c + 7]);
              *(v4u*)(op + 8 * c) = w; } }
    }
}
typedef short bf16x8 __attribute__((ext_vector_type(8)));
typedef short s16x4 __attribute__((ext_vector_type(4)));
typedef float f32x16 __attribute__((ext_vector_type(16)));
typedef __bf16 bf16x2_t __attribute__((ext_vector_type(2)));
namespace fa {
DI int crow(int i, int h) { return (i & 3) + 8 * (i >> 2) + 4 * h; }
DI void glds16(const void* gsrc, unsigned lds_dst) { unsigned keep;
    asm volatile("s_mov_b32 %0, m0\n\ts_mov_b32 m0, %2\n\ts_nop 0\n\tglobal_load_lds_dwordx4 %1, off\n\ts_mov_b32 m0, %0" : "=&s"(keep) : "v"(gsrc), "s"(lds_dst) : "memory"); }
#define FA_WAIT_BAR(N) asm volatile("s_waitcnt vmcnt(" #N ") lgkmcnt(0)\n\ts_barrier" ::: "memory")
DI unsigned cvtpk(float lo, float hi) { f32x2 v = {lo, hi}; bf16x2_t b = __builtin_convertvector(v, bf16x2_t); return __builtin_bit_cast(unsigned, b); }
DI float xmax32(float v) { float a = v, b = v; asm volatile("s_nop 1\n\tv_permlane32_swap_b32 %0, %1\n\ts_nop 1" : "+v"(a), "+v"(b)); return fmaxf(a, b); }
DI float xsum32(float v) { float a = v, b = v; asm volatile("s_nop 1\n\tv_permlane32_swap_b32 %0, %1\n\ts_nop 1" : "+v"(a), "+v"(b)); return a + b; }
typedef short v4i16_t __attribute__((ext_vector_type(4)));
DI s16x4 vtr(LAS const char* p) { return __builtin_bit_cast(s16x4, __builtin_amdgcn_ds_read_tr16_b64_v4i16((LAS v4i16_t*)p)); }
constexpr int KSLOT = 8192, KRING = 3 * KSLOT;
template <int DV, class Pre>
DI void tile(LAS const char* ks, LAS const char* vs, const bf16x8 (&qf)[4], int lane, Pre pre, f32x16 (&o)[DV / 32], float& m, float& l) {
    const int r = lane & 31, h = lane >> 5;
    f32x16 p0, p1;
#pragma unroll
    for (int i = 0; i < 16; ++i) { p0[i] = 0.f; p1[i] = 0.f; }
    LAS const char* kb = ks + h * 1024 + r * 16;
#pragma unroll
    for (int d0 = 0; d0 < 4; ++d0) {
        const bf16x8 a0 = *(LAS const bf16x8*)(kb + d0 * 2048), a1 = *(LAS const bf16x8*)(kb + d0 * 2048 + 512);
        p0 = __builtin_amdgcn_mfma_f32_32x32x16_bf16(a0, qf[d0], p0, 0, 0, 0);
        p1 = __builtin_amdgcn_mfma_f32_32x32x16_bf16(a1, qf[d0], p1, 0, 0, 0);
    }
    pre(p0, p1);
    float mx = fmaxf(p0[0], p1[0]);
#pragma unroll
    for (int i = 1; i < 16; ++i) mx = fmaxf(mx, fmaxf(p0[i], p1[i]));
    mx = xmax32(mx);
    const float mn = fmaxf(m, mx);
    if (__any(mn > m)) { const float a = __builtin_amdgcn_exp2f(m - mn); l *= a;
#pragma unroll
        for (int b = 0; b < DV / 32; ++b)
#pragma unroll
            for (int i = 0; i < 16; ++i) o[b][i] *= a; }
    m = mn;
    float sum = 0.f;
#pragma unroll
    for (int i = 0; i < 16; ++i) { p0[i] = __builtin_amdgcn_exp2f(p0[i] - mn); p1[i] = __builtin_amdgcn_exp2f(p1[i] - mn); sum += p0[i] + p1[i]; }
    l += sum;
    bf16x8 pf[4];
#pragma unroll
    for (int s = 0; s < 2; ++s) {
        v4u w0, w1;
        w0.x = cvtpk(p0[8 * s], p0[8 * s + 1]); w0.y = cvtpk(p0[8 * s + 2], p0[8 * s + 3]); w0.z = cvtpk(p0[8 * s + 4], p0[8 * s + 5]); w0.w = cvtpk(p0[8 * s + 6], p0[8 * s + 7]);
        w1.x = cvtpk(p1[8 * s], p1[8 * s + 1]); w1.y = cvtpk(p1[8 * s + 2], p1[8 * s + 3]); w1.z = cvtpk(p1[8 * s + 4], p1[8 * s + 5]); w1.w = cvtpk(p1[8 * s + 6], p1[8 * s + 7]);
        pf[s] = __builtin_bit_cast(bf16x8, w0); pf[2 + s] = __builtin_bit_cast(bf16x8, w1);
    }
    LAS const char* vb = vs + ((lane >> 4) & 1) * 32 + (lane & 3) * 8 + (4 * h + ((lane & 15) >> 2)) * 64;
#pragma unroll
    for (int b = 0; b < DV / 32; ++b)
#pragma unroll
        for (int kq = 0; kq < 4; ++kq) {
            const s16x4 lo = vtr(vb + (b * 4 + kq) * 1024), hi = vtr(vb + (b * 4 + kq) * 1024 + 512);
            const bf16x8 vf = {lo[0], lo[1], lo[2], lo[3], hi[0], hi[1], hi[2], hi[3]};
            o[b] = __builtin_amdgcn_mfma_f32_32x32x16_bf16(vf, pf[kq], o[b], 0, 0, 0);
        }
}
template <int DV, class KP, class VP, class Act, class Pre>
DI void loop(LAS char* shm, int wid, int lane, const bf16x8 (&qf)[4], int ntiles, KP kp, VP vp, Act act, Pre pre, f32x16 (&o)[DV / 32], float& m, float& l) {
    constexpr int VSLOT = DV * 128;
    const unsigned ldsK = (unsigned)(size_t)shm, ldsV = ldsK + KRING;
#define FA_ISSUE(i, s) do { glds16(kp(i), (unsigned)__builtin_amdgcn_readfirstlane(ldsK + (s) * KSLOT + wid * 1024)); \
        _Pragma("unroll") for (int pc_ = 0; pc_ < DV / 64; ++pc_) glds16(vp((i), wid + 8 * pc_), (unsigned)__builtin_amdgcn_readfirstlane(ldsV + (s) * VSLOT + (wid + 8 * pc_) * 1024)); } while (0)
    if (ntiles > 0) FA_ISSUE(0, 0);
    if (ntiles > 1) FA_ISSUE(1, 1);
    int sc = 0, sn2 = 2;
    for (int i = 0; i < ntiles; ++i) {
        if (i + 1 < ntiles) { if (DV == 64) FA_WAIT_BAR(2); else FA_WAIT_BAR(3); } else FA_WAIT_BAR(0);
        if (i + 2 < ntiles) FA_ISSUE(i + 2, sn2);
        if (act(i)) tile<DV>((LAS const char*)shm + sc * KSLOT, (LAS const char*)shm + KRING + sc * VSLOT, qf, lane, [&](f32x16& p0, f32x16& p1) { pre(i, p0, p1); }, o, m, l);
        sc = (sc == 2) ? 0 : sc + 1; sn2 = (sn2 == 2) ? 0 : sn2 + 1;
    }
    FA_WAIT_BAR(0);
#undef FA_ISSUE
}
template <int DV>
DI void store_o(bf16* orow, int h, const f32x16 (&o)[DV / 32], float sc) {
#pragma unroll
    for (int b = 0; b < DV / 32; ++b)
#pragma unroll
        for (int g4 = 0; g4 < 4; ++g4) { v2u w; w.x = cvtpk(o[b][4 * g4] * sc, o[b][4 * g4 + 1] * sc); w.y = cvtpk(o[b][4 * g4 + 2] * sc, o[b][4 * g4 + 3] * sc);
            *(v2u*)(orow + 32 * b + 8 * g4 + 4 * h) = w; }
}
}
constexpr int FA_CUM_OFF = 98304;
DI void attn_fox_fast(Ctx& C) {
    const int vblk = (C.blk % 8) * (C.G / 8) + C.blk / 8;
    const bf16* QKV = (const bf16*)(C.ws + WS_R1); bf16* O = (bf16*)(C.ws + WS_UO); const float* CUM = (const float*)(C.ws + WS_CUM);
    const int lane = C.lane, wid = C.wave, r = lane & 31, h2 = lane >> 5;
    LAS float* cumL = (LAS float*)(C.lds + FA_CUM_OFF);
    const int nunits = BATCH * 16 * 16, per = (nunits + C.G - 1) / C.G;
    for (int ui = 0; ui < per; ++ui) {
        const int u = vblk * per + ui; if (u >= nunits) break;
        const int bh = u / 16, k16 = u % 16, pair = k16 >> 1, qblk = (k16 & 1) ? (15 - pair) : pair;
        const int b = bh / 16, hd = bh % 16;
        const float* cum = CUM + (size_t)bh * SEQ;
        const int nt = 4 * qblk + 4;
        for (int i = C.tid; i < nt * 16; i += NTHR) *(LAS f32x4*)(cumL + 4 * i) = *(const f32x4*)(cum + 4 * i);
        const int tq = 256 * qblk + 32 * wid + r; const size_t row = (size_t)b * SEQ + tq;
        bf16x8 qf[4];
#pragma unroll
        for (int d0 = 0; d0 < 4; ++d0) qf[d0] = *(const bf16x8*)(QKV + row * 3072 + hd * 64 + d0 * 16 + h2 * 8);
        const float cq = cum[tq];
        const bf16* kbase = QKV + (size_t)b * SEQ * 3072 + 1024 + hd * 64 + (size_t)lane * 3072 + wid * 8;
        const bf16* vbase = QKV + (size_t)b * SEQ * 3072 + 2048 + hd * 64 + (size_t)(16 * (wid & 3) + (lane >> 2)) * 3072 + (wid >> 2) * 32 + (lane & 3) * 8;
        const int jdiag = 4 * qblk + (wid >> 1), qloc = 32 * (wid & 1) + r;
        f32x16 o[2]; float m = -1e30f, l = 0.f;
#pragma unroll
        for (int i = 0; i < 16; ++i) { o[0][i] = 0.f; o[1][i] = 0.f; }
        asm volatile("s_waitcnt lgkmcnt(0)" ::: "memory"); __builtin_amdgcn_s_barrier();
        fa::loop<64>((LAS char*)C.lds, wid, lane, qf, nt,
            [&](int i) { return kbase + (size_t)(nt - 1 - i) * 64 * 3072; },
            [&](int i, int) { return vbase + (size_t)(nt - 1 - i) * 64 * 3072; },
            [&](int i) { return (nt - 1 - i) <= jdiag; },
            [&](int i, f32x16& p0, f32x16& p1) { const int j = nt - 1 - i; const LAS float* cl = cumL + 64 * j + 4 * h2;
#pragma unroll
                for (int g4 = 0; g4 < 4; ++g4) { const f32x4 c0 = *(const LAS f32x4*)(cl + 8 * g4), c1 = *(const LAS f32x4*)(cl + 32 + 8 * g4);
                    p0[4 * g4] += cq - c0.x; p0[4 * g4 + 1] += cq - c0.y; p0[4 * g4 + 2] += cq - c0.z; p0[4 * g4 + 3] += cq - c0.w;
                    p1[4 * g4] += cq - c1.x; p1[4 * g4 + 1] += cq - c1.y; p1[4 * g4 + 2] += cq - c1.z; p1[4 * g4 + 3] += cq - c1.w; }
                if (j == jdiag) {
#pragma unroll
                    for (int ii = 0; ii < 16; ++ii) { const int kv = fa::crow(ii, h2); if (kv > qloc) p0[ii] = -INFINITY; if (kv + 32 > qloc) p1[ii] = -INFINITY; } } },
            o, m, l);
        l = fa::xsum32(l);
        fa::store_o<64>(O + row * DM + hd * 64, h2, o, 1.0f / l);
    }
}
DI void attn_diff_fast(Ctx& C) {
    const int vblk = (C.blk % 8) * (C.G / 8) + C.blk / 8;
    const bf16* QKV = (const bf16*)(C.ws + WS_R1);
    const int lane = C.lane, wid = C.wave, r = lane & 31, h2 = lane >> 5;
    const int nunits = BATCH * 16 * 16, per = (nunits + C.G - 1) / C.G;
    for (int ui = 0; ui < per; ++ui) {
        const int u = vblk * per + ui; if (u >= nunits) break;
        const int bh = u / 16, k16 = u % 16, pair = k16 >> 1, qblk = (k16 & 1) ? (15 - pair) : pair;
        const int b = bh / 16, hh = bh % 16;
        bf16* O = (bf16*)(C.ws + ((hh & 1) ? WS_O2 : WS_UO));
        const int nt = 4 * qblk + 4;
        const int tq = 256 * qblk + 32 * wid + r; const size_t row = (size_t)b * SEQ + tq;
        bf16x8 qf[4];
#pragma unroll
        for (int d0 = 0; d0 < 4; ++d0) qf[d0] = *(const bf16x8*)(QKV + row * 3072 + hh * 64 + d0 * 16 + h2 * 8);
        const bf16* kbase = QKV + (size_t)b * SEQ * 3072 + 1024 + hh * 64 + (size_t)lane * 3072 + wid * 8;
        const bf16* vbase = QKV + (size_t)b * SEQ * 3072 + 2048 + (hh >> 1) * 128 + (size_t)(16 * (wid & 3) + (lane >> 2)) * 3072 + (wid >> 2) * 32 + (lane & 3) * 8;
        const int jdiag = 4 * qblk + (wid >> 1), qloc = 32 * (wid & 1) + r;
        f32x16 o[4]; float m = -1e30f, l = 0.f;
#pragma unroll
        for (int bq = 0; bq < 4; ++bq)
#pragma unroll
            for (int i = 0; i < 16; ++i) o[bq][i] = 0.f;
        fa::loop<128>((LAS char*)C.lds, wid, lane, qf, nt,
            [&](int i) { return kbase + (size_t)(nt - 1 - i) * 64 * 3072; },
            [&](int i, int pc) { return vbase + (size_t)(nt - 1 - i) * 64 * 3072 + (pc >= 8 ? 64 : 0); },
            [&](int i) { return (nt - 1 - i) <= jdiag; },
            [&](int i, f32x16& p0, f32x16& p1) { const int j = nt - 1 - i;
                if (j == jdiag) {
#pragma unroll
                    for (int ii = 0; ii < 16; ++ii) { const int kv = fa::crow(ii, h2); if (kv > qloc) p0[ii] = -INFINITY; if (kv + 32 > qloc) p1[ii] = -INFINITY; } } },
            o, m, l);
        l = fa::xsum32(l);
        fa::store_o<128>(O + row * DM + (hh >> 1) * 128, h2, o, 1.0f / l);
    }
}
DI void attn_dil_fast(Ctx& C, int gi, int dil) {
    const int vblk = (C.blk % 8) * (C.G / 8) + C.blk / 8;
    const bf16* QKV = (const bf16*)(C.ws + WS_R1); bf16* O = (bf16*)(C.ws + WS_O2); float* LSE = (float*)(C.ws + WS_LSE);
    const int lane = C.lane, wid = C.wave, r = lane & 31, h2 = lane >> 5;
    const int nub = (SEQ / dil) / 256;
    const int nunits = BATCH * 16 * 16, per = (nunits + C.G - 1) / C.G;
    for (int ui = 0; ui < per; ++ui) {
        const int u = vblk * per + ui; if (u >= nunits) break;
        const int bh = u / 16, k16 = u % 16, b = bh / 16, hd = bh % 16, res = k16 / nub, ublk = k16 % nub;
        const int uq = 256 * ublk + 32 * wid + r; const size_t row = (size_t)b * SEQ + (size_t)uq * dil + res; const size_t row0 = (size_t)b * SEQ + res;
        bf16x8 qf[4];
#pragma unroll
        for (int d0 = 0; d0 < 4; ++d0) qf[d0] = *(const bf16x8*)(QKV + row * 3072 + hd * 64 + d0 * 16 + h2 * 8);
        const size_t rs = (size_t)dil * 3072;
        const bf16* kbase = QKV + row0 * 3072 + 1024 + hd * 64 + (size_t)lane * rs + wid * 8;
        const bf16* vbase = QKV + row0 * 3072 + 2048 + hd * 64 + (size_t)(16 * (wid & 3) + (lane >> 2)) * rs + (wid >> 2) * 32 + (lane & 3) * 8;
        const int jlo = (4 * ublk - 2) > 0 ? (4 * ublk - 2) : 0, nt = 4 * ublk + 4 - jlo;
        const int jw_hi = 4 * ublk + (wid >> 1), jw_lo = jw_hi - 2;
        f32x16 o[2]; float m = -1e30f, l = 0.f;
#pragma unroll
        for (int i = 0; i < 16; ++i) { o[0][i] = 0.f; o[1][i] = 0.f; }
        fa::loop<64>((LAS char*)C.lds, wid, lane, qf, nt,
            [&](int i) { return kbase + (size_t)(jlo + i) * 64 * rs; },
            [&](int i, int) { return vbase + (size_t)(jlo + i) * 64 * rs; },
            [&](int i) { const int j = jlo + i; return j >= jw_lo && j <= jw_hi; },
            [&](int i, f32x16& p0, f32x16& p1) { const int dlt = uq - 64 * (jlo + i);
#pragma unroll
                for (int ii = 0; ii < 16; ++ii) { const int d0 = dlt - fa::crow(ii, h2), d1 = d0 - 32;
                    if (d0 < 0 || d0 > 128) p0[ii] = -INFINITY; if (d1 < 0 || d1 > 128) p1[ii] = -INFINITY; } },
            o, m, l);
        l = fa::xsum32(l);
        const float inv = 1.0f / l, lse = m + log2f(l);
        bf16* op = O + row * DM + hd * 64;
        if (gi == 0) { fa::store_o<64>(op, h2, o, inv); if (h2 == 0) LSE[row * 16 + hd] = lse; }
        else {
            const float lo = LSE[row * 16 + hd], mx = fmaxf(lo, lse), ea = __builtin_amdgcn_exp2f(lo - mx), eb = __builtin_amdgcn_exp2f(lse - mx), rs2 = 1.0f / (ea + eb), fa_ = ea * rs2, fb = eb * rs2 * inv;
#pragma unroll
            for (int bq = 0; bq < 2; ++bq)
#pragma unroll
                for (int g4 = 0; g4 < 4; ++g4) { const v2u w = *(const v2u*)(op + 32 * bq + 8 * g4 + 4 * h2);
                    o[bq][4 * g4] = bflo(w.x) * fa_ + o[bq][4 * g4] * fb; o[bq][4 * g4 + 1] = bfhi(w.x) * fa_ + o[bq][4 * g4 + 1] * fb;
                    o[bq][4 * g4 + 2] = bflo(w.y) * fa_ + o[bq][4 * g4 + 2] * fb; o[bq][4 * g4 + 3] = bfhi(w.y) * fa_ + o[bq][4 * g4 + 3] * fb; }
            asm volatile("" ::: "memory");
            fa::store_o<64>(op, h2, o, 1.0f);
            if (h2 == 0) LSE[row * 16 + hd] = mx + log2f(ea + eb);
        }
    }
}
__global__ void __launch_bounds__(NTHR, 2) hybrid_fwd(Args args) {
    extern __shared__ __attribute__((aligned(16))) unsigned char lds_raw[];
    Ctx C;
    C.hbuf = args.out; C.ws = args.ws; C.lds = (LAS unsigned char*)lds_raw;
    C.tid = threadIdx.x; C.lane = C.tid & 63; C.wave = __builtin_amdgcn_readfirstlane(C.tid >> 6); C.G = gridDim.x; C.blk = blockIdx.x;
    volatile LAS unsigned* MISC = (volatile LAS unsigned*)(C.lds + MISC_OFF);
    if (C.tid < 32) MISC[C.tid] = 0u;
    if (C.tid == 0) {
#pragma unroll
        for (int i = 0; i < N_IN; ++i) ((LAS unsigned long long*)(C.lds + PTR_OFF))[i] = (unsigned long long)args.in[i];
    }
    __syncthreads();
    const int lo = args.ph_lo, hi = args.ph_hi;
    unsigned* barw = (unsigned*)(C.ws + WS_CTL) + CW_BAR;
    XcdBarrier bar; bar.bar = barw; bar.x = 0; bar.st = nullptr;
    if (hi - lo > 1) bar = xcd_barrier_post(barw, MISC + 8);
    int ph = 0;
#ifndef DBG_ONLY
#define DBG_ONLY -1
#endif
#define PHASE(tag, ...) do { if ((DBG_ONLY < 0 || DBG_ONLY == (tag)) && lo <= ph && ph < hi) { { int t_ = threadIdx.x; asm volatile("" : "+v"(t_)); C.tid = t_; C.lane = t_ & 63; } __VA_ARGS__; if (ph + 1 < hi) xcd_barrier(bar); } ++ph; } while (0)
    bf16* const UO = (bf16*)(C.ws + WS_UO); bf16* const O2 = (bf16*)(C.ws + WS_O2); bf16* const R1 = (bf16*)(C.ws + WS_R1);
    const float* const WQ_ = nullptr; (void)WQ_;

    PHASE(0, phase_p0a(C));
    PHASE(0, phase_p0b(C));
    PHASE(1, phase_n1<0>(C));
    PHASE(2, gemm_qkv(C, UO, (const bf16*)(C.ws + WS_FOXWIN), FOX_NPAD, R1, 3072, 3072, (float*)(C.ws + WS_FLOG), 16));
    PHASE(3, { const PrepSeg segs[2] = {{0, 16, inp(C, I_FOX_QG), 0, QSC}, {1024, 16, inp(C, I_FOX_KG), 0, 1.0f}}; prep_rows<2>(C, R1, 3072, segs); fox_scan(C); });
    PHASE(4, attn_fox_fast(C));
    PHASE(2, gemm_qkv(C, UO, (const bf16*)(C.ws + WS_WOUT), DM, R1, DM, DM, nullptr, 0));
    PHASE(5, phase_n2<0>(C, R1));
    PHASE(6, phase_s(C));
    PHASE(7, gemm_moe1(C, 0));
    PHASE(8, gemm_moe2(C, 0));
    PHASE(1, phase_n1<1>(C));
    PHASE(2, gemm_qkv(C, UO, (const bf16*)(C.ws + WS_NSAWIN), NSA_NPAD, R1, NSA_LDQ, NSA_LDQ, (float*)(C.ws + WS_GATE), 48));
    PHASE(3, { const PrepSeg segs[3] = {{0, 16, inp(C, I_NSA_QG), 1, QSC}, {1536, 4, inp(C, I_NSA_KG) + 64, 1, 1.0f}, {2048, 4, inp(C, I_NSA_KG) + 128, 1, 1.0f}}; prep_rows<3>(C, R1, NSA_LDQ, segs); nsa_compress(C); });
    PHASE(9, nsa_cmp_select(C));
    PHASE(10, attn_nsa_naive(C));
    PHASE(2, gemm_qkv(C, UO, (const bf16*)(C.ws + WS_WOUT + 2 * MiB), DM, R1, DM, DM, nullptr, 0));
    PHASE(5, phase_n2<1>(C, R1));
    PHASE(6, phase_s(C));
    PHASE(7, gemm_moe1(C, 1));
    PHASE(8, gemm_moe2(C, 1));
    PHASE(1, phase_n1<2>(C));
#pragma unroll
    for (int gi = 0; gi < 3; ++gi) {
        const int dil = (gi == 0) ? 1 : (gi == 1) ? 4 : 16;
        PHASE(2, gemm_qkv(C, UO, (const bf16*)(C.ws + WS_DILWIN) + (size_t)gi * 3072 * DM, 3072, R1, 3072, 3072, nullptr, 0));
        PHASE(3, { const PrepSeg segs[2] = {{0, 16, inp(C, I_DIL_QG), 1, QSC}, {1024, 16, inp(C, I_DIL_KG), 1, 1.0f}}; prep_rows<2>(C, R1, 3072, segs); });
        PHASE(11, attn_dil_fast(C, gi, dil));
    }
    PHASE(2, gemm_qkv(C, O2, (const bf16*)(C.ws + WS_WOUT + 4 * MiB), DM, R1, DM, DM, nullptr, 0));
    PHASE(5, phase_n2<2>(C, R1));
    PHASE(6, phase_s(C));
    PHASE(7, gemm_moe1(C, 2));
    PHASE(8, gemm_moe2(C, 2));
    PHASE(1, phase_n1<3>(C));
    PHASE(2, gemm_qkv(C, UO, (const bf16*)(C.ws + WS_DIFFWIN), 3072, R1, 3072, 3072, nullptr, 0));
    PHASE(3, { const PrepSeg segs[2] = {{0, 16, inp(C, I_DIFF_QG), 1, QSC}, {1024, 16, inp(C, I_DIFF_KG), 1, 1.0f}}; prep_rows<2>(C, R1, 3072, segs); });
    PHASE(12, attn_diff_fast(C));
    PHASE(13, diff_combine(C));
    PHASE(2, gemm_qkv(C, UO, (const bf16*)(C.ws + WS_WOUT + 6 * MiB), DM, R1, DM, DM, nullptr, 0));
    PHASE(5, phase_n2<3>(C, R1));
    PHASE(6, phase_s(C));
    PHASE(7, gemm_moe1(C, 3));
    PHASE(8, gemm_moe2(C, 3));
    PHASE(1, phase_final(C));
#undef PHASE
}
constexpr int N_PHASES = 2 + 9 + 10 + 15 + 10 + 1;

#ifndef MK_PER_PHASE
#define MK_PER_PHASE 0
#endif
extern "C" void kernel_launch(void* const* d_in, const int* in_sizes, int n_in, void* d_out, int out_size, void* d_ws, size_t ws_size, hipStream_t stream) {
    static int grid = 0;
    if (grid == 0) {
        if (n_in != N_IN || out_size != T * DM || ws_size < WS_END) { fprintf(stderr, "kernel_launch: unexpected shapes (n_in %d out %d ws %zu)\n", n_in, out_size, ws_size); grid = -1; return; }
        int dev = 0, cus = 0, per_cu = 0;
        if (hipGetDevice(&dev) != hipSuccess || hipDeviceGetAttribute(&cus, hipDeviceAttributeMultiprocessorCount, dev) != hipSuccess) { grid = -1; return; }
        if (hipFuncSetAttribute((const void*)hybrid_fwd, hipFuncAttributeMaxDynamicSharedMemorySize, LDS_BYTES) != hipSuccess) { fprintf(stderr, "kernel_launch: hipFuncSetAttribute failed\n"); grid = -1; return; }
        if (hipOccupancyMaxActiveBlocksPerMultiprocessor(&per_cu, (const void*)hybrid_fwd, NTHR, LDS_BYTES) != hipSuccess || per_cu < 1) fprintf(stderr, "kernel_launch: occupancy query reports %d\n", per_cu);
        (void)hipGetLastError();
        grid = (cus >= 256) ? 256 : (cus >= 128) ? 128 : 64;
    }
    if (grid < 0) return;
    (void)hipMemsetAsync((char*)d_ws + WS_CTL, 0, CTL_ZERO_BYTES, stream);
    Args a{};
    for (int i = 0; i < N_IN; ++i) a.in[i] = (const float*)d_in[i];
    a.out = (float*)d_out; a.ws = (unsigned char*)d_ws;
#if MK_PER_PHASE
    for (int p = 0; p < N_PHASES; ++p) { a.ph_lo = p; a.ph_hi = p + 1; hipLaunchKernelGGL(hybrid_fwd, dim3(grid), dim3(NTHR), LDS_BYTES, stream, a); }
#else
    a.ph_lo = 0; a.ph_hi = N_PHASES;
    hipLaunchKernelGGL(hybrid_fwd, dim3(grid), dim3(NTHR), LDS_BYTES, stream, a);
#endif
    const hipError_t le = hipPeekAtLastError();
    if (le != hipSuccess) fprintf(stderr, "kernel_launch: launch failed: %s\n", hipGetErrorName(le));
}
```

```cpp
#include <hip/hip_runtime.h>
#include <cstdio>
#include <cstdint>
namespace pg8 {
#define PG8_LAS __attribute__((address_space(3)))
typedef unsigned short bf16_t;
typedef short bf16x8 __attribute__((ext_vector_type(8)));
typedef float f32x4 __attribute__((ext_vector_type(4)));
typedef unsigned u32x4 __attribute__((ext_vector_type(4)));
constexpr int BM = 256, BK = 64, HALF = 128, HTB = HALF * BK * 2  , STAGE_BYTES = 8 * HTB, NXCD = 8, WGM = 8;

__host__ __device__ __forceinline__ int lds_byte(int r, int c) { const int st = (r >> 4) * 2 + (c >> 5), rr = r & 15, cc = c & 31, ob = rr * 64 + cc * 2; return st * 1024 + (ob ^ (((ob >> 9) & 1) << 5)); }
__host__ __device__ __forceinline__ void stage_rc(int b, int& R, int& C) { const int st = b / 1024, sb = b % 1024, swz = sb ^ (((sb >> 9) & 1) << 5); R = (st >> 1) * 16 + swz / 64; C = (st & 1) * 32 + (swz % 64) / 2; }
__host__ __device__ __forceinline__ int perm32(int rho) { const int n = rho >> 4, i = rho & 15; return 8 * (i >> 2) + 4 * n + (i & 3); }

struct Unit { int pm, pn; };
struct Gemm { const bf16_t* A; const bf16_t* Bt; int M, N, K; };

struct StaticOrder {
    int nM, nN, nwg, G, c;
    __host__ __device__ void init(int M, int N, int G_, int c_) { nM = M / BM; nN = N / BM; nwg = nM * nN; G = G_; c = c_; }
    __host__ __device__ bool next(int i, Unit& u) const {
        const long L = (long)i * G + c; if (L >= nwg) return false;
        int wgid = (int)L; { const int q = nwg / NXCD, r = nwg % NXCD, xcd = wgid % NXCD, off = wgid / NXCD; wgid = (xcd < r ? xcd * (q + 1) : r * (q + 1) + (xcd - r) * q) + off; }
        const int nig = WGM * nN, gid = wgid / nig, fm = gid * WGM, gsz = (nM - fm) < WGM ? (nM - fm) : WGM;
        u.pm = fm + ((wgid % nig) % gsz); u.pn = (wgid % nig) / gsz; return true;
    }
    __device__ __forceinline__ void a_ready(const Unit&) const {}
    __device__ __forceinline__ void done(const Unit&) const {}
};
__device__ __forceinline__ unsigned cvt_pk_bf16(float lo, float hi) { unsigned r; asm volatile("v_cvt_pk_bf16_f32 %0, %1, %2" : "=v"(r) : "v"(lo), "v"(hi)); return r; }
typedef float f32x2 __attribute__((ext_vector_type(2)));
struct EpiStore {
    static constexpr bool PERM = true, AFTER_DRAIN = false;
    bf16_t* O; int ldc; int ntn; int n_main; float* tail; int tail_n;
    __device__ __forceinline__ void operator()(const f32x4 (&acc)[2][2][4][2], const Unit& u, int wr, int wc, int fr, int fq) const {
        const int row0 = u.pm * BM + wr * 64 + fr; const int ct = u.pn % ntn;
#pragma unroll
        for (int bj = 0; bj < 2; ++bj) {
            const int col = ct * BM + bj * HALF + wc * 32 + 8 * fq;
            if (col < n_main) {
#pragma unroll
                for (int ai = 0; ai < 2; ++ai)
#pragma unroll
                    for (int m = 0; m < 4; ++m) { const f32x4 v0 = acc[ai][bj][m][0], v1 = acc[ai][bj][m][1];
                        u32x4 w; w.x = cvt_pk_bf16(v0[0], v0[1]); w.y = cvt_pk_bf16(v0[2], v0[3]); w.z = cvt_pk_bf16(v1[0], v1[1]); w.w = cvt_pk_bf16(v1[2], v1[3]);
                        *(u32x4*)(O + (size_t)(row0 + ai * HALF + m * 16) * ldc + col) = w; }
            } else if (col - n_main < tail_n) {
#pragma unroll
                for (int ai = 0; ai < 2; ++ai)
#pragma unroll
                    for (int m = 0; m < 4; ++m) { float* p = tail + (size_t)(row0 + ai * HALF + m * 16) * tail_n + (col - n_main);
                        *(f32x4*)p = acc[ai][bj][m][0]; *(f32x4*)(p + 4) = acc[ai][bj][m][1]; }
            }
        }
    }
};
struct EpiSwiGLU {
    static constexpr bool PERM = true, AFTER_DRAIN = false;
    bf16_t* H; int ntn;
    __device__ __forceinline__ void operator()(const f32x4 (&acc)[2][2][4][2], const Unit& u, int wr, int wc, int fr, int fq) const {
        const int row0 = u.pm * BM + wr * 64 + fr; const int ct = u.pn % ntn;
        typedef unsigned u32x2v __attribute__((ext_vector_type(2)));
#pragma unroll
        for (int bj = 0; bj < 2; ++bj) {
            const int hc = ct * 128 + bj * 64 + wc * 16 + 4 * fq;
#pragma unroll
            for (int ai = 0; ai < 2; ++ai)
#pragma unroll
                for (int m = 0; m < 4; ++m) { const f32x4 g = acc[ai][bj][m][0], up = acc[ai][bj][m][1]; float r[4];
#pragma unroll
                    for (int i = 0; i < 4; ++i) { const float e = __builtin_amdgcn_exp2f(-g[i] * 1.4426950408889634f); r[i] = g[i] * __builtin_amdgcn_rcpf(1.0f + e) * up[i]; }
                    u32x2v w; w.x = cvt_pk_bf16(r[0], r[1]); w.y = cvt_pk_bf16(r[2], r[3]);
                    *(u32x2v*)(H + (size_t)(row0 + ai * HALF + m * 16) * 512 + hc) = w; }
        }
    }
};
struct MoeOrder {
    const int* tile_e; int ntiles, NT, G, c;
    __device__ __forceinline__ bool next(int i, Unit& u) const {
        const int L = i * G + c; if (L >= ntiles * NT) return false;
        const int pm = L / NT, j = L % NT; u.pm = pm; u.pn = tile_e[pm] * NT + j; return true;
    }
    __device__ __forceinline__ void a_ready(const Unit&) const {}
    __device__ __forceinline__ void done(const Unit&) const {}
};
template <class Epi, class Sched, bool ALIGN_EPI = false, bool SP2 = false>
__device__ __forceinline__ void gemm_phase(PG8_LAS unsigned char* lds, const Gemm g, const Sched& S, const Epi& E) {
    int tid_ = threadIdx.x; asm volatile("" : "+v"(tid_));
    const int tid = tid_, wid = __builtin_amdgcn_readfirstlane(tid >> 6), lane = tid & 63, wr = wid >> 2, wc = wid & 3, fr = lane & 15, fq = lane >> 4;
    const int K = g.K, nt = K / BK;
    unsigned voffA[2], voffB[2];
#pragma unroll
    for (int i = 0; i < 2; ++i) { int R, C; stage_rc(tid * 16 + i * 8192, R, C); const int Rb = Epi::PERM ? ((R & ~31) + perm32(R & 31)) : R;
        voffA[i] = (unsigned)(R * K + C) * 2u; voffB[i] = (unsigned)(Rb * K + C) * 2u; }
    const size_t kstep = (size_t)(BK * 2);
    const size_t hstep = (size_t)HALF * K * 2;
    const size_t tstep = 2 * hstep;
    const unsigned ldsw = (unsigned)wid * 1024u;
    const int aoff = lds_byte(wr * 64 + fr, fq * 8), boff = lds_byte(wc * 32 + fr, fq * 8);
#define PG8_SA(b, h) (((b) * 2 + (h)) * HTB)
#define PG8_SB(b, h) ((4 + (b) * 2 + (h)) * HTB)
#define PG8_STAGE(bufoff, gbase, voff) do { _Pragma("unroll") for (int _i = 0; _i < 2; ++_i) \
        __builtin_amdgcn_global_load_lds((const unsigned*)((const char*)(gbase) + (voff)[_i]), (PG8_LAS unsigned*)(lds + (bufoff) + ldsw + _i * 8192), 16, 0, 0); } while (0)
#define PG8_LDA(dst, b, h) do { _Pragma("unroll") for (int m = 0; m < 4; ++m) _Pragma("unroll") for (int k = 0; k < 2; ++k) dst[m][k] = *(const PG8_LAS bf16x8*)(lds + PG8_SA(b, h) + aoff + m * 2048 + k * 1024); } while (0)
#define PG8_LDB(dst, b, h) do { _Pragma("unroll") for (int n = 0; n < 2; ++n) _Pragma("unroll") for (int k = 0; k < 2; ++k) dst[n][k] = *(const PG8_LAS bf16x8*)(lds + PG8_SB(b, h) + boff + n * 2048 + k * 1024); } while (0)
#define PG8_MMA(ai, bj, At, Bt) do { __builtin_amdgcn_s_setprio(1); _Pragma("unroll") for (int m = 0; m < 4; ++m) _Pragma("unroll") for (int n = 0; n < 2; ++n) _Pragma("unroll") for (int k = 0; k < 2; ++k) \
        acc[ai][bj][m][n] = __builtin_amdgcn_mfma_f32_16x16x32_bf16(Bt[n][k], At[m][k], acc[ai][bj][m][n], 0, 0, 0); __builtin_amdgcn_s_setprio(0); } while (0)
#define PG8_WAIT_V(n) asm volatile("s_waitcnt vmcnt(" #n ")" ::: "memory")
#define PG8_WAIT_L(n) asm volatile("s_waitcnt lgkmcnt(" #n ")" ::: "memory")
#define PG8_BAR __builtin_amdgcn_s_barrier()
#define PG8_SCHED __builtin_amdgcn_sched_barrier(0)
    Unit cur, nxt; int ui = 0;
    if (!S.next(0, cur)) return;
    f32x4 acc[2][2][4][2];
#pragma unroll
    for (int a = 0; a < 2; ++a)
#pragma unroll
        for (int b = 0; b < 2; ++b)
#pragma unroll
            for (int m = 0; m < 4; ++m)
#pragma unroll
                for (int n = 0; n < 2; ++n) acc[a][b][m][n] = (f32x4){0.f, 0.f, 0.f, 0.f};
    bf16x8 At[4][2], B0[2][2], B1[2][2];
    const char* cA = (const char*)g.A + (size_t)cur.pm * tstep; const char* cB = (const char*)g.Bt + (size_t)cur.pn * tstep;
    S.a_ready(cur);
    if constexpr (SP2) {
        PG8_STAGE(PG8_SB(0, 0), cB, voffB); PG8_STAGE(PG8_SB(0, 1), cB + hstep, voffB); PG8_STAGE(PG8_SA(0, 0), cA, voffA); PG8_STAGE(PG8_SA(0, 1), cA + hstep, voffA);
        if (wr == 1) PG8_BAR;
        PG8_WAIT_V(2); PG8_BAR;
        PG8_STAGE(PG8_SB(1, 0), cB + kstep, voffB); PG8_STAGE(PG8_SA(1, 0), cA + kstep, voffA); PG8_STAGE(PG8_SB(1, 1), cB + hstep + kstep, voffB);
        PG8_WAIT_V(6); PG8_BAR;
    } else {
        PG8_STAGE(PG8_SB(0, 0), cB, voffB); PG8_STAGE(PG8_SA(0, 0), cA, voffA); PG8_STAGE(PG8_SB(0, 1), cB + hstep, voffB); PG8_STAGE(PG8_SA(0, 1), cA + hstep, voffA);
        if (wr == 1) PG8_BAR;
        PG8_WAIT_V(4); PG8_BAR;
        PG8_STAGE(PG8_SB(1, 0), cB + kstep, voffB); PG8_STAGE(PG8_SA(1, 0), cA + kstep, voffA); PG8_STAGE(PG8_SB(1, 1), cB + hstep + kstep, voffB);
        PG8_WAIT_V(6); PG8_BAR;
    }
    for (;;) {
        const bool has_next = S.next(ui + 1, nxt);
        const char* nA = has_next ? (const char*)g.A + (size_t)nxt.pm * tstep : cA; const char* nB = has_next ? (const char*)g.Bt + (size_t)nxt.pn * tstep : cB;
        for (int t = 0; t < nt; t += 2) {
            const bool last = (t == nt - 2);
            const char* a1 = cA + (size_t)(t + 1) * kstep;
            const char* a2 = last ? nA : cA + (size_t)(t + 2) * kstep; const char* b2 = last ? nB : cB + (size_t)(t + 2) * kstep;
            const char* a3 = a2 + kstep; const char* b3 = b2 + kstep;
            if (last && has_next) S.a_ready(nxt);
            if constexpr (SP2) {
            PG8_LDB(B0, 0, 0); PG8_LDB(B1, 0, 1); PG8_SCHED; PG8_LDA(At, 0, 0); PG8_STAGE(PG8_SA(1, 1), a1 + hstep, voffA);
            PG8_WAIT_V(8); PG8_WAIT_L(0); PG8_BAR; PG8_MMA(0, 0, At, B0); PG8_MMA(0, 1, At, B1); PG8_BAR; PG8_SCHED;
            PG8_LDA(At, 0, 1); PG8_STAGE(PG8_SB(0, 0), b2, voffB); PG8_STAGE(PG8_SB(0, 1), b2 + hstep, voffB); PG8_STAGE(PG8_SA(0, 0), a2, voffA);
            PG8_WAIT_V(8); PG8_WAIT_L(0); PG8_BAR; PG8_MMA(1, 0, At, B0); PG8_MMA(1, 1, At, B1); PG8_BAR; PG8_SCHED;
            PG8_LDB(B0, 1, 0); PG8_LDB(B1, 1, 1); PG8_SCHED; PG8_LDA(At, 1, 0); PG8_STAGE(PG8_SA(0, 1), a2 + hstep, voffA);
            PG8_WAIT_V(8); PG8_WAIT_L(0); PG8_BAR; PG8_MMA(0, 0, At, B0); PG8_MMA(0, 1, At, B1); PG8_BAR; PG8_SCHED;
            PG8_LDA(At, 1, 1); PG8_STAGE(PG8_SB(1, 0), b3, voffB); PG8_STAGE(PG8_SB(1, 1), b3 + hstep, voffB); PG8_STAGE(PG8_SA(1, 0), a3, voffA);
            PG8_WAIT_V(8); PG8_WAIT_L(0); PG8_BAR; PG8_MMA(1, 0, At, B0); PG8_MMA(1, 1, At, B1); PG8_BAR; PG8_SCHED;
            } else {
            PG8_LDB(B0, 0, 0); PG8_SCHED; PG8_LDA(At, 0, 0); PG8_STAGE(PG8_SA(1, 1), a1 + hstep, voffA);
            PG8_WAIT_L(8); PG8_BAR; PG8_WAIT_L(0); PG8_MMA(0, 0, At, B0); PG8_BAR; PG8_SCHED;
            PG8_LDB(B1, 0, 1); PG8_STAGE(PG8_SB(0, 0), b2, voffB);
            PG8_BAR; PG8_WAIT_L(0); PG8_MMA(0, 1, At, B1); PG8_BAR;
            PG8_LDA(At, 0, 1); PG8_STAGE(PG8_SA(0, 0), a2, voffA);
            PG8_BAR; PG8_WAIT_L(0); PG8_MMA(1, 0, At, B0); PG8_BAR; PG8_SCHED;
            PG8_STAGE(PG8_SB(0, 1), b2 + hstep, voffB);
            PG8_WAIT_V(6); PG8_BAR; PG8_MMA(1, 1, At, B1); PG8_BAR;
            PG8_LDB(B0, 1, 0); PG8_SCHED; PG8_LDA(At, 1, 0); PG8_STAGE(PG8_SA(0, 1), a2 + hstep, voffA);
            PG8_WAIT_L(8); PG8_BAR; PG8_WAIT_L(0); PG8_MMA(0, 0, At, B0); PG8_BAR; PG8_SCHED;
            PG8_LDB(B1, 1, 1); PG8_STAGE(PG8_SB(1, 0), b3, voffB);
            PG8_BAR; PG8_WAIT_L(0); PG8_MMA(0, 1, At, B1); PG8_BAR;
            PG8_LDA(At, 1, 1); PG8_STAGE(PG8_SA(1, 0), a3, voffA);
            PG8_BAR; PG8_WAIT_L(0); PG8_MMA(1, 0, At, B0); PG8_BAR; PG8_SCHED;
            PG8_STAGE(PG8_SB(1, 1), b3 + hstep, voffB);
            PG8_WAIT_V(6); PG8_BAR; PG8_MMA(1, 1, At, B1); PG8_BAR;
            }
        }
        if constexpr (ALIGN_EPI) { if (wr == 0) PG8_BAR; }
        if constexpr (!Epi::AFTER_DRAIN) { E(acc, cur, wr, wc, fr, fq); S.done(cur); }
        if (!has_next) break;
#pragma unroll
        for (int a = 0; a < 2; ++a)
#pragma unroll
            for (int b = 0; b < 2; ++b)
#pragma unroll
                for (int m = 0; m < 4; ++m)
#pragma unroll
                    for (int n = 0; n < 2; ++n) acc[a][b][m][n] = (f32x4){0.f, 0.f, 0.f, 0.f};
        cur = nxt; cA = nA; cB = nB; ++ui;
        if constexpr (ALIGN_EPI) { if (wr == 1) PG8_BAR; }
    }
    PG8_WAIT_V(0);
    if constexpr (!ALIGN_EPI) { if (wr == 0) PG8_BAR; }
    PG8_BAR;
    if constexpr (Epi::AFTER_DRAIN) { E.fused(acc, cur, wr, wc, fr, fq, lds, wid, lane); S.done(cur); }
#undef PG8_SA
#undef PG8_SB
#undef PG8_STAGE
#undef PG8_LDA
#undef PG8_LDB
#undef PG8_MMA
#undef PG8_WAIT_V
#undef PG8_WAIT_L
#undef PG8_BAR
#undef PG8_SCHED
}
}
#define GAS __attribute__((address_space(1)))
#define LAS __attribute__((address_space(3)))
#define DI __device__ __forceinline__
typedef unsigned short bf16;
typedef unsigned v4u __attribute__((ext_vector_type(4)));
typedef unsigned v2u __attribute__((ext_vector_type(2)));
typedef float f32x4 __attribute__((ext_vector_type(4)));
typedef float f32x2 __attribute__((ext_vector_type(2)));
typedef GAS unsigned gu32;
#define LDS_WAIT() asm volatile("s_waitcnt lgkmcnt(0)" ::: "memory")
#define VM_WAIT() asm volatile("s_waitcnt vmcnt(0)" ::: "memory")
DI unsigned f2bf(float f) { unsigned u = __builtin_bit_cast(unsigned, f); return (u + 0x7fffu + ((u >> 16) & 1u)) >> 16; }
DI unsigned pk2(float lo, float hi) { return f2bf(lo) | (f2bf(hi) << 16); }
DI float bflo(unsigned u) { return __builtin_bit_cast(float, u << 16); }
DI float bfhi(unsigned u) { return __builtin_bit_cast(float, u & 0xffff0000u); }
DI float wave_sum(float v) {
#pragma unroll
    for (int o = 1; o < 64; o <<= 1) v += __shfl_xor(v, o);
    return v;
}
DI float wave_max(float v) {
#pragma unroll
    for (int o = 1; o < 64; o <<= 1) v = fmaxf(v, __shfl_xor(v, o));
    return v;
}
#define XB_TMO      128
#define XB_XCNT(j)  (256  + 64 * (j))
#define XB_XSUB(j)  (1280 + 64 * (j))
#define XB_XGEN(j)  (2304 + 64 * (j))
#define XB_TOP      3328
#define XB_TOPGEN   3392
#define XCD_BAR_WORDS 3456
#define XB_SPIN_CAP (1u << 18)

__device__ __forceinline__ unsigned xb_ld(unsigned* p)              { return __hip_atomic_load(p, __ATOMIC_RELAXED, __HIP_MEMORY_SCOPE_AGENT); }
__device__ __forceinline__ unsigned xb_add(unsigned* p, unsigned v) { return __hip_atomic_fetch_add(p, v, __ATOMIC_RELAXED, __HIP_MEMORY_SCOPE_AGENT); }
__device__ __forceinline__ unsigned xb_xcc_id() { return (unsigned)__builtin_amdgcn_s_getreg((3 << 11) | 20) & 0xFu; }
#define XB_SPIN(cond, bar) do { unsigned _sp = 0; while (cond) { __builtin_amdgcn_s_sleep(1); \
    if ((++_sp & 255u) == 0u) { if (xb_ld(&(bar)[XB_TMO])) break; if (_sp > XB_SPIN_CAP) { atomicAdd(&(bar)[XB_TMO], 1u); break; } } } } while (0)

struct XcdBarrier {
    unsigned* bar; unsigned x;
    volatile LAS unsigned* st;
};

__device__ __forceinline__ XcdBarrier xcd_barrier_post(unsigned* bar, volatile LAS unsigned* st) {
    XcdBarrier b; b.bar = bar; b.x = xb_xcc_id(); b.st = st;
    if (threadIdx.x == 0) (void)xb_add(&bar[XB_XCNT(b.x)], 1u);
    return b;
}
__device__ __forceinline__ void xcd_barrier_complete(unsigned* bar, unsigned x, unsigned& nloc, unsigned& nx) {
    const unsigned G = gridDim.x * gridDim.y * gridDim.z;
    unsigned sum, cnt, mine, sp = 0u;
    for (;;) {
        sum = 0u; cnt = 0u; mine = 0u;
#pragma unroll
        for (unsigned j = 0; j < 16; ++j) { const unsigned c = xb_ld(&bar[XB_XCNT(j)]); sum += c; cnt += (c > 0u) ? 1u : 0u; mine = (j == x) ? c : mine; }
        if (sum == G) break;
        __builtin_amdgcn_s_sleep(1);
        if ((++sp & 255u) == 0u) { if (xb_ld(&bar[XB_TMO])) break; if (sp > XB_SPIN_CAP) { atomicAdd(&bar[XB_TMO], 1u); break; } }
    }
    nloc = mine > 0u ? mine : 1u; nx = cnt > 0u ? cnt : 1u;
}

__device__ __forceinline__ void xcd_barrier(const XcdBarrier& b) {
    asm volatile("s_waitcnt vmcnt(0)" ::: "memory");
    __syncthreads();
    if (threadIdx.x == 0) {
        unsigned* bar = b.bar;
        __builtin_amdgcn_s_waitcnt(0);
        unsigned nloc = b.st[0], nx = b.st[1];
        if (nloc == 0u) { xcd_barrier_complete(bar, b.x, nloc, nx); b.st[0] = nloc; b.st[1] = nx; }
        const unsigned old = xb_add(&bar[XB_XSUB(b.x)], 1u);
        const unsigned gen = old / nloc;
        if (old + 1u == (gen + 1u) * nloc) {
            __builtin_amdgcn_fence(__ATOMIC_RELEASE, "agent");
            asm volatile("s_waitcnt vmcnt(0)" ::: "memory");
            const unsigned og = xb_add(&bar[XB_TOP], 1u);
            const unsigned tg = og / nx;
            if (og + 1u == (tg + 1u) * nx) xb_add(&bar[XB_TOPGEN], 1u);
            else XB_SPIN(xb_ld(&bar[XB_TOPGEN]) == tg, bar);
            __builtin_amdgcn_fence(__ATOMIC_ACQUIRE, "agent");
            xb_add(&bar[XB_XGEN(b.x)], 1u);
            asm volatile("s_waitcnt vmcnt(0)" ::: "memory");
        } else {
            XB_SPIN(xb_ld(&bar[XB_XGEN(b.x)]) == gen, bar);
            __builtin_amdgcn_fence(__ATOMIC_ACQUIRE, "agent");
            asm volatile("s_waitcnt vmcnt(0)" ::: "memory");
        }
    }
    __syncthreads();
}
constexpr int BATCH = 8, SEQ = 4096, DM = 1024, T = BATCH * SEQ, HD = 64;
constexpr int NWAVES = 8, NTHR = 512;
constexpr float EPS = 1e-6f, LOG2E = 1.4426950408889634f, QSC = 0.125f * LOG2E;
enum { I_X = 0, I_C, I_FOX_WIN, I_FOX_BF, I_FOX_QG, I_FOX_KG, I_FOX_WOUT, I_NSA_WIN, I_NSA_QG, I_NSA_KG, I_NSA_POS, I_NSA_W1, I_NSA_W2, I_NSA_WOUT,
       I_DIL_WIN, I_DIL_QG, I_DIL_KG, I_DIL_WOUT, I_DIFF_WIN, I_DIFF_QG, I_DIFF_KG, I_DIFF_LAM, I_DIFF_SG, I_DIFF_WOUT,
       I_NORM_GAIN, I_ADA_W, I_ADA_B, I_ROUTER_W, I_ROUTER_B, I_MOE_WG, I_MOE_WU, I_MOE_WD, N_IN };
constexpr size_t MiB = 1u << 20;
constexpr size_t WS_CTL = 0, CTL_ZERO_BYTES = 1 * MiB;
constexpr size_t WS_MODP = 1 * MiB, WS_MOD = 7 * MiB, WS_ROPE = 8 * MiB, WS_FLOG = 9 * MiB, WS_CUM = 11 * MiB, WS_GATE = 13 * MiB, WS_LSE = 19 * MiB, WS_SELM = 21 * MiB;
constexpr size_t WS_KC = 22 * MiB, WS_VC = 22 * MiB + 512 * 1024;
constexpr size_t WS_EIDX = 23 * MiB, WS_WTS = WS_EIDX + 256 * 1024, WS_LRANK = WS_WTS + 256 * 1024, WS_ROWOF = WS_LRANK + 256 * 1024;
constexpr size_t WS_HIST = 24 * MiB, WS_TILEE = WS_HIST + 64 * 1024, WS_NTILES = WS_TILEE + 4096;
constexpr size_t WS_FOXWIN = 32 * MiB, WS_NSAWIN = 39 * MiB, WS_DILWIN = 45 * MiB, WS_DIFFWIN = 63 * MiB, WS_WOUT = 69 * MiB;
constexpr size_t WS_MOEW = 80 * MiB, MOEW_LAYER = 48 * MiB, MOEW_D_OFF = 32 * MiB;
constexpr size_t WS_UO = 272 * MiB, WS_O2 = 336 * MiB, WS_R1 = 400 * MiB, WS_HID = WS_R1 + 136 * MiB, WS_END = 608 * MiB;
constexpr int CW_BAR = 4096;
constexpr int LDS_BYTES = 147456, MISC_OFF = 131072 + 320;
constexpr int FOX_NPAD = 3328, NSA_NPAD = 2816;

struct Args { const float* in[N_IN]; float* out; unsigned char* ws; int ph_lo, ph_hi; };
struct Ctx {
    float* hbuf; unsigned char* ws; LAS unsigned char* lds;
    int tid, lane, wave, G, blk;
};
constexpr int PTR_OFF = 131072 + 1024;
DI const float* inp(const Ctx& C, int i) {
    const unsigned long long v = ((const LAS unsigned long long*)(C.lds + PTR_OFF))[i];
    const unsigned lo = __builtin_amdgcn_readfirstlane((unsigned)v), hi = __builtin_amdgcn_readfirstlane((unsigned)(v >> 32));
    return (const float*)(((unsigned long long)hi << 32) | lo);
}

DI void conv_item(const float* W0, const float* W1, int K, int Nsrc, int ldn, bf16* WT, int mode, int nblk, int item, LAS float* scr, int lane) {
    const int kb = item / nblk, nb = item % nblk, k0 = 64 * kb, n0 = 32 * nb;
    const int n = n0 + (lane & 31);
    const float* src; bool valid;
    if (mode == 0) { valid = n < Nsrc; src = W0 + n; }
    else { const int j = n >> 3, i = n & 7; valid = true; src = ((i < 4) ? W0 : W1) + 4 * j + (i & 3); }
#pragma unroll 8
    for (int i = 0; i < 32; ++i) { const int kk = 2 * i + (lane >> 5); scr[kk * 33 + (lane & 31)] = valid ? src[(size_t)(k0 + kk) * ldn] : 0.f; }
    LDS_WAIT(); asm volatile("" ::: "memory");
    const int c = lane & 7;
#pragma unroll
    for (int j = 0; j < 4; ++j) { const int nn = (lane >> 3) + 8 * j; const LAS float* s = scr + (8 * c) * 33 + nn;
        v4u o; o.x = pk2(s[0 * 33], s[1 * 33]); o.y = pk2(s[2 * 33], s[3 * 33]); o.z = pk2(s[4 * 33], s[5 * 33]); o.w = pk2(s[6 * 33], s[7 * 33]);
        *(v4u*)(WT + (size_t)(n0 + nn) * K + k0 + 8 * c) = o; }
    LDS_WAIT(); asm volatile("" ::: "memory");
}
DI void sincos_d(double x, float& s, float& c) {
    const double k = __builtin_rint(x * 0.6366197723675814);
    double r = __builtin_fma(-k, 1.5707963267948966, x); r = __builtin_fma(-k, 6.123233995736766e-17, r);
    const int q = ((int)k) & 3; const double r2 = r * r;
    double sp = 1.0 / 6227020800.0; sp = sp * r2 - 1.0 / 39916800.0; sp = sp * r2 + 1.0 / 362880.0; sp = sp * r2 - 1.0 / 5040.0; sp = sp * r2 + 1.0 / 120.0; sp = sp * r2 - 1.0 / 6.0; sp = sp * r2 + 1.0; sp *= r;
    double cp = -1.0 / 87178291200.0; cp = cp * r2 + 1.0 / 479001600.0; cp = cp * r2 - 1.0 / 3628800.0; cp = cp * r2 + 1.0 / 40320.0; cp = cp * r2 - 1.0 / 720.0; cp = cp * r2 + 1.0 / 24.0; cp = cp * r2 - 0.5; cp = cp * r2 + 1.0;
    const double ss = (q == 0) ? sp : (q == 1) ? cp : (q == 2) ? -sp : -cp;
    const double cc = (q == 0) ? cp : (q == 1) ? -sp : (q == 2) ? -cp : sp;
    s = (float)ss; c = (float)cc;
}
DI void phase_p0a(Ctx& C) {
    const int gw = C.blk * NWAVES + C.wave, NGW = C.G * NWAVES;
    LAS float* cond = (LAS float*)C.lds;
    for (int i = C.tid; i < BATCH * DM; i += NTHR) { const float v = inp(C, I_C)[i]; cond[i] = v / (1.0f + expf(-v)); }
    __syncthreads();
    float* MODP = (float*)(C.ws + WS_MODP);
    for (int it = gw; it < 4 * 96 * 8; it += NGW) {
        const int l = it / 768, rem = it % 768, cg = rem / 8, kc = rem % 8, col = cg * 64 + C.lane;
        float acc[8];
#pragma unroll
        for (int b = 0; b < 8; ++b) acc[b] = 0.f;
        const float* w = inp(C, I_ADA_W) + ((size_t)l * DM + kc * 128) * 6144 + col;
#pragma unroll 4
        for (int k = 0; k < 128; ++k) { const float wv = w[(size_t)k * 6144];
#pragma unroll
            for (int b = 0; b < 8; ++b) acc[b] += cond[b * DM + kc * 128 + k] * wv; }
#pragma unroll
        for (int b = 0; b < 8; ++b) MODP[(((size_t)kc * 4 + l) * 8 + b) * 6144 + col] = acc[b];
    }
    __syncthreads();
    { f32x2* ROPE = (f32x2*)(C.ws + WS_ROPE);
      for (int i = C.blk * NTHR + C.tid; i < SEQ * 32; i += C.G * NTHR) { const int t = i >> 5, f = i & 31;
          const float inv = exp2f(-(float)f * (13.287712379549449f / 32.0f)); const float ang = (float)t * inv; float s, c; sincos_d((double)ang, s, c); ROPE[i] = (f32x2){c, s}; } }
    LAS float* scr = (LAS float*)(C.lds + C.wave * 16384);
    constexpr int I_FOXIN = 16 * (FOX_NPAD / 32), I_NSAIN = 16 * (NSA_NPAD / 32), I_DILIN = 16 * (9216 / 32), I_DIFFIN = 16 * (3072 / 32), I_WO = 16 * 32, I_GU = 16 * 32, I_D = 8 * 32;
    constexpr int NITEMS = I_FOXIN + I_NSAIN + I_DILIN + I_DIFFIN + 4 * I_WO + 64 * I_GU + 64 * I_D;
    for (int it = gw; it < NITEMS; it += NGW) {
        int r = it;
        if (r < I_FOXIN) { conv_item(inp(C, I_FOX_WIN), nullptr, DM, 3088, 3088, (bf16*)(C.ws + WS_FOXWIN), 0, FOX_NPAD / 32, r, scr, C.lane); continue; } r -= I_FOXIN;
        if (r < I_NSAIN) { conv_item(inp(C, I_NSA_WIN), nullptr, DM, 2608, 2608, (bf16*)(C.ws + WS_NSAWIN), 0, NSA_NPAD / 32, r, scr, C.lane); continue; } r -= I_NSAIN;
        if (r < I_DILIN) { conv_item(inp(C, I_DIL_WIN), nullptr, DM, 9216, 9216, (bf16*)(C.ws + WS_DILWIN), 0, 9216 / 32, r, scr, C.lane); continue; } r -= I_DILIN;
        if (r < I_DIFFIN) { conv_item(inp(C, I_DIFF_WIN), nullptr, DM, 3072, 3072, (bf16*)(C.ws + WS_DIFFWIN), 0, 3072 / 32, r, scr, C.lane); continue; } r -= I_DIFFIN;
        if (r < 4 * I_WO) { const int m = r / I_WO; const float* src = (m == 0) ? inp(C, I_FOX_WOUT) : (m == 1) ? inp(C, I_NSA_WOUT) : (m == 2) ? inp(C, I_DIL_WOUT) : inp(C, I_DIFF_WOUT);
            conv_item(src, nullptr, DM, DM, DM, (bf16*)(C.ws + WS_WOUT + (size_t)m * 2 * MiB), 0, 32, r % I_WO, scr, C.lane); continue; } r -= 4 * I_WO;
        if (r < 64 * I_GU) { const int le = r / I_GU, l = le / 16, e = le % 16;
            conv_item(inp(C, I_MOE_WG) + (size_t)le * DM * 512, inp(C, I_MOE_WU) + (size_t)le * DM * 512, DM, 1024, 512, (bf16*)(C.ws + WS_MOEW + (size_t)l * MOEW_LAYER + (size_t)e * 2 * MiB), 1, 32, r % I_GU, scr, C.lane); continue; } r -= 64 * I_GU;
        { const int le = r / I_D, l = le / 16, e = le % 16;
            conv_item(inp(C, I_MOE_WD) + (size_t)le * 512 * DM, nullptr, 512, DM, DM, (bf16*)(C.ws + WS_MOEW + (size_t)l * MOEW_LAYER + MOEW_D_OFF + (size_t)e * MiB), 0, 32, r % I_D, scr, C.lane); }
    }
}
DI void phase_p0b(Ctx& C) {
    const float* MODP = (const float*)(C.ws + WS_MODP); float* MOD = (float*)(C.ws + WS_MOD);
    for (int i = C.blk * NTHR + C.tid; i < 4 * 8 * 6144; i += C.G * NTHR) { const int l = i / (8 * 6144), col = i % 6144;
        float s = inp(C, I_ADA_B)[l * 6144 + col];
#pragma unroll
        for (int kc = 0; kc < 8; ++kc) s += MODP[(size_t)kc * (4 * 8 * 6144) + i];
        MOD[i] = s; }
}
DI void ld_row_f32(const float* p, int lane, f32x4 (&v)[4]) {
#pragma unroll
    for (int j = 0; j < 4; ++j) v[j] = *(const f32x4*)(p + 4 * lane + 256 * j);
}
DI void st_row_f32(float* p, int lane, const f32x4 (&v)[4]) {
#pragma unroll
    for (int j = 0; j < 4; ++j) *(f32x4*)(p + 4 * lane + 256 * j) = v[j];
}
DI void ld_row_bf16(const bf16* p, int lane, f32x4 (&v)[4]) {
#pragma unroll
    for (int j = 0; j < 4; ++j) { const v2u w = *(const v2u*)(p + 4 * lane + 256 * j); v[j] = (f32x4){bflo(w.x), bfhi(w.x), bflo(w.y), bfhi(w.y)}; }
}
DI void st_row_bf16(bf16* p, int lane, const f32x4 (&v)[4]) {
#pragma unroll
    for (int j = 0; j < 4; ++j) { v2u w; w.x = pk2(v[j].x, v[j].y); w.y = pk2(v[j].z, v[j].w); *(v2u*)(p + 4 * lane + 256 * j) = w; }
}
DI void norm_mod(const f32x4 (&h)[4], const float* gain, const float* sc, const float* sh, int lane, f32x4 (&u)[4]) {
    float ss = 0.f;
#pragma unroll
    for (int j = 0; j < 4; ++j) ss += (h[j].x * h[j].x + h[j].y * h[j].y) + (h[j].z * h[j].z + h[j].w * h[j].w);
    const float r = 1.0f / sqrtf(wave_sum(ss) * (1.0f / DM) + EPS);
#pragma unroll
    for (int j = 0; j < 4; ++j) { const f32x4 g = *(const f32x4*)(gain + 4 * lane + 256 * j), s1 = *(const f32x4*)(sc + 4 * lane + 256 * j), s0 = *(const f32x4*)(sh + 4 * lane + 256 * j);
        u[j] = (h[j] * r) * g * (s1 + 1.0f) + s0; }
}
DI void moe_combine(Ctx& C, int LP, int row, int b, f32x4 (&h)[4]) {
    const int* ROWOF = (const int*)(C.ws + WS_ROWOF); const float* WTS = (const float*)(C.ws + WS_WTS); const bf16* YS = (const bf16*)(C.ws + WS_R1);
    const float* g2 = (const float*)(C.ws + WS_MOD) + ((size_t)(LP * 8 + b) * 6 + 5) * DM;
    const int r0 = ROWOF[2 * row], r1 = ROWOF[2 * row + 1]; const float w0 = WTS[2 * row], w1 = WTS[2 * row + 1];
    f32x4 y0[4], y1[4]; ld_row_bf16(YS + (size_t)r0 * DM, C.lane, y0); ld_row_bf16(YS + (size_t)r1 * DM, C.lane, y1);
#pragma unroll
    for (int j = 0; j < 4; ++j) { const f32x4 g = *(const f32x4*)(g2 + 4 * C.lane + 256 * j); h[j] += g * (y0[j] * w0 + y1[j] * w1); }
}
template <int L> DI void phase_n1(Ctx& C) {
    const int RPB = T / C.G, RPW = RPB / NWAVES;
    const float* MOD = (const float*)(C.ws + WS_MOD); bf16* U = (bf16*)(C.ws + WS_UO);
    for (int i = 0; i < RPW; ++i) {
        const int row = C.blk * RPB + C.wave * RPW + i, b = row / SEQ;
        f32x4 h[4], u[4];
        if (L == 0) ld_row_f32(inp(C, I_X) + (size_t)row * DM, C.lane, h);
        else { ld_row_f32(C.hbuf + (size_t)row * DM, C.lane, h); moe_combine(C, L - 1, row, b, h); }
        st_row_f32(C.hbuf + (size_t)row * DM, C.lane, h);
        norm_mod(h, inp(C, I_NORM_GAIN) + (L * 2 + 0) * DM, MOD + ((size_t)(L * 8 + b) * 6 + 1) * DM, MOD + ((size_t)(L * 8 + b) * 6 + 0) * DM, C.lane, u);
        st_row_bf16(U + (size_t)row * DM, C.lane, u);
    }
}
DI void phase_final(Ctx& C) {
    const int RPB = T / C.G, RPW = RPB / NWAVES;
    for (int i = 0; i < RPW; ++i) {
        const int row = C.blk * RPB + C.wave * RPW + i, b = row / SEQ;
        f32x4 h[4]; ld_row_f32(C.hbuf + (size_t)row * DM, C.lane, h); moe_combine(C, 3, row, b, h); st_row_f32(C.hbuf + (size_t)row * DM, C.lane, h);
    }
}
template <int L> DI void phase_n2(Ctx& C, const bf16* Y) {
    const int RPB = T / C.G, RPW = RPB / NWAVES;
    const float* MOD = (const float*)(C.ws + WS_MOD); bf16* U = (bf16*)(C.ws + WS_UO);
    LAS float* wT = (LAS float*)C.lds; LAS int* hist = (LAS int*)(C.lds + 65536);
    for (int idx = C.tid; idx < DM * 16; idx += NTHR) wT[(idx & 15) * DM + (idx >> 4)] = inp(C, I_ROUTER_W)[idx];
    if (C.tid < 16) hist[C.tid] = 0;
    __syncthreads();
    int* EIDX = (int*)(C.ws + WS_EIDX); float* WTS = (float*)(C.ws + WS_WTS); int* LRANK = (int*)(C.ws + WS_LRANK);
    for (int i = 0; i < RPW; ++i) {
        const int row = C.blk * RPB + C.wave * RPW + i, b = row / SEQ;
        f32x4 h[4], y[4], u[4]; ld_row_f32(C.hbuf + (size_t)row * DM, C.lane, h); ld_row_bf16(Y + (size_t)row * DM, C.lane, y);
        const float* g1 = MOD + ((size_t)(L * 8 + b) * 6 + 2) * DM;
#pragma unroll
        for (int j = 0; j < 4; ++j) h[j] += *(const f32x4*)(g1 + 4 * C.lane + 256 * j) * y[j];
        st_row_f32(C.hbuf + (size_t)row * DM, C.lane, h);
        norm_mod(h, inp(C, I_NORM_GAIN) + (L * 2 + 1) * DM, MOD + ((size_t)(L * 8 + b) * 6 + 4) * DM, MOD + ((size_t)(L * 8 + b) * 6 + 3) * DM, C.lane, u);
        st_row_bf16(U + (size_t)row * DM, C.lane, u);
        float sc[16], sel[16];
#pragma unroll
        for (int e = 0; e < 16; ++e) { float a = 0.f;
#pragma unroll
            for (int j = 0; j < 4; ++j) { const f32x4 w = *(const LAS f32x4*)(wT + e * DM + 256 * j + 4 * C.lane); a += (u[j].x * w.x + u[j].y * w.y) + (u[j].z * w.z + u[j].w * w.w); }
            a = wave_sum(a); sc[e] = 1.0f / (1.0f + expf(-a)); sel[e] = sc[e] + inp(C, I_ROUTER_B)[e]; }
        float bs = -INFINITY, bw0 = 0.f, bw1 = 0.f; int be0 = 0, be1 = 1;
#pragma unroll
        for (int g = 0; g < 4; ++g) {
            const float a0 = sel[4 * g], a1 = sel[4 * g + 1], a2 = sel[4 * g + 2], a3 = sel[4 * g + 3];
            const float c0 = sc[4 * g], c1 = sc[4 * g + 1], c2 = sc[4 * g + 2], c3 = sc[4 * g + 3];
            int i1 = 0; float v1 = a0, s1 = c0;
            if (a1 > v1) { v1 = a1; s1 = c1; i1 = 1; } if (a2 > v1) { v1 = a2; s1 = c2; i1 = 2; } if (a3 > v1) { v1 = a3; s1 = c3; i1 = 3; }
            int i2 = -1; float v2 = -INFINITY, s2 = 0.f;
            if (i1 != 0 && a0 > v2) { v2 = a0; s2 = c0; i2 = 0; } if (i1 != 1 && a1 > v2) { v2 = a1; s2 = c1; i2 = 1; }
            if (i1 != 2 && a2 > v2) { v2 = a2; s2 = c2; i2 = 2; } if (i1 != 3 && a3 > v2) { v2 = a3; s2 = c3; i2 = 3; }
            const float gs = v1 + v2;
            if (gs > bs) { bs = gs; be0 = 4 * g + i1; be1 = 4 * g + i2; bw0 = s1; bw1 = s2; }
        }
        if (C.lane == 0) {
            const float inv = 1.0f / (bw0 + bw1);
            EIDX[2 * row] = be0; EIDX[2 * row + 1] = be1; WTS[2 * row] = bw0 * inv; WTS[2 * row + 1] = bw1 * inv;
            LRANK[2 * row] = __hip_atomic_fetch_add(hist + be0, 1, __ATOMIC_RELAXED, __HIP_MEMORY_SCOPE_WORKGROUP);
            LRANK[2 * row + 1] = __hip_atomic_fetch_add(hist + be1, 1, __ATOMIC_RELAXED, __HIP_MEMORY_SCOPE_WORKGROUP);
        }
    }
    __syncthreads();
    if (C.tid < 16) ((int*)(C.ws + WS_HIST))[C.blk * 16 + C.tid] = hist[C.tid];
    __syncthreads();
}
DI void phase_s(Ctx& C) {
    const int RPB = T / C.G, RPW = RPB / NWAVES;
    LAS int* tot = (LAS int*)C.lds; LAS int* before = tot + 16; LAS int* base = tot + 32;
    if (C.tid < 48) tot[C.tid] = 0;
    __syncthreads();
    const int* HIST = (const int*)(C.ws + WS_HIST);
    for (int idx = C.tid; idx < C.G * 16; idx += NTHR) { const int bb = idx >> 4, e = idx & 15; const int c = HIST[idx];
        __hip_atomic_fetch_add(tot + e, c, __ATOMIC_RELAXED, __HIP_MEMORY_SCOPE_WORKGROUP);
        if (bb < C.blk) __hip_atomic_fetch_add(before + e, c, __ATOMIC_RELAXED, __HIP_MEMORY_SCOPE_WORKGROUP); }
    __syncthreads();
    if (C.tid == 0) { int ps = 0; int* TILEE = (int*)(C.ws + WS_TILEE);
        for (int e = 0; e < 16; ++e) { base[e] = ps + before[e]; const int pe = (tot[e] + 255) & ~255;
            if (C.blk == 0) for (int tl = ps >> 8; tl < ((ps + pe) >> 8); ++tl) TILEE[tl] = e;
            ps += pe; }
        if (C.blk == 0) *(int*)(C.ws + WS_NTILES) = ps >> 8; }
    __syncthreads();
    const int* EIDX = (const int*)(C.ws + WS_EIDX); const int* LRANK = (const int*)(C.ws + WS_LRANK); int* ROWOF = (int*)(C.ws + WS_ROWOF);
    const bf16* U = (const bf16*)(C.ws + WS_UO); bf16* XS = (bf16*)(C.ws + WS_R1);
    for (int i = 0; i < RPW; ++i) {
        const int row = C.blk * RPB + C.wave * RPW + i;
        const int d0 = base[EIDX[2 * row]] + LRANK[2 * row], d1 = base[EIDX[2 * row + 1]] + LRANK[2 * row + 1];
        if (C.lane == 0) { ROWOF[2 * row] = d0; ROWOF[2 * row + 1] = d1; }
        const v4u a = *(const v4u*)(U + (size_t)row * DM + 8 * C.lane), bq = *(const v4u*)(U + (size_t)row * DM + 512 + 8 * C.lane);
        *(v4u*)(XS + (size_t)d0 * DM + 8 * C.lane) = a; *(v4u*)(XS + (size_t)d0 * DM + 512 + 8 * C.lane) = bq;
        *(v4u*)(XS + (size_t)d1 * DM + 8 * C.lane) = a; *(v4u*)(XS + (size_t)d1 * DM + 512 + 8 * C.lane) = bq;
    }
    __syncthreads();
}
DI void gemm_qkv(Ctx& C, const bf16* A, const bf16* Bt, int Npad, bf16* O, int ldc, int n_main, float* tail, int tail_n) {
    pg8::Gemm g{A, Bt, T, Npad, DM}; pg8::StaticOrder S; S.init(T, Npad, C.G, C.blk);
    pg8::EpiStore E{O, ldc, 1 << 20, n_main, tail, tail_n};
    pg8::gemm_phase<pg8::EpiStore, pg8::StaticOrder, true, true>(C.lds, g, S, E);
}
DI void gemm_moe1(Ctx& C, int L) {
    const int ntiles = *(const int*)(C.ws + WS_NTILES);
    pg8::Gemm g{(const bf16*)(C.ws + WS_R1), (const bf16*)(C.ws + WS_MOEW + (size_t)L * MOEW_LAYER), ntiles * 256, 16 * 1024, DM};
    pg8::MoeOrder S{(const int*)(C.ws + WS_TILEE), ntiles, 4, C.G, C.blk};
    pg8::EpiSwiGLU E{(bf16*)(C.ws + WS_HID), 4};
    pg8::gemm_phase<pg8::EpiSwiGLU, pg8::MoeOrder, true, true>(C.lds, g, S, E);
}
DI void gemm_moe2(Ctx& C, int L) {
    const int ntiles = *(const int*)(C.ws + WS_NTILES);
    pg8::Gemm g{(const bf16*)(C.ws + WS_HID), (const bf16*)(C.ws + WS_MOEW + (size_t)L * MOEW_LAYER + MOEW_D_OFF), ntiles * 256, 16 * 1024, 512};
    pg8::MoeOrder S{(const int*)(C.ws + WS_TILEE), ntiles, 4, C.G, C.blk};
    pg8::EpiStore E{(bf16*)(C.ws + WS_R1), DM, 4, DM, nullptr, 0};
    pg8::gemm_phase<pg8::EpiStore, pg8::MoeOrder, true, true>(C.lds, g, S, E);
}
struct PrepSeg { int col0, nvec; const float* gain; int rope; float scale; };
template <int NSEG> DI void prep_rows(Ctx& C, bf16* QKV, int ldq, const PrepSeg (&segs)[NSEG]) {
    const int gw = C.blk * NWAVES + C.wave, NGW = C.G * NWAVES, sub = C.lane & 7;
    const f32x2* ROPE = (const f32x2*)(C.ws + WS_ROPE);
    for (int row = gw; row < T; row += NGW) {
        const int t = row % SEQ;
#pragma unroll
        for (int sg = 0; sg < NSEG; ++sg) {
            for (int v0 = 0; v0 < segs[sg].nvec; v0 += 8) {
                const int vec = v0 + (C.lane >> 3); const bool act = vec < segs[sg].nvec; const int vv = act ? vec : 0;
                bf16* p = QKV + (size_t)row * ldq + segs[sg].col0 + vv * 64 + sub * 8;
                const v4u w = *(const v4u*)p;
                float x[8] = {bflo(w.x), bfhi(w.x), bflo(w.y), bfhi(w.y), bflo(w.z), bfhi(w.z), bflo(w.w), bfhi(w.w)};
                float ss = 0.f;
#pragma unroll
                for (int e = 0; e < 8; ++e) ss += x[e] * x[e];
                ss += __shfl_xor(ss, 1); ss += __shfl_xor(ss, 2); ss += __shfl_xor(ss, 4);
                const float r = 1.0f / sqrtf(ss * (1.0f / 64.0f) + EPS);
                const f32x4 g0 = *(const f32x4*)(segs[sg].gain + sub * 8), g1 = *(const f32x4*)(segs[sg].gain + sub * 8 + 4);
                const float gg[8] = {g0.x, g0.y, g0.z, g0.w, g1.x, g1.y, g1.z, g1.w};
#pragma unroll
                for (int e = 0; e < 8; ++e) x[e] = x[e] * r * gg[e];
                if (segs[sg].rope) {
#pragma unroll
                    for (int e = 0; e < 8; ++e) { const float pr = __shfl_xor(x[e], 4); const f32x2 cs = ROPE[t * 32 + (sub & 3) * 8 + e];
                        x[e] = (sub < 4) ? (x[e] * cs.x - pr * cs.y) : (pr * cs.y + x[e] * cs.x); }
                }
                const float sc = segs[sg].scale;
                v4u o; o.x = pk2(x[0] * sc, x[1] * sc); o.y = pk2(x[2] * sc, x[3] * sc); o.z = pk2(x[4] * sc, x[5] * sc); o.w = pk2(x[6] * sc, x[7] * sc);
                if (act) *(v4u*)p = o;
            }
        }
    }
}
DI float log_sigmoid(float x) { return (x < 0.f) ? (x - log1pf(expf(x))) : (-log1pf(expf(-x))); }
DI void fox_scan(Ctx& C) {
    const int gw = C.blk * NWAVES + C.wave, NGW = C.G * NWAVES;
    const float* FLOG = (const float*)(C.ws + WS_FLOG); float* CUM = (float*)(C.ws + WS_CUM);
    for (int task = gw; task < BATCH * 16; task += NGW) {
        const int b = task / 16, h = task % 16; const float bf = inp(C, I_FOX_BF)[h];
        const float* src = FLOG + ((size_t)b * SEQ + 64 * C.lane) * 16 + h;
        float run = 0.f;
        for (int i = 0; i < 64; ++i) run += log_sigmoid(src[(size_t)i * 16] + bf);
        float inc = run;
#pragma unroll
        for (int o = 1; o < 64; o <<= 1) { const float v = __shfl_up(inc, o); if (C.lane >= o) inc += v; }
        float acc = inc - run;
        float* dst = CUM + ((size_t)b * 16 + h) * SEQ + 64 * C.lane;
        for (int i = 0; i < 64; ++i) { acc += log_sigmoid(src[(size_t)i * 16] + bf); dst[i] = acc * LOG2E; }
    }
}
template <class AllowF, class BiasF>
DI void nattn(const bf16* qptr, const bf16* kbase, size_t kstride, const bf16* vbase, size_t vstride, int klo, int khi, AllowF allow, BiasF bias, float (&o)[64], float& m, float& l) {
    unsigned q[32];
#pragma unroll
    for (int c = 0; c < 8; ++c) { const v4u w = *(const v4u*)(qptr + 8 * c); q[4 * c] = w.x; q[4 * c + 1] = w.y; q[4 * c + 2] = w.z; q[4 * c + 3] = w.w; }
    m = -1e30f; l = 0.f;
#pragma unroll
    for (int d = 0; d < 64; ++d) o[d] = 0.f;
    for (int kk = klo; kk < khi; ++kk) {
        const bool ok = allow(kk);
        if (!__any(ok)) continue;
        const v4u* kp = (const v4u*)(kbase + (size_t)kk * kstride);
        float s = 0.f;
#pragma unroll
        for (int c = 0; c < 8; ++c) { const v4u w = kp[c];
            s += bflo(q[4 * c]) * bflo(w.x) + bfhi(q[4 * c]) * bfhi(w.x) + bflo(q[4 * c + 1]) * bflo(w.y) + bfhi(q[4 * c + 1]) * bfhi(w.y) + bflo(q[4 * c + 2]) * bflo(w.z) + bfhi(q[4 * c + 2]) * bfhi(w.z) + bflo(q[4 * c + 3]) * bflo(w.w) + bfhi(q[4 * c + 3]) * bfhi(w.w); }
        s += bias(kk);
        if (ok) {
            const float mn = fmaxf(m, s), a = exp2f(m - mn), p = exp2f(s - mn);
            l = l * a + p; m = mn;
            const v4u* vp = (const v4u*)(vbase + (size_t)kk * vstride);
#pragma unroll
            for (int c = 0; c < 8; ++c) { const v4u w = vp[c];
                o[8 * c] = o[8 * c] * a + p * bflo(w.x); o[8 * c + 1] = o[8 * c + 1] * a + p * bfhi(w.x); o[8 * c + 2] = o[8 * c + 2] * a + p * bflo(w.y); o[8 * c + 3] = o[8 * c + 3] * a + p * bfhi(w.y);
                o[8 * c + 4] = o[8 * c + 4] * a + p * bflo(w.z); o[8 * c + 5] = o[8 * c + 5] * a + p * bfhi(w.z); o[8 * c + 6] = o[8 * c + 6] * a + p * bflo(w.w); o[8 * c + 7] = o[8 * c + 7] * a + p * bfhi(w.w); }
        }
    }
}
DI void st_o64(bf16* p, const float (&o)[64], float sc) {
#pragma unroll
    for (int c = 0; c < 8; ++c) { v4u w; w.x = pk2(o[8 * c] * sc, o[8 * c + 1] * sc); w.y = pk2(o[8 * c + 2] * sc, o[8 * c + 3] * sc); w.z = pk2(o[8 * c + 4] * sc, o[8 * c + 5] * sc); w.w = pk2(o[8 * c + 6] * sc, o[8 * c + 7] * sc); *(v4u*)(p + 8 * c) = w; }
}
DI void attn_fox_naive(Ctx& C) {
    const int gw = C.blk * NWAVES + C.wave, NGW = C.G * NWAVES;
    const bf16* QKV = (const bf16*)(C.ws + WS_R1); bf16* O = (bf16*)(C.ws + WS_UO); const float* CUM = (const float*)(C.ws + WS_CUM);
    for (int task = gw; task < BATCH * 16 * 64; task += NGW) {
        const int chunk = task / 128, bh = task % 128, b = bh / 16, h = bh % 16, t = chunk * 64 + C.lane; const size_t row = (size_t)b * SEQ + t;
        const float* cum = CUM + (size_t)bh * SEQ; const float cq = cum[t];
        float o[64], m, l;
        nattn(QKV + row * 3072 + h * 64, QKV + (size_t)b * SEQ * 3072 + 1024 + h * 64, 3072, QKV + (size_t)b * SEQ * 3072 + 2048 + h * 64, 3072, 0, chunk * 64 + 64,
              [&](int kk) { return kk <= t; }, [&](int kk) { return cq - cum[kk]; }, o, m, l);
        st_o64(O + row * DM + h * 64, o, 1.0f / l);
    }
}
DI void attn_diff_naive(Ctx& C) {
    const int gw = C.blk * NWAVES + C.wave, NGW = C.G * NWAVES;
    const bf16* QKV = (const bf16*)(C.ws + WS_R1);
    for (int task = gw; task < BATCH * 16 * 64 * 2; task += NGW) {
        const int half = task & 1, t2 = task >> 1, chunk = t2 / 128, bh = t2 % 128, b = bh / 16, hh = bh % 16, t = chunk * 64 + C.lane; const size_t row = (size_t)b * SEQ + t;
        bf16* O = (bf16*)(C.ws + ((hh & 1) ? WS_O2 : WS_UO));
        float o[64], m, l;
        nattn(QKV + row * 3072 + hh * 64, QKV + (size_t)b * SEQ * 3072 + 1024 + hh * 64, 3072, QKV + (size_t)b * SEQ * 3072 + 2048 + (hh >> 1) * 128 + half * 64, 3072, 0, chunk * 64 + 64,
              [&](int kk) { return kk <= t; }, [&](int) { return 0.f; }, o, m, l);
        st_o64(O + row * DM + (hh >> 1) * 128 + half * 64, o, 1.0f / l);
    }
}
DI void diff_combine(Ctx& C) {
    const int gw = C.blk * NWAVES + C.wave, NGW = C.G * NWAVES;
    const float lam_init = 0.8f - 0.6f * expf(-0.3f * 3.0f);
    const float* lm = inp(C, I_DIFF_LAM);
    const float s01 = wave_sum(lm[C.lane] * lm[64 + C.lane]), s23 = wave_sum(lm[128 + C.lane] * lm[192 + C.lane]);
    const float lam = expf(s01) - expf(s23) + lam_init;
    bf16* O0 = (bf16*)(C.ws + WS_UO); const bf16* O1 = (const bf16*)(C.ws + WS_O2);
    for (int row = gw; row < T; row += NGW) {
        f32x4 a[4], bq[4]; ld_row_bf16(O0 + (size_t)row * DM, C.lane, a); ld_row_bf16(O1 + (size_t)row * DM, C.lane, bq);
#pragma unroll
        for (int j = 0; j < 4; ++j) { f32x4 d = a[j] - bq[j] * lam; float ss = (d.x * d.x + d.y * d.y) + (d.z * d.z + d.w * d.w);
            ss += __shfl_xor(ss, 1); ss += __shfl_xor(ss, 2); ss += __shfl_xor(ss, 4); ss += __shfl_xor(ss, 8); ss += __shfl_xor(ss, 16);
            const float r = (1.0f - lam_init) / sqrtf(ss * (1.0f / 128.0f) + EPS);
            const f32x4 g = *(const f32x4*)(inp(C, I_DIFF_SG) + ((4 * C.lane) & 127)); a[j] = d * r * g; }
        st_row_bf16(O0 + (size_t)row * DM, C.lane, a);
    }
}
DI void attn_dil_naive(Ctx& C, int gi, int dil) {
    const int gw = C.blk * NWAVES + C.wave, NGW = C.G * NWAVES;
    const bf16* QKV = (const bf16*)(C.ws + WS_R1); bf16* O = (bf16*)(C.ws + WS_O2); float* LSE = (float*)(C.ws + WS_LSE);
    const int sublen = SEQ / dil, nchunk = sublen / 64;
    for (int task = gw; task < BATCH * 16 * 64; task += NGW) {
        const int bh = task % 128, w = task / 128, b = bh / 16, h = bh % 16, r = w / nchunk, chunk = w % nchunk, u = chunk * 64 + C.lane;
        const size_t row = (size_t)b * SEQ + (size_t)u * dil + r; const size_t row0 = (size_t)b * SEQ + r;
        float o[64], m, l;
        const int klo = (chunk * 64 - 128) > 0 ? (chunk * 64 - 128) : 0;
        nattn(QKV + row * 3072 + h * 64, QKV + row0 * 3072 + 1024 + h * 64, (size_t)dil * 3072, QKV + row0 * 3072 + 2048 + h * 64, (size_t)dil * 3072, klo, chunk * 64 + 64,
              [&](int kk) { return kk <= u && u - kk <= 128; }, [&](int) { return 0.f; }, o, m, l);
        const float inv = 1.0f / l; float lse = m + log2f(l);
        bf16* op = O + row * DM + h * 64;
        if (gi == 0) { st_o64(op, o, inv); LSE[row * 16 + h] = lse; }
        else {
            const float lo = LSE[row * 16 + h], mx = fmaxf(lo, lse), ea = exp2f(lo - mx), eb = exp2f(lse - mx), rs = 1.0f / (ea + eb), fa = ea * rs, fb = eb * rs * inv;
#pragma unroll
            for (int c = 0; c < 8; ++c) { const v4u w = *(const v4u*)(op + 8 * c);
                o[8 * c] = bflo(w.x) * fa + o[8 * c] * fb; o[8 * c + 1] = bfhi(w.x) * fa + o[8 * c + 1] * fb; o[8 * c + 2] = bflo(w.y) * fa + o[8 * c + 2] * fb; o[8 * c + 3] = bfhi(w.y) * fa + o[8 * c + 3] * fb;
                o[8 * c + 4] = bflo(w.z) * fa + o[8 * c + 4] * fb; o[8 * c + 5] = bfhi(w.z) * fa + o[8 * c + 5] * fb; o[8 * c + 6] = bflo(w.w) * fa + o[8 * c + 6] * fb; o[8 * c + 7] = bfhi(w.w) * fa + o[8 * c + 7] * fb; }
            st_o64(op, o, 1.0f); LSE[row * 16 + h] = mx + log2f(ea + eb);
        }
    }
}
constexpr int NSA_LDQ = 2560;
DI void nsa_compress(Ctx& C) {
    const bf16* QKV = (const bf16*)(C.ws + WS_R1); const f32x2* ROPE = (const f32x2*)(C.ws + WS_ROPE);
    LAS float* vec = (LAS float*)C.lds;
    LAS float* part = (LAS float*)(C.lds + 65536);
    LAS float* hid = (LAS float*)(C.lds + 65536 + 8192);
    float* KC = (float*)(C.ws + WS_KC); float* VC = (float*)(C.ws + WS_VC);
    for (int task = C.blk; task < 1024; task += C.G) {
        const int which = task / 512, r = task % 512, b = r / 64, g = (r / 16) % 4, n0 = (r % 16) * 4;
        const int col = (which == 0 ? 1024 : 1280) + g * 64;
        const float* pos = inp(C, I_NSA_POS) + which * 4096;
        for (int idx = C.tid; idx < 16384; idx += NTHR) { const int tsk = idx >> 12, rem = idx & 4095, l = rem >> 6, d = rem & 63;
            const unsigned short raw = QKV[((size_t)b * SEQ + (n0 + tsk) * 64 + l) * NSA_LDQ + col + d];
            vec[idx] = __builtin_bit_cast(float, (unsigned)raw << 16) + pos[rem]; }
        __syncthreads();
        { const int j = C.tid & 127, pt = C.tid >> 7; float a0 = 0.f, a1 = 0.f, a2 = 0.f, a3 = 0.f;
          const float* w1 = inp(C, I_NSA_W1) + ((size_t)which * 4096 + pt * 1024) * 128 + j; const LAS float* vv = vec + pt * 1024;
#pragma unroll 8
          for (int k = 0; k < 1024; ++k) { const float w = w1[(size_t)k * 128]; a0 += vv[k] * w; a1 += vv[4096 + k] * w; a2 += vv[8192 + k] * w; a3 += vv[12288 + k] * w; }
          part[(pt * 4 + 0) * 128 + j] = a0; part[(pt * 4 + 1) * 128 + j] = a1; part[(pt * 4 + 2) * 128 + j] = a2; part[(pt * 4 + 3) * 128 + j] = a3; }
        __syncthreads();
        { const int tsk = C.tid >> 7, j = C.tid & 127; const float s = (part[(0 * 4 + tsk) * 128 + j] + part[(1 * 4 + tsk) * 128 + j]) + (part[(2 * 4 + tsk) * 128 + j] + part[(3 * 4 + tsk) * 128 + j]);
          hid[tsk * 128 + j] = s / (1.0f + expf(-s)); }
        __syncthreads();
        if (C.tid < 256) { const int tsk = C.tid >> 6, d = C.tid & 63; float o = 0.f;
            const float* w2 = inp(C, I_NSA_W2) + (size_t)which * 128 * 64 + d;
#pragma unroll 8
            for (int j = 0; j < 128; ++j) o += hid[tsk * 128 + j] * w2[j * 64];
            const size_t oi = (((size_t)b * 4 + g) * 64 + n0 + tsk) * 64 + d;
            if (which == 1) VC[oi] = o;
            else { const float ss = wave_sum(o * o); float y = o / sqrtf(ss * (1.0f / 64.0f) + EPS) * inp(C, I_NSA_KG)[d];
                const float pr = __shfl_xor(y, 32); const f32x2 cs = ROPE[((n0 + tsk) * 64 + 63) * 32 + (d & 31)];
                KC[oi] = (d < 32) ? (y * cs.x - pr * cs.y) : (pr * cs.y + y * cs.x); } }
        __syncthreads();
    }
}
DI float rdl(float v, int l) { return __builtin_bit_cast(float, __builtin_amdgcn_readlane(__builtin_bit_cast(int, v), l)); }
DI void nsa_cmp_select(Ctx& C) {
    const bf16* QKV = (const bf16*)(C.ws + WS_R1); bf16* OC = (bf16*)(C.ws + WS_O2); const float* GATE = (const float*)(C.ws + WS_GATE);
    const float* KC = (const float*)(C.ws + WS_KC); const float* VC = (const float*)(C.ws + WS_VC); unsigned long long* SELM = (unsigned long long*)(C.ws + WS_SELM);
    LAS float* kcT = (LAS float*)C.lds;
    LAS float* vcl = (LAS float*)(C.lds + 16384);
    for (int task = C.blk; task < BATCH * 4 * 8; task += C.G) {
        const int b = task / 32, g = (task / 8) % 4, cur = (task % 8) * 8 + C.wave;
        __syncthreads();
        for (int idx = C.tid; idx < 4096; idx += NTHR) { const int j = idx >> 6, d = idx & 63; kcT[d * 64 + j] = KC[((size_t)b * 4 + g) * 4096 + idx]; vcl[idx] = VC[((size_t)b * 4 + g) * 4096 + idx]; }
        __syncthreads();
        unsigned long long umask = 0ull;
        for (int tt = 0; tt < 64; ++tt) {
            const int t = cur * 64 + tt; const size_t row = (size_t)b * SEQ + t; const int nvalid = cur + (tt == 63 ? 1 : 0);
            const bool valid = C.lane < nvalid;
            float imp = 0.f;
#pragma unroll 1
            for (int p = 0; p < 4; ++p) {
                const int head = g * 4 + p;
                const float qv = __builtin_bit_cast(float, (unsigned)QKV[row * NSA_LDQ + head * 64 + C.lane] << 16);
                float s = 0.f;
#pragma unroll 8
                for (int d = 0; d < 64; ++d) s += rdl(qv, d) * kcT[d * 64 + C.lane];
                const float mx = wave_max(valid ? s : -1e30f); const float e = valid ? exp2f(s - mx) : 0.f;
                const float den = fmaxf(wave_sum(e), 1e-30f); const float pj = e / den;
                imp += pj;
                float o = 0.f;
#pragma unroll 8
                for (int j = 0; j < 64; ++j) o += rdl(pj, j) * vcl[j * 64 + C.lane];
                const float g0 = 1.0f / (1.0f + expf(-GATE[row * 48 + head]));
                OC[row * DM + head * 64 + C.lane] = (bf16)f2bf(g0 * o);
            }
            const float v = (C.lane > cur) ? -1.0f : ((C.lane == 0 || C.lane == cur || C.lane == cur - 1) ? 5.0f : imp);
            int rank = 0;
#pragma unroll 8
            for (int j = 0; j < 64; ++j) { const float vj = rdl(v, j); rank += (vj > v || (vj == v && j < C.lane)) ? 1 : 0; }
            unsigned long long mask = __ballot(rank < 16);
            if (cur < 63) mask &= ((2ull << cur) - 1ull);
            if (C.lane == 0) SELM[((size_t)b * 4 + g) * SEQ + t] = mask;
            umask |= mask;
        }
        if (C.lane == 0) ((unsigned long long*)(C.ws + 25 * MiB))[((size_t)b * 4 + g) * 64 + cur] = umask;
    }
    __syncthreads();
}
DI void attn_nsa_naive(Ctx& C) {
    const int gw = C.blk * NWAVES + C.wave, NGW = C.G * NWAVES;
    const bf16* QKV = (const bf16*)(C.ws + WS_R1); bf16* O = (bf16*)(C.ws + WS_UO); const bf16* OC = (const bf16*)(C.ws + WS_O2); const float* GATE = (const float*)(C.ws + WS_GATE);
    const unsigned long long* SELM = (const unsigned long long*)(C.ws + WS_SELM);
    for (int task = gw; task < BATCH * 16 * 64; task += NGW) {
        const int chunk = task / 128, bh = task % 128, b = bh / 16, head = bh % 16, g = head >> 2, t = chunk * 64 + C.lane; const size_t row = (size_t)b * SEQ + t;
        const size_t kb = (size_t)b * SEQ * NSA_LDQ;
        const unsigned long long mask = SELM[((size_t)b * 4 + g) * SEQ + t];
        float o[64], m, l;
        nattn(QKV + row * NSA_LDQ + head * 64, QKV + kb + 1536 + g * 64, NSA_LDQ, QKV + kb + 1792 + g * 64, NSA_LDQ, 0, chunk * 64 + 64,
              [&](int kk) { return ((mask >> (kk >> 6)) & 1ull) != 0ull && kk <= t; }, [&](int) { return 0.f; }, o, m, l);
        { const float g1 = 1.0f / (1.0f + expf(-GATE[row * 48 + 16 + head])) / l; const bf16* ocp = OC + row * DM + head * 64; bf16* op = O + row * DM + head * 64;
#pragma unroll
          for (int c = 0; c < 8; ++c) { const v4u w = *(const v4u*)(ocp + 8 * c); v4u r;
              r.x = pk2(bflo(w.x) + g1 * o[8 * c], bfhi(w.x) + g1 * o[8 * c + 1]); r.y = pk2(bflo(w.y) + g1 * o[8 * c + 2], bfhi(w.y) + g1 * o[8 * c + 3]);
              r.z = pk2(bflo(w.z) + g1 * o[8 * c + 4], bfhi(w.z) + g1 * o[8 * c + 5]); r.w = pk2(bflo(w.w) + g1 * o[8 * c + 6], bfhi(w.w) + g1 * o[8 * c + 7]); *(v4u*)(op + 8 * c) = r; } }
    }
    asm volatile("s_waitcnt vmcnt(0)" ::: "memory");
    for (int task = gw; task < BATCH * 16 * 64; task += NGW) {
        const int chunk = task / 128, bh = task % 128, b = bh / 16, head = bh % 16, g = head >> 2, t = chunk * 64 + C.lane; const size_t row = (size_t)b * SEQ + t;
        const size_t kb = (size_t)b * SEQ * NSA_LDQ;
        float o[64], m, l;
        const int klo = (chunk * 64 - 511) > 0 ? (chunk * 64 - 511) : 0;
        nattn(QKV + row * NSA_LDQ + head * 64, QKV + kb + 2048 + g * 64, NSA_LDQ, QKV + kb + 2304 + g * 64, NSA_LDQ, klo, chunk * 64 + 64,
              [&](int kk) { return kk <= t && t - kk < 512; }, [&](int) { return 0.f; }, o, m, l);
        { const float g2 = 1.0f / (1.0f + expf(-GATE[row * 48 + 32 + head])) / l; bf16* op = O + row * DM + head * 64;
#pragma unroll
          for (int c = 0; c < 8; ++c) { const v4u p = *(const v4u*)(op + 8 * c); v4u w;
              w.x = pk2(bflo(p.x) + g2 * o[8 * c], bfhi(p.x) + g2 * o[8 * c + 1]); w.y = pk2(bflo(p.y) + g2 * o[8 * c + 2], bfhi(p.y) + g2 * o[8 * c + 3]);
              w.z = pk2(bflo(p.z) + g2 * o[8 * c + 4], bfhi(p.z) + g2 * o[8 * c + 5]); w.w = pk2(bflo(p.w) + g2 * o[8 * c + 6], bfhi(p.w) + g2 * o[8 * c + 7]);
              *(v4u*)(op + 8 * c) = w; } }
    }
}
typedef short bf16x8 __attribute__((ext_vector_type(8)));
typedef short s16x4 __attribute__((ext_vector_type(4)));
typedef float f32x16 __attribute__((ext_vector_type(16)));
typedef __bf16 bf16x2_t __attribute__((ext_vector_type(2)));
namespace fa {
DI int crow(int i, int h) { return (i & 3) + 8 * (i >> 2) + 4 * h; }
DI void glds16(const void* gsrc, unsigned lds_dst) { unsigned keep;
    asm volatile("s_mov_b32 %0, m0\n\ts_mov_b32 m0, %2\n\ts_nop 0\n\tglobal_load_lds_dwordx4 %1, off\n\ts_mov_b32 m0, %0" : "=&s"(keep) : "v"(gsrc), "s"(lds_dst) : "memory"); }
#define FA_WAIT_BAR(N) asm volatile("s_waitcnt vmcnt(" #N ") lgkmcnt(0)\n\ts_barrier" ::: "memory")
DI unsigned cvtpk(float lo, float hi) { f32x2 v = {lo, hi}; bf16x2_t b = __builtin_convertvector(v, bf16x2_t); return __builtin_bit_cast(unsigned, b); }
DI float xmax32(float v) { float a = v, b = v; asm volatile("s_nop 1\n\tv_permlane32_swap_b32 %0, %1\n\ts_nop 1" : "+v"(a), "+v"(b)); return fmaxf(a, b); }
DI float xsum32(float v) { float a = v, b = v; asm volatile("s_nop 1\n\tv_permlane32_swap_b32 %0, %1\n\ts_nop 1" : "+v"(a), "+v"(b)); return a + b; }
typedef short v4i16_t __attribute__((ext_vector_type(4)));
DI s16x4 vtr(LAS const char* p) { return __builtin_bit_cast(s16x4, __builtin_amdgcn_ds_read_tr16_b64_v4i16((LAS v4i16_t*)p)); }
constexpr int KSLOT = 8192, KRING = 3 * KSLOT;
template <int DV, class Pre>
DI void tile(LAS const char* ks, LAS const char* vs, const bf16x8 (&qf)[4], int lane, Pre pre, f32x16 (&o)[DV / 32], float& m, float& l) {
    const int r = lane & 31, h = lane >> 5;
    f32x16 p0, p1;
#pragma unroll
    for (int i = 0; i < 16; ++i) { p0[i] = 0.f; p1[i] = 0.f; }
    LAS const char* kb = ks + h * 1024 + r * 16;
#pragma unroll
    for (int d0 = 0; d0 < 4; ++d0) {
        const bf16x8 a0 = *(LAS const bf16x8*)(kb + d0 * 2048), a1 = *(LAS const bf16x8*)(kb + d0 * 2048 + 512);
        p0 = __builtin_amdgcn_mfma_f32_32x32x16_bf16(a0, qf[d0], p0, 0, 0, 0);
        p1 = __builtin_amdgcn_mfma_f32_32x32x16_bf16(a1, qf[d0], p1, 0, 0, 0);
    }
    pre(p0, p1);
    float mx = fmaxf(p0[0], p1[0]);
#pragma unroll
    for (int i = 1; i < 16; ++i) mx = fmaxf(mx, fmaxf(p0[i], p1[i]));
    mx = xmax32(mx);
    const float mn = fmaxf(m, mx);
    if (__any(mn > m)) { const float a = __builtin_amdgcn_exp2f(m - mn); l *= a;
#pragma unroll
        for (int b = 0; b < DV / 32; ++b)
#pragma unroll
            for (int i = 0; i < 16; ++i) o[b][i] *= a; }
    m = mn;
    float sum = 0.f;
#pragma unroll
    for (int i = 0; i < 16; ++i) { p0[i] = __builtin_amdgcn_exp2f(p0[i] - mn); p1[i] = __builtin_amdgcn_exp2f(p1[i] - mn); sum += p0[i] + p1[i]; }
    l += sum;
    bf16x8 pf[4];
#pragma unroll
    for (int s = 0; s < 2; ++s) {
        v4u w0, w1;
        w0.x = cvtpk(p0[8 * s], p0[8 * s + 1]); w0.y = cvtpk(p0[8 * s + 2], p0[8 * s + 3]); w0.z = cvtpk(p0[8 * s + 4], p0[8 * s + 5]); w0.w = cvtpk(p0[8 * s + 6], p0[8 * s + 7]);
        w1.x = cvtpk(p1[8 * s], p1[8 * s + 1]); w1.y = cvtpk(p1[8 * s + 2], p1[8 * s + 3]); w1.z = cvtpk(p1[8 * s + 4], p1[8 * s + 5]); w1.w = cvtpk(p1[8 * s + 6], p1[8 * s + 7]);
        pf[s] = __builtin_bit_cast(bf16x8, w0); pf[2 + s] = __builtin_bit_cast(bf16x8, w1);
    }
    LAS const char* vb = vs + ((lane >> 4) & 1) * 32 + (lane & 3) * 8 + (4 * h + ((lane & 15) >> 2)) * 64;
#pragma unroll
    for (int b = 0; b < DV / 32; ++b)
#pragma unroll
        for (int kq = 0; kq < 4; ++kq) {
            const s16x4 lo = vtr(vb + (b * 4 + kq) * 1024), hi = vtr(vb + (b * 4 + kq) * 1024 + 512);
            const bf16x8 vf = {lo[0], lo[1], lo[2], lo[3], hi[0], hi[1], hi[2], hi[3]};
            o[b] = __builtin_amdgcn_mfma_f32_32x32x16_bf16(vf, pf[kq], o[b], 0, 0, 0);
        }
}
template <int DV, class KP, class VP, class Act, class Pre>
DI void loop(LAS char* shm, int wid, int lane, const bf16x8 (&qf)[4], int ntiles, KP kp, VP vp, Act act, Pre pre, f32x16 (&o)[DV / 32], float& m, float& l) {
    constexpr int VSLOT = DV * 128;
    const unsigned ldsK = (unsigned)(size_t)shm, ldsV = ldsK + KRING;
#define FA_ISSUE(i, s) do { glds16(kp(i), (unsigned)__builtin_amdgcn_readfirstlane(ldsK + (s) * KSLOT + wid * 1024)); \
        _Pragma("unroll") for (int pc_ = 0; pc_ < DV / 64; ++pc_) glds16(vp((i), wid + 8 * pc_), (unsigned)__builtin_amdgcn_readfirstlane(ldsV + (s) * VSLOT + (wid + 8 * pc_) * 1024)); } while (0)
    if (ntiles > 0) FA_ISSUE(0, 0);
    if (ntiles > 1) FA_ISSUE(1, 1);
    int sc = 0, sn2 = 2;
    for (int i = 0; i < ntiles; ++i) {
        if (i + 1 < ntiles) { if (DV == 64) FA_WAIT_BAR(2); else FA_WAIT_BAR(3); } else FA_WAIT_BAR(0);
        if (i + 2 < ntiles) FA_ISSUE(i + 2, sn2);
        if (act(i)) tile<DV>((LAS const char*)shm + sc * KSLOT, (LAS const char*)shm + KRING + sc * VSLOT, qf, lane, [&](f32x16& p0, f32x16& p1) { pre(i, p0, p1); }, o, m, l);
        sc = (sc == 2) ? 0 : sc + 1; sn2 = (sn2 == 2) ? 0 : sn2 + 1;
    }
    FA_WAIT_BAR(0);
#undef FA_ISSUE
}
template <int DV>
DI void store_o(bf16* orow, int h, const f32x16 (&o)[DV / 32], float sc) {
#pragma unroll
    for (int b = 0; b < DV / 32; ++b)
#pragma unroll
        for (int g4 = 0; g4 < 4; ++g4) { v2u w; w.x = cvtpk(o[b][4 * g4] * sc, o[b][4 * g4 + 1] * sc); w.y = cvtpk(o[b][4 * g4 + 2] * sc, o[b][4 * g4 + 3] * sc);
            *(v2u*)(orow + 32 * b + 8 * g4 + 4 * h) = w; }
}
}
constexpr int FA_CUM_OFF = 98304;
DI void attn_fox_fast(Ctx& C) {
    const int vblk = (C.blk % 8) * (C.G / 8) + C.blk / 8;
    const bf16* QKV = (const bf16*)(C.ws + WS_R1); bf16* O = (bf16*)(C.ws + WS_UO); const float* CUM = (const float*)(C.ws + WS_CUM);
    const int lane = C.lane, wid = C.wave, r = lane & 31, h2 = lane >> 5;
    LAS float* cumL = (LAS float*)(C.lds + FA_CUM_OFF);
    const int nunits = BATCH * 16 * 16, per = (nunits + C.G - 1) / C.G;
    for (int ui = 0; ui < per; ++ui) {
        const int u = vblk * per + ui; if (u >= nunits) break;
        const int bh = u / 16, k16 = u % 16, pair = k16 >> 1, qblk = (k16 & 1) ? (15 - pair) : pair;
        const int b = bh / 16, hd = bh % 16;
        const float* cum = CUM + (size_t)bh * SEQ;
        const int nt = 4 * qblk + 4;
        for (int i = C.tid; i < nt * 16; i += NTHR) *(LAS f32x4*)(cumL + 4 * i) = *(const f32x4*)(cum + 4 * i);
        const int tq = 256 * qblk + 32 * wid + r; const size_t row = (size_t)b * SEQ + tq;
        bf16x8 qf[4];
#pragma unroll
        for (int d0 = 0; d0 < 4; ++d0) qf[d0] = *(const bf16x8*)(QKV + row * 3072 + hd * 64 + d0 * 16 + h2 * 8);
        const float cq = cum[tq];
        const bf16* kbase = QKV + (size_t)b * SEQ * 3072 + 1024 + hd * 64 + (size_t)lane * 3072 + wid * 8;
        const bf16* vbase = QKV + (size_t)b * SEQ * 3072 + 2048 + hd * 64 + (size_t)(16 * (wid & 3) + (lane >> 2)) * 3072 + (wid >> 2) * 32 + (lane & 3) * 8;
        const int jdiag = 4 * qblk + (wid >> 1), qloc = 32 * (wid & 1) + r;
        f32x16 o[2]; float m = -1e30f, l = 0.f;
#pragma unroll
        for (int i = 0; i < 16; ++i) { o[0][i] = 0.f; o[1][i] = 0.f; }
        asm volatile("s_waitcnt lgkmcnt(0)" ::: "memory"); __builtin_amdgcn_s_barrier();
        fa::loop<64>((LAS char*)C.lds, wid, lane, qf, nt,
            [&](int i) { return kbase + (size_t)(nt - 1 - i) * 64 * 3072; },
            [&](int i, int) { return vbase + (size_t)(nt - 1 - i) * 64 * 3072; },
            [&](int i) { return (nt - 1 - i) <= jdiag; },
            [&](int i, f32x16& p0, f32x16& p1) { const int j = nt - 1 - i; const LAS float* cl = cumL + 64 * j + 4 * h2;
#pragma unroll
                for (int g4 = 0; g4 < 4; ++g4) { const f32x4 c0 = *(const LAS f32x4*)(cl + 8 * g4), c1 = *(const LAS f32x4*)(cl + 32 + 8 * g4);
                    p0[4 * g4] += cq - c0.x; p0[4 * g4 + 1] += cq - c0.y; p0[4 * g4 + 2] += cq - c0.z; p0[4 * g4 + 3] += cq - c0.w;
                    p1[4 * g4] += cq - c1.x; p1[4 * g4 + 1] += cq - c1.y; p1[4 * g4 + 2] += cq - c1.z; p1[4 * g4 + 3] += cq - c1.w; }
                if (j == jdiag) {
#pragma unroll
                    for (int ii = 0; ii < 16; ++ii) { const int kv = fa::crow(ii, h2); if (kv > qloc) p0[ii] = -INFINITY; if (kv + 32 > qloc) p1[ii] = -INFINITY; } } },
            o, m, l);
        l = fa::xsum32(l);
        fa::store_o<64>(O + row * DM + hd * 64, h2, o, 1.0f / l);
    }
}
DI void attn_diff_fast(Ctx& C) {
    const int vblk = (C.blk % 8) * (C.G / 8) + C.blk / 8;
    const bf16* QKV = (const bf16*)(C.ws + WS_R1);
    const int lane = C.lane, wid = C.wave, r = lane & 31, h2 = lane >> 5;
    const int nunits = BATCH * 16 * 16, per = (nunits + C.G - 1) / C.G;
    for (int ui = 0; ui < per; ++ui) {
        const int u = vblk * per + ui; if (u >= nunits) break;
        const int bh = u / 16, k16 = u % 16, pair = k16 >> 1, qblk = (k16 & 1) ? (15 - pair) : pair;
        const int b = bh / 16, hh = bh % 16;
        bf16* O = (bf16*)(C.ws + ((hh & 1) ? WS_O2 : WS_UO));
        const int nt = 4 * qblk + 4;
        const int tq = 256 * qblk + 32 * wid + r; const size_t row = (size_t)b * SEQ + tq;
        bf16x8 qf[4];
#pragma unroll
        for (int d0 = 0; d0 < 4; ++d0) qf[d0] = *(const bf16x8*)(QKV + row * 3072 + hh * 64 + d0 * 16 + h2 * 8);
        const bf16* kbase = QKV + (size_t)b * SEQ * 3072 + 1024 + hh * 64 + (size_t)lane * 3072 + wid * 8;
        const bf16* vbase = QKV + (size_t)b * SEQ * 3072 + 2048 + (hh >> 1) * 128 + (size_t)(16 * (wid & 3) + (lane >> 2)) * 3072 + (wid >> 2) * 32 + (lane & 3) * 8;
        const int jdiag = 4 * qblk + (wid >> 1), qloc = 32 * (wid & 1) + r;
        f32x16 o[4]; float m = -1e30f, l = 0.f;
#pragma unroll
        for (int bq = 0; bq < 4; ++bq)
#pragma unroll
            for (int i = 0; i < 16; ++i) o[bq][i] = 0.f;
        fa::loop<128>((LAS char*)C.lds, wid, lane, qf, nt,
            [&](int i) { return kbase + (size_t)(nt - 1 - i) * 64 * 3072; },
            [&](int i, int pc) { return vbase + (size_t)(nt - 1 - i) * 64 * 3072 + (pc >= 8 ? 64 : 0); },
            [&](int i) { return (nt - 1 - i) <= jdiag; },
            [&](int i, f32x16& p0, f32x16& p1) { const int j = nt - 1 - i;
                if (j == jdiag) {
#pragma unroll
                    for (int ii = 0; ii < 16; ++ii) { const int kv = fa::crow(ii, h2); if (kv > qloc) p0[ii] = -INFINITY; if (kv + 32 > qloc) p1[ii] = -INFINITY; } } },
            o, m, l);
        l = fa::xsum32(l);
        fa::store_o<128>(O + row * DM + (hh >> 1) * 128, h2, o, 1.0f / l);
    }
}
DI void attn_dil_fast(Ctx& C, int gi, int dil) {
    const int vblk = (C.blk % 8) * (C.G / 8) + C.blk / 8;
    const bf16* QKV = (const bf16*)(C.ws + WS_R1); bf16* O = (bf16*)(C.ws + WS_O2); float* LSE = (float*)(C.ws + WS_LSE);
    const int lane = C.lane, wid = C.wave, r = lane & 31, h2 = lane >> 5;
    const int nub = (SEQ / dil) / 256;
    const int nunits = BATCH * 16 * 16, per = (nunits + C.G - 1) / C.G;
    for (int ui = 0; ui < per; ++ui) {
        const int u = vblk * per + ui; if (u >= nunits) break;
        const int bh = u / 16, k16 = u % 16, b = bh / 16, hd = bh % 16, res = k16 / nub, ublk = k16 % nub;
        const int uq = 256 * ublk + 32 * wid + r; const size_t row = (size_t)b * SEQ + (size_t)uq * dil + res; const size_t row0 = (size_t)b * SEQ + res;
        bf16x8 qf[4];
#pragma unroll
        for (int d0 = 0; d0 < 4; ++d0) qf[d0] = *(const bf16x8*)(QKV + row * 3072 + hd * 64 + d0 * 16 + h2 * 8);
        const size_t rs = (size_t)dil * 3072;
        const bf16* kbase = QKV + row0 * 3072 + 1024 + hd * 64 + (size_t)lane * rs + wid * 8;
        const bf16* vbase = QKV + row0 * 3072 + 2048 + hd * 64 + (size_t)(16 * (wid & 3) + (lane >> 2)) * rs + (wid >> 2) * 32 + (lane & 3) * 8;
        const int jlo = (4 * ublk - 2) > 0 ? (4 * ublk - 2) : 0, nt = 4 * ublk + 4 - jlo;
        const int jw_hi = 4 * ublk + (wid >> 1), jw_lo = jw_hi - 2;
        f32x16 o[2]; float m = -1e30f, l = 0.f;
#pragma unroll
        for (int i = 0; i < 16; ++i) { o[0][i] = 0.f; o[1][i] = 0.f; }
        fa::loop<64>((LAS char*)C.lds, wid, lane, qf, nt,
            [&](int i) { return kbase + (size_t)(jlo + i) * 64 * rs; },
            [&](int i, int) { return vbase + (size_t)(jlo + i) * 64 * rs; },
            [&](int i) { const int j = jlo + i; return j >= jw_lo && j <= jw_hi; },
            [&](int i, f32x16& p0, f32x16& p1) { const int dlt = uq - 64 * (jlo + i);
#pragma unroll
                for (int ii = 0; ii < 16; ++ii) { const int d0 = dlt - fa::crow(ii, h2), d1 = d0 - 32;
                    if (d0 < 0 || d0 > 128) p0[ii] = -INFINITY; if (d1 < 0 || d1 > 128) p1[ii] = -INFINITY; } },
            o, m, l);
        l = fa::xsum32(l);
        const float inv = 1.0f / l, lse = m + log2f(l);
        bf16* op = O + row * DM + hd * 64;
        if (gi == 0) { fa::store_o<64>(op, h2, o, inv); if (h2 == 0) LSE[row * 16 + hd] = lse; }
        else {
            const float lo = LSE[row * 16 + hd], mx = fmaxf(lo, lse), ea = __builtin_amdgcn_exp2f(lo - mx), eb = __builtin_amdgcn_exp2f(lse - mx), rs2 = 1.0f / (ea + eb), fa_ = ea * rs2, fb = eb * rs2 * inv;
#pragma unroll
            for (int bq = 0; bq < 2; ++bq)
#pragma unroll
                for (int g4 = 0; g4 < 4; ++g4) { const v2u w = *(const v2u*)(op + 32 * bq + 8 * g4 + 4 * h2);
                    o[bq][4 * g4] = bflo(w.x) * fa_ + o[bq][4 * g4] * fb; o[bq][4 * g4 + 1] = bfhi(w.x) * fa_ + o[bq][4 * g4 + 1] * fb;
                    o[bq][4 * g4 + 2] = bflo(w.y) * fa_ + o[bq][4 * g4 + 2] * fb; o[bq][4 * g4 + 3] = bfhi(w.y) * fa_ + o[bq][4 * g4 + 3] * fb; }
            asm volatile("" ::: "memory");
            fa::store_o<64>(op, h2, o, 1.0f);
            if (h2 == 0) LSE[row * 16 + hd] = mx + log2f(ea + eb);
        }
    }
}
constexpr size_t WS_USELM_ = 25 * MiB;
DI void attn_nsa_fast(Ctx& C) {
    const int vblk = (C.blk % 8) * (C.G / 8) + C.blk / 8;
    const bf16* QKV = (const bf16*)(C.ws + WS_R1); bf16* O = (bf16*)(C.ws + WS_UO); const bf16* OC = (const bf16*)(C.ws + WS_O2); const float* GATE = (const float*)(C.ws + WS_GATE);
    const unsigned long long* SELM = (const unsigned long long*)(C.ws + WS_SELM); const unsigned long long* USELM = (const unsigned long long*)(C.ws + 25 * MiB);
    const int lane = C.lane, wid = C.wave, r = lane & 31, h2 = lane >> 5;
    LAS int* jl = (LAS int*)(C.lds + FA_CUM_OFF);
    const int nunits = BATCH * 4 * 64, per = (nunits + C.G - 1) / C.G;
    for (int ui = 0; ui < per; ++ui) {
        const int u = vblk * per + ui; if (u >= nunits) break;
        const int bg = u / 64, k64 = u % 64, sub = k64 >> 3, i8 = k64 & 7, c = (i8 & 1) ? (16 * (i8 >> 1) + 15 - sub) : (16 * (i8 >> 1) + sub);
        const int b = bg / 4, g = bg % 4, head = 4 * g + (wid >> 1);
        const int qloc = 32 * (wid & 1) + r, t = 64 * c + qloc; const size_t row = (size_t)b * SEQ + t;
        bf16x8 qf[4];
#pragma unroll
        for (int d0 = 0; d0 < 4; ++d0) qf[d0] = *(const bf16x8*)(QKV + row * NSA_LDQ + head * 64 + d0 * 16 + h2 * 8);
        const unsigned long long mymask = SELM[((size_t)b * 4 + g) * SEQ + t];
        unsigned long long U = USELM[((size_t)b * 4 + g) * 64 + c];
        { const unsigned ulo = __builtin_amdgcn_readfirstlane((unsigned)U), uhi = __builtin_amdgcn_readfirstlane((unsigned)(U >> 32)); U = ((unsigned long long)uhi << 32) | ulo; }
        const int nsel = __builtin_popcountll(U);
        if (wid == 0) { if ((U >> lane) & 1ull) jl[__builtin_popcountll(U & ((1ull << lane) - 1ull))] = lane; }
        unsigned wlo = (unsigned)mymask, whi = (unsigned)(mymask >> 32);
#pragma unroll
        for (int of = 1; of < 32; of <<= 1) { wlo |= __shfl_xor(wlo, of); whi |= __shfl_xor(whi, of); }
        const unsigned long long Uw = ((unsigned long long)__builtin_amdgcn_readfirstlane(whi) << 32) | __builtin_amdgcn_readfirstlane(wlo);
        asm volatile("s_waitcnt lgkmcnt(0)" ::: "memory"); __builtin_amdgcn_s_barrier();
        const size_t kb = (size_t)b * SEQ * NSA_LDQ;
        const size_t koff = (size_t)lane * NSA_LDQ + wid * 8, voff = (size_t)(16 * (wid & 3) + (lane >> 2)) * NSA_LDQ + (wid >> 2) * 32 + (lane & 3) * 8;
        f32x16 o1[2]; float m1 = -1e30f, l1 = 0.f;
#pragma unroll
        for (int i = 0; i < 16; ++i) { o1[0][i] = 0.f; o1[1][i] = 0.f; }
        { const bf16* kbase = QKV + kb + 1536 + g * 64 + koff; const bf16* vbase = QKV + kb + 1792 + g * 64 + voff;
          fa::loop<64>((LAS char*)C.lds, wid, lane, qf, nsel,
            [&](int i) { return kbase + (size_t)jl[i] * 64 * NSA_LDQ; },
            [&](int i, int) { return vbase + (size_t)jl[i] * 64 * NSA_LDQ; },
            [&](int i) { const int j = __builtin_amdgcn_readfirstlane(jl[i]); return ((Uw >> j) & 1ull) != 0ull; },
            [&](int i, f32x16& p0, f32x16& p1) { const int j = __builtin_amdgcn_readfirstlane(jl[i]);
                if (!((mymask >> j) & 1ull)) {
#pragma unroll
                    for (int ii = 0; ii < 16; ++ii) { p0[ii] = -INFINITY; p1[ii] = -INFINITY; } }
                if (j == c) {
#pragma unroll
                    for (int ii = 0; ii < 16; ++ii) { const int kv = fa::crow(ii, h2); if (kv > qloc) p0[ii] = -INFINITY; if (kv + 32 > qloc) p1[ii] = -INFINITY; } } },
            o1, m1, l1); }
        l1 = fa::xsum32(l1);
        f32x16 o2[2]; float m2 = -1e30f, l2 = 0.f;
#pragma unroll
        for (int i = 0; i < 16; ++i) { o2[0][i] = 0.f; o2[1][i] = 0.f; }
        { const bf16* kbase = QKV + kb + 2048 + g * 64 + koff; const bf16* vbase = QKV + kb + 2304 + g * 64 + voff;
          const int jlo = (c - 8) > 0 ? (c - 8) : 0, nt = c - jlo + 1;
          fa::loop<64>((LAS char*)C.lds, wid, lane, qf, nt,
            [&](int i) { return kbase + (size_t)(jlo + i) * 64 * NSA_LDQ; },
            [&](int i, int) { return vbase + (size_t)(jlo + i) * 64 * NSA_LDQ; },
            [&](int) { return true; },
            [&](int i, f32x16& p0, f32x16& p1) { const int j = jlo + i;
                if (j == c) {
#pragma unroll
                    for (int ii = 0; ii < 16; ++ii) { const int kv = fa::crow(ii, h2); if (kv > qloc) p0[ii] = -INFINITY; if (kv + 32 > qloc) p1[ii] = -INFINITY; } }
                if (j == c - 8) {
#pragma unroll
                    for (int ii = 0; ii < 16; ++ii) { const int kv = fa::crow(ii, h2); if (kv <= qloc) p0[ii] = -INFINITY; if (kv + 32 <= qloc) p1[ii] = -INFINITY; } } },
            o2, m2, l2); }
        l2 = fa::xsum32(l2);
        const float g1 = 1.0f / (1.0f + expf(-GATE[row * 48 + 16 + head])) / l1, g2 = 1.0f / (1.0f + expf(-GATE[row * 48 + 32 + head])) / l2;
        const bf16* ocp = OC + row * DM + head * 64; bf16* op = O + row * DM + head * 64;
#pragma unroll
        for (int bq = 0; bq < 2; ++bq)
#pragma unroll
            for (int g4 = 0; g4 < 4; ++g4) { const v2u w = *(const v2u*)(ocp + 32 * bq + 8 * g4 + 4 * h2); v2u ov;
                ov.x = fa::cvtpk(bflo(w.x) + g1 * o1[bq][4 * g4] + g2 * o2[bq][4 * g4], bfhi(w.x) + g1 * o1[bq][4 * g4 + 1] + g2 * o2[bq][4 * g4 + 1]);
                ov.y = fa::cvtpk(bflo(w.y) + g1 * o1[bq][4 * g4 + 2] + g2 * o2[bq][4 * g4 + 2], bfhi(w.y) + g1 * o1[bq][4 * g4 + 3] + g2 * o2[bq][4 * g4 + 3]);
                *(v2u*)(op + 32 * bq + 8 * g4 + 4 * h2) = ov; }
    }
}
__global__ void __launch_bounds__(NTHR, 2) hybrid_fwd(Args args) {
    extern __shared__ __attribute__((aligned(16))) unsigned char lds_raw[];
    Ctx C;
    C.hbuf = args.out; C.ws = args.ws; C.lds = (LAS unsigned char*)lds_raw;
    C.tid = threadIdx.x; C.lane = C.tid & 63; C.wave = __builtin_amdgcn_readfirstlane(C.tid >> 6); C.G = gridDim.x; C.blk = blockIdx.x;
    volatile LAS unsigned* MISC = (volatile LAS unsigned*)(C.lds + MISC_OFF);
    if (C.tid < 32) MISC[C.tid] = 0u;
    if (C.tid == 0) {
#pragma unroll
        for (int i = 0; i < N_IN; ++i) ((LAS unsigned long long*)(C.lds + PTR_OFF))[i] = (unsigned long long)args.in[i];
    }
    __syncthreads();
    const int lo = args.ph_lo, hi = args.ph_hi;
    unsigned* barw = (unsigned*)(C.ws + WS_CTL) + CW_BAR;
    XcdBarrier bar; bar.bar = barw; bar.x = 0; bar.st = nullptr;
    if (hi - lo > 1) bar = xcd_barrier_post(barw, MISC + 8);
    int ph = 0;
#ifndef DBG_ONLY
#define DBG_ONLY -1
#endif
#define PHASE(tag, ...) do { if ((DBG_ONLY < 0 || DBG_ONLY == (tag)) && lo <= ph && ph < hi) { { int t_ = threadIdx.x; asm volatile("" : "+v"(t_)); C.tid = t_; C.lane = t_ & 63; } __VA_ARGS__; if (ph + 1 < hi) xcd_barrier(bar); } ++ph; } while (0)
    bf16* const UO = (bf16*)(C.ws + WS_UO); bf16* const O2 = (bf16*)(C.ws + WS_O2); bf16* const R1 = (bf16*)(C.ws + WS_R1);
    const float* const WQ_ = nullptr; (void)WQ_;

    PHASE(0, phase_p0a(C));
    PHASE(0, phase_p0b(C));
    PHASE(1, phase_n1<0>(C));
    PHASE(2, gemm_qkv(C, UO, (const bf16*)(C.ws + WS_FOXWIN), FOX_NPAD, R1, 3072, 3072, (float*)(C.ws + WS_FLOG), 16));
    PHASE(3, { const PrepSeg segs[2] = {{0, 16, inp(C, I_FOX_QG), 0, QSC}, {1024, 16, inp(C, I_FOX_KG), 0, 1.0f}}; prep_rows<2>(C, R1, 3072, segs); fox_scan(C); });
    PHASE(4, attn_fox_fast(C));
    PHASE(2, gemm_qkv(C, UO, (const bf16*)(C.ws + WS_WOUT), DM, R1, DM, DM, nullptr, 0));
    PHASE(5, phase_n2<0>(C, R1));
    PHASE(6, phase_s(C));
    PHASE(7, gemm_moe1(C, 0));
    PHASE(8, gemm_moe2(C, 0));
    PHASE(1, phase_n1<1>(C));
    PHASE(2, gemm_qkv(C, UO, (const bf16*)(C.ws + WS_NSAWIN), NSA_NPAD, R1, NSA_LDQ, NSA_LDQ, (float*)(C.ws + WS_GATE), 48));
    PHASE(3, { const PrepSeg segs[3] = {{0, 16, inp(C, I_NSA_QG), 1, QSC}, {1536, 4, inp(C, I_NSA_KG) + 64, 1, 1.0f}, {2048, 4, inp(C, I_NSA_KG) + 128, 1, 1.0f}}; prep_rows<3>(C, R1, NSA_LDQ, segs); nsa_compress(C); });
    PHASE(9, nsa_cmp_select(C));
    PHASE(10, attn_nsa_fast(C));
    PHASE(2, gemm_qkv(C, UO, (const bf16*)(C.ws + WS_WOUT + 2 * MiB), DM, R1, DM, DM, nullptr, 0));
    PHASE(5, phase_n2<1>(C, R1));
    PHASE(6, phase_s(C));
    PHASE(7, gemm_moe1(C, 1));
    PHASE(8, gemm_moe2(C, 1));
    PHASE(1, phase_n1<2>(C));
#pragma unroll
    for (int gi = 0; gi < 3; ++gi) {
        const int dil = (gi == 0) ? 1 : (gi == 1) ? 4 : 16;
        PHASE(2, gemm_qkv(C, UO, (const bf16*)(C.ws + WS_DILWIN) + (size_t)gi * 3072 * DM, 3072, R1, 3072, 3072, nullptr, 0));
        PHASE(3, { const PrepSeg segs[2] = {{0, 16, inp(C, I_DIL_QG), 1, QSC}, {1024, 16, inp(C, I_DIL_KG), 1, 1.0f}}; prep_rows<2>(C, R1, 3072, segs); });
        PHASE(11, attn_dil_fast(C, gi, dil));
    }
    PHASE(2, gemm_qkv(C, O2, (const bf16*)(C.ws + WS_WOUT + 4 * MiB), DM, R1, DM, DM, nullptr, 0));
    PHASE(5, phase_n2<2>(C, R1));
    PHASE(6, phase_s(C));
    PHASE(7, gemm_moe1(C, 2));
    PHASE(8, gemm_moe2(C, 2));
    PHASE(1, phase_n1<3>(C));
    PHASE(2, gemm_qkv(C, UO, (const bf16*)(C.ws + WS_DIFFWIN), 3072, R1, 3072, 3072, nullptr, 0));
    PHASE(3, { const PrepSeg segs[2] = {{0, 16, inp(C, I_DIFF_QG), 1, QSC}, {1024, 16, inp(C, I_DIFF_KG), 1, 1.0f}}; prep_rows<2>(C, R1, 3072, segs); });
    PHASE(12, attn_diff_fast(C));
    PHASE(13, diff_combine(C));
    PHASE(2, gemm_qkv(C, UO, (const bf16*)(C.ws + WS_WOUT + 6 * MiB), DM, R1, DM, DM, nullptr, 0));
    PHASE(5, phase_n2<3>(C, R1));
    PHASE(6, phase_s(C));
    PHASE(7, gemm_moe1(C, 3));
    PHASE(8, gemm_moe2(C, 3));
    PHASE(1, phase_final(C));
#undef PHASE
}
constexpr int N_PHASES = 2 + 9 + 10 + 15 + 10 + 1;

#ifndef MK_PER_PHASE
#define MK_PER_PHASE 0
#endif
extern "C" void kernel_launch(void* const* d_in, const int* in_sizes, int n_in, void* d_out, int out_size, void* d_ws, size_t ws_size, hipStream_t stream) {
    static int grid = 0;
    if (grid == 0) {
        if (n_in != N_IN || out_size != T * DM || ws_size < WS_END) { fprintf(stderr, "kernel_launch: unexpected shapes (n_in %d out %d ws %zu)\n", n_in, out_size, ws_size); grid = -1; return; }
        int dev = 0, cus = 0, per_cu = 0;
        if (hipGetDevice(&dev) != hipSuccess || hipDeviceGetAttribute(&cus, hipDeviceAttributeMultiprocessorCount, dev) != hipSuccess) { grid = -1; return; }
        if (hipFuncSetAttribute((const void*)hybrid_fwd, hipFuncAttributeMaxDynamicSharedMemorySize, LDS_BYTES) != hipSuccess) { fprintf(stderr, "kernel_launch: hipFuncSetAttribute failed\n"); grid = -1; return; }
        if (hipOccupancyMaxActiveBlocksPerMultiprocessor(&per_cu, (const void*)hybrid_fwd, NTHR, LDS_BYTES) != hipSuccess || per_cu < 1) fprintf(stderr, "kernel_launch: occupancy query reports %d\n", per_cu);
        (void)hipGetLastError();
        grid = (cus >= 256) ? 256 : (cus >= 128) ? 128 : 64;
    }
    if (grid < 0) return;
    (void)hipMemsetAsync((char*)d_ws + WS_CTL, 0, CTL_ZERO_BYTES, stream);
    Args a{};
    for (int i = 0; i < N_IN; ++i) a.in[i] = (const float*)d_in[i];
    a.out = (float*)d_out; a.ws = (unsigned char*)d_ws;
#if MK_PER_PHASE
    for (int p = 0; p < N_PHASES; ++p) { a.ph_lo = p; a.ph_hi = p + 1; hipLaunchKernelGGL(hybrid_fwd, dim3(grid), dim3(NTHR), LDS_BYTES, stream, a); }
#else
    a.ph_lo = 0; a.ph_hi = N_PHASES;
    hipLaunchKernelGGL(hybrid_fwd, dim3(grid), dim3(NTHR), LDS_BYTES, stream, a);
#endif
    const hipError_t le = hipPeekAtLastError();
    if (le != hipSuccess) fprintf(stderr, "kernel_launch: launch failed: %s\n", hipGetErrorName(le));
}
```

```cpp
#include <hip/hip_runtime.h>
#include <cstdio>
#include <cstdint>
namespace pg8 {
#define PG8_LAS __attribute__((address_space(3)))
typedef unsigned short bf16_t;
typedef short bf16x8 __attribute__((ext_vector_type(8)));
typedef float f32x4 __attribute__((ext_vector_type(4)));
typedef unsigned u32x4 __attribute__((ext_vector_type(4)));
constexpr int BM = 256, BK = 64, HALF = 128, HTB = HALF * BK * 2  , STAGE_BYTES = 8 * HTB, NXCD = 8, WGM = 8;

__host__ __device__ __forceinline__ int lds_byte(int r, int c) { const int st = (r >> 4) * 2 + (c >> 5), rr = r & 15, cc = c & 31, ob = rr * 64 + cc * 2; return st * 1024 + (ob ^ (((ob >> 9) & 1) << 5)); }
__host__ __device__ __forceinline__ void stage_rc(int b, int& R, int& C) { const int st = b / 1024, sb = b % 1024, swz = sb ^ (((sb >> 9) & 1) << 5); R = (st >> 1) * 16 + swz / 64; C = (st & 1) * 32 + (swz % 64) / 2; }
__host__ __device__ __forceinline__ int perm32(int rho) { const int n = rho >> 4, i = rho & 15; return 8 * (i >> 2) + 4 * n + (i & 3); }

struct Unit { int pm, pn; };
struct Gemm { const bf16_t* A; const bf16_t* Bt; int M, N, K; };

struct StaticOrder {
    int nM, nN, nwg, G, c;
    __host__ __device__ void init(int M, int N, int G_, int c_) { nM = M / BM; nN = N / BM; nwg = nM * nN; G = G_; c = c_; }
    __host__ __device__ bool next(int i, Unit& u) const {
        const long L = (long)i * G + c; if (L >= nwg) return false;
        int wgid = (int)L; { const int q = nwg / NXCD, r = nwg % NXCD, xcd = wgid % NXCD, off = wgid / NXCD; wgid = (xcd < r ? xcd * (q + 1) : r * (q + 1) + (xcd - r) * q) + off; }
        const int nig = WGM * nN, gid = wgid / nig, fm = gid * WGM, gsz = (nM - fm) < WGM ? (nM - fm) : WGM;
        u.pm = fm + ((wgid % nig) % gsz); u.pn = (wgid % nig) / gsz; return true;
    }
    __device__ __forceinline__ void a_ready(const Unit&) const {}
    __device__ __forceinline__ void done(const Unit&) const {}
};
__device__ __forceinline__ unsigned cvt_pk_bf16(float lo, float hi) { unsigned r; asm volatile("v_cvt_pk_bf16_f32 %0, %1, %2" : "=v"(r) : "v"(lo), "v"(hi)); return r; }
typedef float f32x2 __attribute__((ext_vector_type(2)));
struct EpiStore {
    static constexpr bool PERM = true, AFTER_DRAIN = false;
    bf16_t* O; int ldc; int ntn; int n_main; float* tail; int tail_n;
    __device__ __forceinline__ void operator()(const f32x4 (&acc)[2][2][4][2], const Unit& u, int wr, int wc, int fr, int fq) const {
        const int row0 = u.pm * BM + wr * 64 + fr; const int ct = u.pn % ntn;
#pragma unroll
        for (int bj = 0; bj < 2; ++bj) {
            const int col = ct * BM + bj * HALF + wc * 32 + 8 * fq;
            if (col < n_main) {
#pragma unroll
                for (int ai = 0; ai < 2; ++ai)
#pragma unroll
                    for (int m = 0; m < 4; ++m) { const f32x4 v0 = acc[ai][bj][m][0], v1 = acc[ai][bj][m][1];
                        u32x4 w; w.x = cvt_pk_bf16(v0[0], v0[1]); w.y = cvt_pk_bf16(v0[2], v0[3]); w.z = cvt_pk_bf16(v1[0], v1[1]); w.w = cvt_pk_bf16(v1[2], v1[3]);
                        *(u32x4*)(O + (size_t)(row0 + ai * HALF + m * 16) * ldc + col) = w; }
            } else if (col - n_main < tail_n) {
#pragma unroll
                for (int ai = 0; ai < 2; ++ai)
#pragma unroll
                    for (int m = 0; m < 4; ++m) { float* p = tail + (size_t)(row0 + ai * HALF + m * 16) * tail_n + (col - n_main);
                        *(f32x4*)p = acc[ai][bj][m][0]; *(f32x4*)(p + 4) = acc[ai][bj][m][1]; }
            }
        }
    }
};
struct EpiQKVPrep {
    static constexpr bool PERM = true, AFTER_DRAIN = false;
    bf16_t* O; int ldc; int n_main; float* tail; int tail_n;
    int k_lo, k_hi, k2_lo, k2_hi;
    const float *gq, *gk, *gk2; const float* rope;
    float qs; float eps; int seq; int nbatch; int dilv; int tail_hm;
    __device__ __forceinline__ size_t hmoff(int row, int col) const { const int b = row / seq, t = row - b * seq; const int tp = (dilv > 1) ? (t % dilv) * (seq / dilv) + t / dilv : t;
        return ((size_t)(col >> 6) * nbatch + b) * seq * 64 + (size_t)tp * 64 + (col & 63); }
    __device__ __forceinline__ void operator()(const f32x4 (&acc)[2][2][4][2], const Unit& u, int wr, int wc, int fr, int fq) const {
        const int row0 = u.pm * BM + wr * 64 + fr; const int ct = u.pn;
        const float* gain = (ct < 4) ? gq : (ct >= k_lo && ct < k_hi) ? gk : (ct >= k2_lo && ct < k2_hi) ? gk2 : nullptr;
        if (gain) {
            const float sc = (ct < 4) ? qs : 1.0f;
            const f32x4 ga = *(const f32x4*)(gain + 8 * fq), gb = *(const f32x4*)(gain + 8 * fq + 4), gc = *(const f32x4*)(gain + 32 + 8 * fq), gd = *(const f32x4*)(gain + 36 + 8 * fq);
            const int col = ct * BM + 64 * wc + 8 * fq;
#pragma unroll
            for (int ai = 0; ai < 2; ++ai)
#pragma unroll
                for (int m = 0; m < 4; ++m) {
                    const int row = row0 + ai * HALF + m * 16;
                    f32x4 a = acc[ai][0][m][0], b = acc[ai][0][m][1], c = acc[ai][1][m][0], d = acc[ai][1][m][1];
                    float ss = ((a[0] * a[0] + a[1] * a[1]) + (a[2] * a[2] + a[3] * a[3])) + ((b[0] * b[0] + b[1] * b[1]) + (b[2] * b[2] + b[3] * b[3]))
                             + ((c[0] * c[0] + c[1] * c[1]) + (c[2] * c[2] + c[3] * c[3])) + ((d[0] * d[0] + d[1] * d[1]) + (d[2] * d[2] + d[3] * d[3]));
                    ss += __shfl_xor(ss, 16); ss += __shfl_xor(ss, 32);
                    const float r = sc / sqrtf(ss * (1.0f / 64.0f) + eps);
                    a = a * ga * r; b = b * gb * r; c = c * gc * r; d = d * gd * r;
                    if (rope) { const f32x4* rp = (const f32x4*)(rope + ((size_t)(row % seq) * 32 + 8 * fq) * 2);
                        const f32x4 r0 = rp[0], r1 = rp[1], r2 = rp[2], r3 = rp[3];
                        const f32x4 cs0 = {r0[0], r0[2], r1[0], r1[2]}, sn0 = {r0[1], r0[3], r1[1], r1[3]}, cs1 = {r2[0], r2[2], r3[0], r3[2]}, sn1 = {r2[1], r2[3], r3[1], r3[3]};
                        const f32x4 na = a * cs0 - c * sn0, nc = a * sn0 + c * cs0, nb = b * cs1 - d * sn1, nd = b * sn1 + d * cs1; a = na; b = nb; c = nc; d = nd; }
                    u32x4 w0, w1; w0.x = cvt_pk_bf16(a[0], a[1]); w0.y = cvt_pk_bf16(a[2], a[3]); w0.z = cvt_pk_bf16(b[0], b[1]); w0.w = cvt_pk_bf16(b[2], b[3]);
                    w1.x = cvt_pk_bf16(c[0], c[1]); w1.y = cvt_pk_bf16(c[2], c[3]); w1.z = cvt_pk_bf16(d[0], d[1]); w1.w = cvt_pk_bf16(d[2], d[3]);
                    bf16_t* op = O + hmoff(row, col); *(u32x4*)op = w0; *(u32x4*)(op + 32) = w1; }
            return;
        }
#pragma unroll
        for (int bj = 0; bj < 2; ++bj) {
            const int col = ct * BM + bj * HALF + wc * 32 + 8 * fq;
            if (col < n_main) {
#pragma unroll
                for (int ai = 0; ai < 2; ++ai)
#pragma unroll
                    for (int m = 0; m < 4; ++m) { const f32x4 v0 = acc[ai][bj][m][0], v1 = acc[ai][bj][m][1];
                        u32x4 w; w.x = cvt_pk_bf16(v0[0], v0[1]); w.y = cvt_pk_bf16(v0[2], v0[3]); w.z = cvt_pk_bf16(v1[0], v1[1]); w.w = cvt_pk_bf16(v1[2], v1[3]);
                        *(u32x4*)(O + hmoff(row0 + ai * HALF + m * 16, col)) = w; }
            } else if (col - n_main < tail_n) {
#pragma unroll
                for (int ai = 0; ai < 2; ++ai)
#pragma unroll
                    for (int m = 0; m < 4; ++m) { const int row = row0 + ai * HALF + m * 16;
                        if (tail_hm) { const int b = row / seq, t = row - b * seq; float* p = tail + ((size_t)b * tail_n + (col - n_main)) * seq + t;
#pragma unroll
                            for (int i = 0; i < 4; ++i) { p[(size_t)i * seq] = acc[ai][bj][m][0][i]; p[(size_t)(4 + i) * seq] = acc[ai][bj][m][1][i]; } }
                        else { float* p = tail + (size_t)row * tail_n + (col - n_main); *(f32x4*)p = acc[ai][bj][m][0]; *(f32x4*)(p + 4) = acc[ai][bj][m][1]; } }
            }
        }
    }
};
struct EpiSwiGLU {
    static constexpr bool PERM = true, AFTER_DRAIN = false;
    bf16_t* H; int ntn;
    __device__ __forceinline__ void operator()(const f32x4 (&acc)[2][2][4][2], const Unit& u, int wr, int wc, int fr, int fq) const {
        const int row0 = u.pm * BM + wr * 64 + fr; const int ct = u.pn % ntn;
        typedef unsigned u32x2v __attribute__((ext_vector_type(2)));
#pragma unroll
        for (int bj = 0; bj < 2; ++bj) {
            const int hc = ct * 128 + bj * 64 + wc * 16 + 4 * fq;
#pragma unroll
            for (int ai = 0; ai < 2; ++ai)
#pragma unroll
                for (int m = 0; m < 4; ++m) { const f32x4 g = acc[ai][bj][m][0], up = acc[ai][bj][m][1]; float r[4];
#pragma unroll
                    for (int i = 0; i < 4; ++i) { const float e = __builtin_amdgcn_exp2f(-g[i] * 1.4426950408889634f); r[i] = g[i] * __builtin_amdgcn_rcpf(1.0f + e) * up[i]; }
                    u32x2v w; w.x = cvt_pk_bf16(r[0], r[1]); w.y = cvt_pk_bf16(r[2], r[3]);
                    *(u32x2v*)(H + (size_t)(row0 + ai * HALF + m * 16) * 512 + hc) = w; }
        }
    }
};
struct MoeOrder {
    const int* tile_e; int ntiles, NT, G, c;
    __device__ __forceinline__ bool next(int i, Unit& u) const {
        const int L = i * G + c; if (L >= ntiles * NT) return false;
        const int pm = L / NT, j = L % NT; u.pm = pm; u.pn = tile_e[pm] * NT + j; return true;
    }
    __device__ __forceinline__ void a_ready(const Unit&) const {}
    __device__ __forceinline__ void done(const Unit&) const {}
};
template <class Epi, class Sched, bool ALIGN_EPI = false, bool SP2 = false>
__device__ __forceinline__ void gemm_phase(PG8_LAS unsigned char* lds, const Gemm g, const Sched& S, const Epi& E) {
    int tid_ = threadIdx.x; asm volatile("" : "+v"(tid_));
    const int tid = tid_, wid = __builtin_amdgcn_readfirstlane(tid >> 6), lane = tid & 63, wr = wid >> 2, wc = wid & 3, fr = lane & 15, fq = lane >> 4;
    const int K = g.K, nt = K / BK;
    unsigned voffA[2], voffB[2];
#pragma unroll
    for (int i = 0; i < 2; ++i) { int R, C; stage_rc(tid * 16 + i * 8192, R, C); const int Rb = Epi::PERM ? ((R & ~31) + perm32(R & 31)) : R;
        voffA[i] = (unsigned)(R * K + C) * 2u; voffB[i] = (unsigned)(Rb * K + C) * 2u; }
    const size_t kstep = (size_t)(BK * 2);
    const size_t hstep = (size_t)HALF * K * 2;
    const size_t tstep = 2 * hstep;
    const unsigned ldsw = (unsigned)wid * 1024u;
    const int aoff = lds_byte(wr * 64 + fr, fq * 8), boff = lds_byte(wc * 32 + fr, fq * 8);
#define PG8_SA(b, h) (((b) * 2 + (h)) * HTB)
#define PG8_SB(b, h) ((4 + (b) * 2 + (h)) * HTB)
#define PG8_STAGE(bufoff, gbase, voff) do { _Pragma("unroll") for (int _i = 0; _i < 2; ++_i) \
        __builtin_amdgcn_global_load_lds((const unsigned*)((const char*)(gbase) + (voff)[_i]), (PG8_LAS unsigned*)(lds + (bufoff) + ldsw + _i * 8192), 16, 0, 0); } while (0)
#define PG8_LDA(dst, b, h) do { _Pragma("unroll") for (int m = 0; m < 4; ++m) _Pragma("unroll") for (int k = 0; k < 2; ++k) dst[m][k] = *(const PG8_LAS bf16x8*)(lds + PG8_SA(b, h) + aoff + m * 2048 + k * 1024); } while (0)
#define PG8_LDB(dst, b, h) do { _Pragma("unroll") for (int n = 0; n < 2; ++n) _Pragma("unroll") for (int k = 0; k < 2; ++k) dst[n][k] = *(const PG8_LAS bf16x8*)(lds + PG8_SB(b, h) + boff + n * 2048 + k * 1024); } while (0)
#define PG8_MMA(ai, bj, At, Bt) do { __builtin_amdgcn_s_setprio(1); _Pragma("unroll") for (int m = 0; m < 4; ++m) _Pragma("unroll") for (int n = 0; n < 2; ++n) _Pragma("unroll") for (int k = 0; k < 2; ++k) \
        acc[ai][bj][m][n] = __builtin_amdgcn_mfma_f32_16x16x32_bf16(Bt[n][k], At[m][k], acc[ai][bj][m][n], 0, 0, 0); __builtin_amdgcn_s_setprio(0); } while (0)
#define PG8_WAIT_V(n) asm volatile("s_waitcnt vmcnt(" #n ")" ::: "memory")
#define PG8_WAIT_L(n) asm volatile("s_waitcnt lgkmcnt(" #n ")" ::: "memory")
#define PG8_BAR __builtin_amdgcn_s_barrier()
#define PG8_SCHED __builtin_amdgcn_sched_barrier(0)
    Unit cur, nxt; int ui = 0;
    if (!S.next(0, cur)) return;
    f32x4 acc[2][2][4][2];
#pragma unroll
    for (int a = 0; a < 2; ++a)
#pragma unroll
        for (int b = 0; b < 2; ++b)
#pragma unroll
            for (int m = 0; m < 4; ++m)
#pragma unroll
                for (int n = 0; n < 2; ++n) acc[a][b][m][n] = (f32x4){0.f, 0.f, 0.f, 0.f};
    bf16x8 At[4][2], B0[2][2], B1[2][2];
    const char* cA = (const char*)g.A + (size_t)cur.pm * tstep; const char* cB = (const char*)g.Bt + (size_t)cur.pn * tstep;
    S.a_ready(cur);
    if constexpr (SP2) {
        PG8_STAGE(PG8_SB(0, 0), cB, voffB); PG8_STAGE(PG8_SB(0, 1), cB + hstep, voffB); PG8_STAGE(PG8_SA(0, 0), cA, voffA); PG8_STAGE(PG8_SA(0, 1), cA + hstep, voffA);
        if (wr == 1) PG8_BAR;
        PG8_WAIT_V(2); PG8_BAR;
        PG8_STAGE(PG8_SB(1, 0), cB + kstep, voffB); PG8_STAGE(PG8_SA(1, 0), cA + kstep, voffA); PG8_STAGE(PG8_SB(1, 1), cB + hstep + kstep, voffB);
        PG8_WAIT_V(6); PG8_BAR;
    } else {
        PG8_STAGE(PG8_SB(0, 0), cB, voffB); PG8_STAGE(PG8_SA(0, 0), cA, voffA); PG8_STAGE(PG8_SB(0, 1), cB + hstep, voffB); PG8_STAGE(PG8_SA(0, 1), cA + hstep, voffA);
        if (wr == 1) PG8_BAR;
        PG8_WAIT_V(4); PG8_BAR;
        PG8_STAGE(PG8_SB(1, 0), cB + kstep, voffB); PG8_STAGE(PG8_SA(1, 0), cA + kstep, voffA); PG8_STAGE(PG8_SB(1, 1), cB + hstep + kstep, voffB);
        PG8_WAIT_V(6); PG8_BAR;
    }
    for (;;) {
        const bool has_next = S.next(ui + 1, nxt);
        const char* nA = has_next ? (const char*)g.A + (size_t)nxt.pm * tstep : cA; const char* nB = has_next ? (const char*)g.Bt + (size_t)nxt.pn * tstep : cB;
        for (int t = 0; t < nt; t += 2) {
            const bool last = (t == nt - 2);
            const char* a1 = cA + (size_t)(t + 1) * kstep;
            const char* a2 = last ? nA : cA + (size_t)(t + 2) * kstep; const char* b2 = last ? nB : cB + (size_t)(t + 2) * kstep;
            const char* a3 = a2 + kstep; const char* b3 = b2 + kstep;
            if (last && has_next) S.a_ready(nxt);
            if constexpr (SP2) {
            PG8_LDB(B0, 0, 0); PG8_LDB(B1, 0, 1); PG8_SCHED; PG8_LDA(At, 0, 0); PG8_STAGE(PG8_SA(1, 1), a1 + hstep, voffA);
            PG8_WAIT_V(8); PG8_WAIT_L(0); PG8_BAR; PG8_MMA(0, 0, At, B0); PG8_MMA(0, 1, At, B1); PG8_BAR; PG8_SCHED;
            PG8_LDA(At, 0, 1); PG8_STAGE(PG8_SB(0, 0), b2, voffB); PG8_STAGE(PG8_SB(0, 1), b2 + hstep, voffB); PG8_STAGE(PG8_SA(0, 0), a2, voffA);
            PG8_WAIT_V(8); PG8_WAIT_L(0); PG8_BAR; PG8_MMA(1, 0, At, B0); PG8_MMA(1, 1, At, B1); PG8_BAR; PG8_SCHED;
            PG8_LDB(B0, 1, 0); PG8_LDB(B1, 1, 1); PG8_SCHED; PG8_LDA(At, 1, 0); PG8_STAGE(PG8_SA(0, 1), a2 + hstep, voffA);
            PG8_WAIT_V(8); PG8_WAIT_L(0); PG8_BAR; PG8_MMA(0, 0, At, B0); PG8_MMA(0, 1, At, B1); PG8_BAR; PG8_SCHED;
            PG8_LDA(At, 1, 1); PG8_STAGE(PG8_SB(1, 0), b3, voffB); PG8_STAGE(PG8_SB(1, 1), b3 + hstep, voffB); PG8_STAGE(PG8_SA(1, 0), a3, voffA);
            PG8_WAIT_V(8); PG8_WAIT_L(0); PG8_BAR; PG8_MMA(1, 0, At, B0); PG8_MMA(1, 1, At, B1); PG8_BAR; PG8_SCHED;
            } else {
            PG8_LDB(B0, 0, 0); PG8_SCHED; PG8_LDA(At, 0, 0); PG8_STAGE(PG8_SA(1, 1), a1 + hstep, voffA);
            PG8_WAIT_L(8); PG8_BAR; PG8_WAIT_L(0); PG8_MMA(0, 0, At, B0); PG8_BAR; PG8_SCHED;
            PG8_LDB(B1, 0, 1); PG8_STAGE(PG8_SB(0, 0), b2, voffB);
            PG8_BAR; PG8_WAIT_L(0); PG8_MMA(0, 1, At, B1); PG8_BAR;
            PG8_LDA(At, 0, 1); PG8_STAGE(PG8_SA(0, 0), a2, voffA);
            PG8_BAR; PG8_WAIT_L(0); PG8_MMA(1, 0, At, B0); PG8_BAR; PG8_SCHED;
            PG8_STAGE(PG8_SB(0, 1), b2 + hstep, voffB);
            PG8_WAIT_V(6); PG8_BAR; PG8_MMA(1, 1, At, B1); PG8_BAR;
            PG8_LDB(B0, 1, 0); PG8_SCHED; PG8_LDA(At, 1, 0); PG8_STAGE(PG8_SA(0, 1), a2 + hstep, voffA);
            PG8_WAIT_L(8); PG8_BAR; PG8_WAIT_L(0); PG8_MMA(0, 0, At, B0); PG8_BAR; PG8_SCHED;
            PG8_LDB(B1, 1, 1); PG8_STAGE(PG8_SB(1, 0), b3, voffB);
            PG8_BAR; PG8_WAIT_L(0); PG8_MMA(0, 1, At, B1); PG8_BAR;
            PG8_LDA(At, 1, 1); PG8_STAGE(PG8_SA(1, 0), a3, voffA);
            PG8_BAR; PG8_WAIT_L(0); PG8_MMA(1, 0, At, B0); PG8_BAR; PG8_SCHED;
            PG8_STAGE(PG8_SB(1, 1), b3 + hstep, voffB);
            PG8_WAIT_V(6); PG8_BAR; PG8_MMA(1, 1, At, B1); PG8_BAR;
            }
        }
        if constexpr (ALIGN_EPI) { if (wr == 0) PG8_BAR; }
        if constexpr (!Epi::AFTER_DRAIN) { E(acc, cur, wr, wc, fr, fq); S.done(cur); }
        if (!has_next) break;
#pragma unroll
        for (int a = 0; a < 2; ++a)
#pragma unroll
            for (int b = 0; b < 2; ++b)
#pragma unroll
                for (int m = 0; m < 4; ++m)
#pragma unroll
                    for (int n = 0; n < 2; ++n) acc[a][b][m][n] = (f32x4){0.f, 0.f, 0.f, 0.f};
        cur = nxt; cA = nA; cB = nB; ++ui;
        if constexpr (ALIGN_EPI) { if (wr == 1) PG8_BAR; }
    }
    PG8_WAIT_V(0);
    if constexpr (!ALIGN_EPI) { if (wr == 0) PG8_BAR; }
    PG8_BAR;
    if constexpr (Epi::AFTER_DRAIN) { E.fused(acc, cur, wr, wc, fr, fq, lds, wid, lane); S.done(cur); }
#undef PG8_SA
#undef PG8_SB
#undef PG8_STAGE
#undef PG8_LDA
#undef PG8_LDB
#undef PG8_MMA
#undef PG8_WAIT_V
#undef PG8_WAIT_L
#undef PG8_BAR
#undef PG8_SCHED
}
}
#define GAS __attribute__((address_space(1)))
#define LAS __attribute__((address_space(3)))
#define DI __device__ __forceinline__
typedef unsigned short bf16;
typedef unsigned v4u __attribute__((ext_vector_type(4)));
typedef unsigned v2u __attribute__((ext_vector_type(2)));
typedef float f32x4 __attribute__((ext_vector_type(4)));
typedef float f32x2 __attribute__((ext_vector_type(2)));
typedef GAS unsigned gu32;
#define LDS_WAIT() asm volatile("s_waitcnt lgkmcnt(0)" ::: "memory")
#define VM_WAIT() asm volatile("s_waitcnt vmcnt(0)" ::: "memory")
DI unsigned f2bf(float f) { unsigned u = __builtin_bit_cast(unsigned, f); return (u + 0x7fffu + ((u >> 16) & 1u)) >> 16; }
DI unsigned pk2(float lo, float hi) { return f2bf(lo) | (f2bf(hi) << 16); }
DI float bflo(unsigned u) { return __builtin_bit_cast(float, u << 16); }
DI float bfhi(unsigned u) { return __builtin_bit_cast(float, u & 0xffff0000u); }
DI float wave_sum(float v) {
#pragma unroll
    for (int o = 1; o < 64; o <<= 1) v += __shfl_xor(v, o);
    return v;
}
DI float wave_sum_dpp(float v) {
#define WS_DPP(ctrl, rmask) v += __builtin_bit_cast(float, __builtin_amdgcn_update_dpp(0, __builtin_bit_cast(int, v), ctrl, rmask, 0xf, true))
    WS_DPP(0xB1, 0xf); WS_DPP(0x4E, 0xf); WS_DPP(0x141, 0xf); WS_DPP(0x140, 0xf); WS_DPP(0x142, 0xa); WS_DPP(0x143, 0xc);
#undef WS_DPP
    return __builtin_bit_cast(float, __builtin_amdgcn_readlane(__builtin_bit_cast(int, v), 63));
}
DI float wave_max(float v) {
#pragma unroll
    for (int o = 1; o < 64; o <<= 1) v = fmaxf(v, __shfl_xor(v, o));
    return v;
}
#ifndef DBG_TS_SECT
#define DBG_TS_SECT 0
#endif
#define TS_SECT_BEGIN(C, k) do { if (DBG_TS_SECT == (k) && (C).tid == 0) ((volatile LAS unsigned long long*)((C).lds + 131072 + 320 + 64))[1] = __builtin_amdgcn_s_memrealtime(); } while (0)
#define TS_SECT_END(C, k) do { if (DBG_TS_SECT == (k) && (C).tid == 0) { volatile LAS unsigned long long* t_ = (volatile LAS unsigned long long*)((C).lds + 131072 + 320 + 64); t_[0] = t_[0] + (__builtin_amdgcn_s_memrealtime() - t_[1]); } } while (0)
#define XB_TMO      128
#define XB_XCNT(j)  (256  + 64 * (j))
#define XB_XSUB(j)  (1280 + 64 * (j))
#define XB_XGEN(j)  (2304 + 64 * (j))
#define XB_TOP      3328
#define XB_TOPGEN   3392
#define XCD_BAR_WORDS 3456
#define XB_SPIN_CAP (1u << 18)

__device__ __forceinline__ unsigned xb_ld(unsigned* p)              { return __hip_atomic_load(p, __ATOMIC_RELAXED, __HIP_MEMORY_SCOPE_AGENT); }
__device__ __forceinline__ unsigned xb_add(unsigned* p, unsigned v) { return __hip_atomic_fetch_add(p, v, __ATOMIC_RELAXED, __HIP_MEMORY_SCOPE_AGENT); }
__device__ __forceinline__ unsigned xb_xcc_id() { return (unsigned)__builtin_amdgcn_s_getreg((3 << 11) | 20) & 0xFu; }
#define XB_SPIN(cond, bar) do { unsigned _sp = 0; while (cond) { __builtin_amdgcn_s_sleep(1); \
    if ((++_sp & 255u) == 0u) { if (xb_ld(&(bar)[XB_TMO])) break; if (_sp > XB_SPIN_CAP) { atomicAdd(&(bar)[XB_TMO], 1u); break; } } } } while (0)

struct XcdBarrier {
    unsigned* bar; unsigned x;
    volatile LAS unsigned* st;
};

__device__ __forceinline__ XcdBarrier xcd_barrier_post(unsigned* bar, volatile LAS unsigned* st) {
    XcdBarrier b; b.bar = bar; b.x = xb_xcc_id(); b.st = st;
    if (threadIdx.x == 0) (void)xb_add(&bar[XB_XCNT(b.x)], 1u);
    return b;
}
__device__ __forceinline__ void xcd_barrier_complete(unsigned* bar, unsigned x, unsigned& nloc, unsigned& nx) {
    const unsigned G = gridDim.x * gridDim.y * gridDim.z;
    unsigned sum, cnt, mine, sp = 0u;
    for (;;) {
        sum = 0u; cnt = 0u; mine = 0u;
#pragma unroll
        for (unsigned j = 0; j < 16; ++j) { const unsigned c = xb_ld(&bar[XB_XCNT(j)]); sum += c; cnt += (c > 0u) ? 1u : 0u; mine = (j == x) ? c : mine; }
        if (sum == G) break;
        __builtin_amdgcn_s_sleep(1);
        if ((++sp & 255u) == 0u) { if (xb_ld(&bar[XB_TMO])) break; if (sp > XB_SPIN_CAP) { atomicAdd(&bar[XB_TMO], 1u); break; } }
    }
    nloc = mine > 0u ? mine : 1u; nx = cnt > 0u ? cnt : 1u;
}

__device__ __forceinline__ void xcd_barrier(const XcdBarrier& b) {
    asm volatile("s_waitcnt vmcnt(0)" ::: "memory");
    __syncthreads();
    if (threadIdx.x == 0) {
        unsigned* bar = b.bar;
        __builtin_amdgcn_s_waitcnt(0);
        unsigned nloc = b.st[0], nx = b.st[1];
        if (nloc == 0u) { xcd_barrier_complete(bar, b.x, nloc, nx); b.st[0] = nloc; b.st[1] = nx; }
        const unsigned old = xb_add(&bar[XB_XSUB(b.x)], 1u);
        const unsigned gen = old / nloc;
        if (old + 1u == (gen + 1u) * nloc) {
            __builtin_amdgcn_fence(__ATOMIC_RELEASE, "agent");
            asm volatile("s_waitcnt vmcnt(0)" ::: "memory");
            const unsigned og = xb_add(&bar[XB_TOP], 1u);
            const unsigned tg = og / nx;
            if (og + 1u == (tg + 1u) * nx) xb_add(&bar[XB_TOPGEN], 1u);
            else XB_SPIN(xb_ld(&bar[XB_TOPGEN]) == tg, bar);
            __builtin_amdgcn_fence(__ATOMIC_ACQUIRE, "agent");
            xb_add(&bar[XB_XGEN(b.x)], 1u);
            asm volatile("s_waitcnt vmcnt(0)" ::: "memory");
        } else {
            XB_SPIN(xb_ld(&bar[XB_XGEN(b.x)]) == gen, bar);
            __builtin_amdgcn_fence(__ATOMIC_ACQUIRE, "agent");
            asm volatile("s_waitcnt vmcnt(0)" ::: "memory");
        }
    }
    __syncthreads();
}
constexpr int BATCH = 8, SEQ = 4096, DM = 1024, T = BATCH * SEQ, HD = 64;
constexpr int NWAVES = 8, NTHR = 512;
constexpr float EPS = 1e-6f, LOG2E = 1.4426950408889634f, QSC = 0.125f * LOG2E;
enum { I_X = 0, I_C, I_FOX_WIN, I_FOX_BF, I_FOX_QG, I_FOX_KG, I_FOX_WOUT, I_NSA_WIN, I_NSA_QG, I_NSA_KG, I_NSA_POS, I_NSA_W1, I_NSA_W2, I_NSA_WOUT,
       I_DIL_WIN, I_DIL_QG, I_DIL_KG, I_DIL_WOUT, I_DIFF_WIN, I_DIFF_QG, I_DIFF_KG, I_DIFF_LAM, I_DIFF_SG, I_DIFF_WOUT,
       I_NORM_GAIN, I_ADA_W, I_ADA_B, I_ROUTER_W, I_ROUTER_B, I_MOE_WG, I_MOE_WU, I_MOE_WD, N_IN };
constexpr size_t MiB = 1u << 20;
constexpr size_t WS_CTL = 0, CTL_ZERO_BYTES = 1 * MiB;
constexpr size_t WS_MODP = 1 * MiB, WS_MOD = 7 * MiB, WS_ROPE = 8 * MiB, WS_FLOG = 9 * MiB, WS_CUM = 11 * MiB, WS_GATE = 13 * MiB, WS_LSE = 19 * MiB, WS_SELM = 21 * MiB;
constexpr size_t WS_KC = 22 * MiB, WS_VC = 22 * MiB + 512 * 1024;
constexpr size_t WS_EIDX = 23 * MiB, WS_WTS = WS_EIDX + 256 * 1024, WS_LRANK = WS_WTS + 256 * 1024, WS_ROWOF = WS_LRANK + 256 * 1024;
constexpr size_t WS_W1T = 26 * MiB;
constexpr size_t WS_HIST = 24 * MiB, WS_TILEE = WS_HIST + 64 * 1024, WS_NTILES = WS_TILEE + 4096;
constexpr size_t WS_FOXWIN = 32 * MiB, WS_NSAWIN = 39 * MiB, WS_DILWIN = 45 * MiB, WS_DIFFWIN = 63 * MiB, WS_WOUT = 69 * MiB;
constexpr size_t WS_MOEW = 80 * MiB, MOEW_LAYER = 48 * MiB, MOEW_D_OFF = 32 * MiB;
constexpr size_t WS_UO = 272 * MiB, WS_O2 = 336 * MiB, WS_R1 = 400 * MiB, WS_HID = WS_R1 + 136 * MiB, WS_Y = 608 * MiB, WS_END = 672 * MiB;
constexpr int CW_BAR = 4096;
constexpr int LDS_BYTES = 147456, MISC_OFF = 131072 + 320;
constexpr int FOX_NPAD = 3328, NSA_NPAD = 2816;

struct Args { const float* in[N_IN]; float* out; unsigned char* ws; int ph_lo, ph_hi; };
struct Ctx {
    float* hbuf; unsigned char* ws; LAS unsigned char* lds;
    int tid, lane, wave, G, blk;
};
constexpr int PTR_OFF = 131072 + 1024;
DI const float* inp(const Ctx& C, int i) {
    const unsigned long long v = ((const LAS unsigned long long*)(C.lds + PTR_OFF))[i];
    const unsigned lo = __builtin_amdgcn_readfirstlane((unsigned)v), hi = __builtin_amdgcn_readfirstlane((unsigned)(v >> 32));
    return (const float*)(((unsigned long long)hi << 32) | lo);
}

DI void conv_item(const float* W0, const float* W1, int K, int Nsrc, int ldn, bf16* WT, int mode, int nblk, int item, int lane, unsigned long long pmask = 0ull, int pmod = 64) {
    const int kb = item / nblk, nb = item % nblk, k0 = 64 * kb + 16 * (lane >> 4), n = 64 * nb + 4 * (lane & 15);
    const float* src; bool valid;
    if (mode == 0) { int ns = n;
        if ((pmask >> ((n >> 8) % pmod)) & 1ull) { const int pc = n & 255; ns = (n & ~255) + 64 * ((pc >> 5) & 3) + 32 * (pc >> 7) + (pc & 31); }
        valid = ns < Nsrc; src = W0 + ns; }
    else { const int j = n >> 3; valid = true; src = ((n & 4) ? W1 : W0) + 4 * j; }
    f32x4 v[16];
#pragma unroll
    for (int k = 0; k < 16; ++k) v[k] = valid ? *(const f32x4*)(src + (size_t)(k0 + k) * ldn) : (f32x4){0.f, 0.f, 0.f, 0.f};
#pragma unroll
    for (int i = 0; i < 4; ++i) { v4u o0, o1;
        o0.x = pk2(v[0][i], v[1][i]); o0.y = pk2(v[2][i], v[3][i]); o0.z = pk2(v[4][i], v[5][i]); o0.w = pk2(v[6][i], v[7][i]);
        o1.x = pk2(v[8][i], v[9][i]); o1.y = pk2(v[10][i], v[11][i]); o1.z = pk2(v[12][i], v[13][i]); o1.w = pk2(v[14][i], v[15][i]);
        bf16* dst = WT + (size_t)(n + i) * K + k0; *(v4u*)dst = o0; *(v4u*)(dst + 8) = o1; }
}
DI void sincos_d(double x, float& s, float& c) {
    const double k = __builtin_rint(x * 0.6366197723675814);
    double r = __builtin_fma(-k, 1.5707963267948966, x); r = __builtin_fma(-k, 6.123233995736766e-17, r);
    const int q = ((int)k) & 3; const double r2 = r * r;
    double sp = 1.0 / 6227020800.0; sp = sp * r2 - 1.0 / 39916800.0; sp = sp * r2 + 1.0 / 362880.0; sp = sp * r2 - 1.0 / 5040.0; sp = sp * r2 + 1.0 / 120.0; sp = sp * r2 - 1.0 / 6.0; sp = sp * r2 + 1.0; sp *= r;
    double cp = -1.0 / 87178291200.0; cp = cp * r2 + 1.0 / 479001600.0; cp = cp * r2 - 1.0 / 3628800.0; cp = cp * r2 + 1.0 / 40320.0; cp = cp * r2 - 1.0 / 720.0; cp = cp * r2 + 1.0 / 24.0; cp = cp * r2 - 0.5; cp = cp * r2 + 1.0;
    const double ss = (q == 0) ? sp : (q == 1) ? cp : (q == 2) ? -sp : -cp;
    const double cc = (q == 0) ? cp : (q == 1) ? -sp : (q == 2) ? -cp : sp;
    s = (float)ss; c = (float)cc;
}
DI void phase_p0a(Ctx& C) {
    const int gw = C.blk * NWAVES + C.wave, NGW = C.G * NWAVES;
    LAS float* cond = (LAS float*)C.lds;
    for (int i = C.tid; i < BATCH * DM; i += NTHR) { const float v = inp(C, I_C)[i]; cond[i] = v / (1.0f + expf(-v)); }
    __syncthreads();
    float* MODP = (float*)(C.ws + WS_MODP);
    for (int it = gw; it < 4 * 96 * 8; it += NGW) {
        const int l = it / 768, rem = it % 768, cg = rem / 8, kc = rem % 8, col = cg * 64 + C.lane;
        float acc[8];
#pragma unroll
        for (int b = 0; b < 8; ++b) acc[b] = 0.f;
        const float* w = inp(C, I_ADA_W) + ((size_t)l * DM + kc * 128) * 6144 + col;
        for (int k0 = 0; k0 < 128; k0 += 16) { float wv[16];
#pragma unroll
            for (int k = 0; k < 16; ++k) wv[k] = w[(size_t)(k0 + k) * 6144];
#pragma unroll
            for (int k = 0; k < 16; ++k)
#pragma unroll
                for (int b = 0; b < 8; ++b) acc[b] += cond[b * DM + kc * 128 + k0 + k] * wv[k]; }
#pragma unroll
        for (int b = 0; b < 8; ++b) MODP[(((size_t)kc * 4 + l) * 8 + b) * 6144 + col] = acc[b];
    }
    __syncthreads();
    { f32x2* ROPE = (f32x2*)(C.ws + WS_ROPE);
      for (int i = C.blk * NTHR + C.tid; i < SEQ * 32; i += C.G * NTHR) { const int t = i >> 5, f = i & 31;
          const float inv = exp2f(-(float)f * (13.287712379549449f / 32.0f)); const float ang = (float)t * inv; float s, c; sincos_d((double)ang, s, c); ROPE[i] = (f32x2){c, s}; } }
}
DI void phase_p0c(Ctx& C) {
    const int gw = C.blk * NWAVES + C.wave, NGW = C.G * NWAVES;
    constexpr int I_FOXIN = 16 * (FOX_NPAD / 64), I_NSAIN = 16 * (NSA_NPAD / 64), I_DILIN = 16 * (9216 / 64), I_DIFFIN = 16 * (3072 / 64), I_WO = 16 * 16, I_GU = 16 * 16, I_D = 8 * 16;
    constexpr int I_W1 = 64 * 2;
    constexpr int NITEMS = I_FOXIN + I_NSAIN + I_DILIN + I_DIFFIN + 4 * I_WO + 16 * I_GU + 16 * I_D + 2 * I_W1;
    for (int it = gw; it < NITEMS; it += NGW) {
        int r = it;
        if (r < I_FOXIN) { conv_item(inp(C, I_FOX_WIN), nullptr, DM, 3088, 3088, (bf16*)(C.ws + WS_FOXWIN), 0, FOX_NPAD / 64, r, C.lane, 0xFFull); continue; } r -= I_FOXIN;
        if (r < I_NSAIN) { conv_item(inp(C, I_NSA_WIN), nullptr, DM, 2608, 2608, (bf16*)(C.ws + WS_NSAWIN), 0, NSA_NPAD / 64, r, C.lane, 0x14Full); continue; } r -= I_NSAIN;
        if (r < I_DILIN) { conv_item(inp(C, I_DIL_WIN), nullptr, DM, 9216, 9216, (bf16*)(C.ws + WS_DILWIN), 0, 9216 / 64, r, C.lane, 0xFFull, 12); continue; } r -= I_DILIN;
        if (r < I_DIFFIN) { conv_item(inp(C, I_DIFF_WIN), nullptr, DM, 3072, 3072, (bf16*)(C.ws + WS_DIFFWIN), 0, 3072 / 64, r, C.lane, 0xFFull); continue; } r -= I_DIFFIN;
        if (r < 4 * I_WO) { const int m = r / I_WO; const float* src = (m == 0) ? inp(C, I_FOX_WOUT) : (m == 1) ? inp(C, I_NSA_WOUT) : (m == 2) ? inp(C, I_DIL_WOUT) : inp(C, I_DIFF_WOUT);
            conv_item(src, nullptr, DM, DM, DM, (bf16*)(C.ws + WS_WOUT + (size_t)m * 2 * MiB), 0, 16, r % I_WO, C.lane); continue; } r -= 4 * I_WO;
        if (r < 16 * I_GU) { const int le = r / I_GU, l = le / 16, e = le % 16;
            conv_item(inp(C, I_MOE_WG) + (size_t)le * DM * 512, inp(C, I_MOE_WU) + (size_t)le * DM * 512, DM, 1024, 512, (bf16*)(C.ws + WS_MOEW + (size_t)l * MOEW_LAYER + (size_t)e * 2 * MiB), 1, 16, r % I_GU, C.lane); continue; } r -= 16 * I_GU;
        if (r < 16 * I_D) { const int le = r / I_D, l = le / 16, e = le % 16;
            conv_item(inp(C, I_MOE_WD) + (size_t)le * 512 * DM, nullptr, 512, DM, DM, (bf16*)(C.ws + WS_MOEW + (size_t)l * MOEW_LAYER + MOEW_D_OFF + (size_t)e * MiB), 0, 16, r % I_D, C.lane); continue; } r -= 16 * I_D;
        { const int which = r / I_W1; conv_item(inp(C, I_NSA_W1) + (size_t)which * 4096 * 128, nullptr, 4096, 128, 128, (bf16*)(C.ws + WS_W1T) + (size_t)which * 128 * 4096, 0, 2, r % I_W1, C.lane); }
    }
}
DI void conv_moe_tail(Ctx& C, int l, bool gu) {
    const int lo = C.G > 64 ? 64 : 0;
    if (C.blk < lo) return;
    const int wv = (C.blk - lo) * NWAVES + C.wave, NW = (C.G - lo) * NWAVES, n = gu ? 4096 : 2048;
    for (int it = wv; it < n; it += NW) {
        if (gu) { const int e = it >> 8, le = l * 16 + e;
            conv_item(inp(C, I_MOE_WG) + (size_t)le * DM * 512, inp(C, I_MOE_WU) + (size_t)le * DM * 512, DM, 1024, 512, (bf16*)(C.ws + WS_MOEW + (size_t)l * MOEW_LAYER + (size_t)e * 2 * MiB), 1, 16, it & 255, C.lane); }
        else { const int e = it >> 7, le = l * 16 + e;
            conv_item(inp(C, I_MOE_WD) + (size_t)le * 512 * DM, nullptr, 512, DM, DM, (bf16*)(C.ws + WS_MOEW + (size_t)l * MOEW_LAYER + MOEW_D_OFF + (size_t)e * MiB), 0, 16, it & 127, C.lane); }
    }
}
DI void phase_p0b(Ctx& C) {
    const float* MODP = (const float*)(C.ws + WS_MODP); float* MOD = (float*)(C.ws + WS_MOD);
    for (int i = C.blk * NTHR + C.tid; i < 4 * 8 * 6144; i += C.G * NTHR) { const int l = i / (8 * 6144), col = i % 6144;
        float s = inp(C, I_ADA_B)[l * 6144 + col];
#pragma unroll
        for (int kc = 0; kc < 8; ++kc) s += MODP[(size_t)kc * (4 * 8 * 6144) + i];
        MOD[i] = s; }
}
DI void ld_row_f32(const float* p, int lane, f32x4 (&v)[4]) {
#pragma unroll
    for (int j = 0; j < 4; ++j) v[j] = *(const f32x4*)(p + 4 * lane + 256 * j);
}
DI void st_row_f32(float* p, int lane, const f32x4 (&v)[4]) {
#pragma unroll
    for (int j = 0; j < 4; ++j) *(f32x4*)(p + 4 * lane + 256 * j) = v[j];
}
DI void ld_row_bf16(const bf16* p, int lane, f32x4 (&v)[4]) {
#pragma unroll
    for (int j = 0; j < 4; ++j) { const v2u w = *(const v2u*)(p + 4 * lane + 256 * j); v[j] = (f32x4){bflo(w.x), bfhi(w.x), bflo(w.y), bfhi(w.y)}; }
}
DI void st_row_bf16(bf16* p, int lane, const f32x4 (&v)[4]) {
#pragma unroll
    for (int j = 0; j < 4; ++j) { v2u w; w.x = pk2(v[j].x, v[j].y); w.y = pk2(v[j].z, v[j].w); *(v2u*)(p + 4 * lane + 256 * j) = w; }
}
DI void norm_mod(const f32x4 (&h)[4], const float* gain, const float* sc, const float* sh, int lane, f32x4 (&u)[4]) {
    float ss = 0.f;
#pragma unroll
    for (int j = 0; j < 4; ++j) ss += (h[j].x * h[j].x + h[j].y * h[j].y) + (h[j].z * h[j].z + h[j].w * h[j].w);
    const float r = 1.0f / sqrtf(wave_sum_dpp(ss) * (1.0f / DM) + EPS);
#pragma unroll
    for (int j = 0; j < 4; ++j) { const f32x4 g = *(const f32x4*)(gain + 4 * lane + 256 * j), s1 = *(const f32x4*)(sc + 4 * lane + 256 * j), s0 = *(const f32x4*)(sh + 4 * lane + 256 * j);
        u[j] = (h[j] * r) * g * (s1 + 1.0f) + s0; }
}
DI int wave_row(const Ctx& C, int i) { return (((i >> 2) * (C.G * NWAVES) + C.blk * NWAVES + C.wave) << 2) + (i & 3); }
DI int rdli(int v, int l) { return __builtin_amdgcn_readlane(v, l); }
template <int L, bool FINAL> DI void rows_combine_norm(Ctx& C) {
    const int RPB = T / C.G, RPW = RPB / NWAVES;
    const float* MOD = (const float*)(C.ws + WS_MOD); bf16* U = (bf16*)(C.ws + WS_UO);
    constexpr int LP = FINAL ? 3 : (L > 0 ? L - 1 : 0);
    const int* ROWOF = (const int*)(C.ws + WS_ROWOF); const float* WTS = (const float*)(C.ws + WS_WTS); const bf16* YS = (const bf16*)(C.ws + WS_R1); const bf16* Y = (const bf16*)(C.ws + WS_Y);
    int ro = 0; float wt = 0.f;
    if (FINAL || L > 0) { if (C.lane < 2 * RPW) { const int ri = 2 * wave_row(C, (C.lane >> 3) << 2) + (C.lane & 7); ro = ROWOF[ri]; wt = WTS[ri]; } }
    const float* gain = inp(C, I_NORM_GAIN) + (L * 2 + 0) * DM;
    for (int i = 0; i < RPW; i += 2) {
        const int rowbase2 = wave_row(C, i), b = rowbase2 / SEQ;
        const float* g1 = MOD + ((size_t)(LP * 8 + b) * 6 + 2) * DM; const float* g2 = MOD + ((size_t)(LP * 8 + b) * 6 + 5) * DM;
        const float* sc1 = MOD + ((size_t)(L * 8 + b) * 6 + 1) * DM; const float* sh1 = MOD + ((size_t)(L * 8 + b) * 6 + 0) * DM;
        f32x4 h[2][4], ym[2][4], y0[2][4], y1[2][4]; float w0[2], w1[2];
#pragma unroll
        for (int k = 0; k < 2; ++k) { const size_t row = rowbase2 + k;
            if (!FINAL && L == 0) ld_row_f32(inp(C, I_X) + row * DM, C.lane, h[k]);
            else { const int r0 = rdli(ro, 2 * (i + k)), r1 = rdli(ro, 2 * (i + k) + 1); w0[k] = __builtin_bit_cast(float, rdli(__builtin_bit_cast(int, wt), 2 * (i + k))); w1[k] = __builtin_bit_cast(float, rdli(__builtin_bit_cast(int, wt), 2 * (i + k) + 1));
                ld_row_f32(C.hbuf + row * DM, C.lane, h[k]); ld_row_bf16(Y + row * DM, C.lane, ym[k]); ld_row_bf16(YS + (size_t)r0 * DM, C.lane, y0[k]); ld_row_bf16(YS + (size_t)r1 * DM, C.lane, y1[k]); } }
#pragma unroll
        for (int k = 0; k < 2; ++k) { const size_t row = rowbase2 + k;
            if (FINAL || L > 0) {
#pragma unroll
                for (int j = 0; j < 4; ++j) { const f32x4 ga = *(const f32x4*)(g1 + 4 * C.lane + 256 * j), gb = *(const f32x4*)(g2 + 4 * C.lane + 256 * j);
                    h[k][j] += ga * ym[k][j]; h[k][j] += gb * (y0[k][j] * w0[k] + y1[k][j] * w1[k]); } }
            st_row_f32(C.hbuf + row * DM, C.lane, h[k]);
            if (!FINAL) { f32x4 u[4]; norm_mod(h[k], gain, sc1, sh1, C.lane, u); st_row_bf16(U + row * DM, C.lane, u); } }
    }
}
template <int L> DI void phase_n1(Ctx& C) { rows_combine_norm<L, false>(C); }
DI void phase_final(Ctx& C) { rows_combine_norm<3, true>(C); }
template <int L> DI void phase_n2(Ctx& C, const bf16* Y) {
    const int RPB = T / C.G, RPW = RPB / NWAVES;
    const float* MOD = (const float*)(C.ws + WS_MOD); bf16* U = (bf16*)(C.ws + WS_UO);
    LAS float* wT = (LAS float*)C.lds; LAS int* hist = (LAS int*)(C.lds + 65536);
    for (int idx = C.tid; idx < DM * 16; idx += NTHR) wT[(idx & 15) * DM + (idx >> 4)] = inp(C, I_ROUTER_W)[idx];
    if (C.tid < 16) hist[C.tid] = 0;
    __syncthreads();
    int* EIDX = (int*)(C.ws + WS_EIDX); float* WTS = (float*)(C.ws + WS_WTS); int* LRANK = (int*)(C.ws + WS_LRANK);
    const float* rb = inp(C, I_ROUTER_B); const float* gain = inp(C, I_NORM_GAIN) + (L * 2 + 1) * DM;
    for (int i0 = 0; i0 < RPW; i0 += 4) {
        const int row0 = wave_row(C, i0), b = row0 / SEQ;
        const float* g1 = MOD + ((size_t)(L * 8 + b) * 6 + 2) * DM; const float* sc2 = MOD + ((size_t)(L * 8 + b) * 6 + 4) * DM; const float* sh2 = MOD + ((size_t)(L * 8 + b) * 6 + 3) * DM;
        f32x4 u[4][4];
#pragma unroll
        for (int rr = 0; rr < 4; ++rr) { const size_t row = row0 + rr;
            f32x4 h[4], y[4]; ld_row_f32(C.hbuf + row * DM, C.lane, h); ld_row_bf16(Y + row * DM, C.lane, y);
            float ss = 0.f;
#pragma unroll
            for (int j = 0; j < 4; ++j) { h[j] += *(const f32x4*)(g1 + 4 * C.lane + 256 * j) * y[j]; ss += (h[j].x * h[j].x + h[j].y * h[j].y) + (h[j].z * h[j].z + h[j].w * h[j].w); }
            const float r = 1.0f / sqrtf(wave_sum_dpp(ss) * (1.0f / DM) + EPS);
#pragma unroll
            for (int j = 0; j < 4; ++j) { const f32x4 g = *(const f32x4*)(gain + 4 * C.lane + 256 * j), s1 = *(const f32x4*)(sc2 + 4 * C.lane + 256 * j), s0 = *(const f32x4*)(sh2 + 4 * C.lane + 256 * j);
                u[rr][j] = (h[j] * r) * g * (s1 + 1.0f) + s0; }
            st_row_bf16(U + row * DM, C.lane, u[rr]); }
        float lg[4][16];
#pragma unroll
        for (int e = 0; e < 16; ++e) { float a0 = 0.f, a1 = 0.f, a2 = 0.f, a3 = 0.f;
#pragma unroll
            for (int j = 0; j < 4; ++j) { const f32x4 w = *(const LAS f32x4*)(wT + e * DM + 256 * j + 4 * C.lane);
                a0 += (u[0][j].x * w.x + u[0][j].y * w.y) + (u[0][j].z * w.z + u[0][j].w * w.w); a1 += (u[1][j].x * w.x + u[1][j].y * w.y) + (u[1][j].z * w.z + u[1][j].w * w.w);
                a2 += (u[2][j].x * w.x + u[2][j].y * w.y) + (u[2][j].z * w.z + u[2][j].w * w.w); a3 += (u[3][j].x * w.x + u[3][j].y * w.y) + (u[3][j].z * w.z + u[3][j].w * w.w); }
            lg[0][e] = wave_sum_dpp(a0); lg[1][e] = wave_sum_dpp(a1); lg[2][e] = wave_sum_dpp(a2); lg[3][e] = wave_sum_dpp(a3); }
#pragma unroll
        for (int rr = 0; rr < 4; ++rr) { const int row = row0 + rr;
            float sc[16], sel[16];
#pragma unroll
            for (int e = 0; e < 16; ++e) { sc[e] = 1.0f / (1.0f + expf(-lg[rr][e])); sel[e] = sc[e] + rb[e]; }
            float bs = -INFINITY, bw0 = 0.f, bw1 = 0.f; int be0 = 0, be1 = 1;
#pragma unroll
            for (int g = 0; g < 4; ++g) {
                const float a0 = sel[4 * g], a1 = sel[4 * g + 1], a2 = sel[4 * g + 2], a3 = sel[4 * g + 3];
                const float c0 = sc[4 * g], c1 = sc[4 * g + 1], c2 = sc[4 * g + 2], c3 = sc[4 * g + 3];
                int i1 = 0; float v1 = a0, s1 = c0;
                if (a1 > v1) { v1 = a1; s1 = c1; i1 = 1; } if (a2 > v1) { v1 = a2; s1 = c2; i1 = 2; } if (a3 > v1) { v1 = a3; s1 = c3; i1 = 3; }
                int i2 = -1; float v2 = -INFINITY, s2 = 0.f;
                if (i1 != 0 && a0 > v2) { v2 = a0; s2 = c0; i2 = 0; } if (i1 != 1 && a1 > v2) { v2 = a1; s2 = c1; i2 = 1; }
                if (i1 != 2 && a2 > v2) { v2 = a2; s2 = c2; i2 = 2; } if (i1 != 3 && a3 > v2) { v2 = a3; s2 = c3; i2 = 3; }
                const float gs = v1 + v2;
                if (gs > bs) { bs = gs; be0 = 4 * g + i1; be1 = 4 * g + i2; bw0 = s1; bw1 = s2; }
            }
            if (C.lane == 0) {
                const float inv = 1.0f / (bw0 + bw1);
                EIDX[2 * row] = be0; EIDX[2 * row + 1] = be1; WTS[2 * row] = bw0 * inv; WTS[2 * row + 1] = bw1 * inv;
                LRANK[2 * row] = __hip_atomic_fetch_add(hist + be0, 1, __ATOMIC_RELAXED, __HIP_MEMORY_SCOPE_WORKGROUP);
                LRANK[2 * row + 1] = __hip_atomic_fetch_add(hist + be1, 1, __ATOMIC_RELAXED, __HIP_MEMORY_SCOPE_WORKGROUP);
            } }
    }
    __syncthreads();
    if (C.tid < 16) ((int*)(C.ws + WS_HIST))[C.blk * 16 + C.tid] = hist[C.tid];
    __syncthreads();
}
DI void phase_s(Ctx& C) {
    const int RPB = T / C.G, RPW = RPB / NWAVES;
    LAS int* tot = (LAS int*)C.lds; LAS int* before = tot + 16; LAS int* base = tot + 32;
    if (C.tid < 48) tot[C.tid] = 0;
    __syncthreads();
    const int* HIST = (const int*)(C.ws + WS_HIST);
    for (int idx = C.tid; idx < C.G * 16; idx += NTHR) { const int bb = idx >> 4, e = idx & 15; const int c = HIST[idx];
        __hip_atomic_fetch_add(tot + e, c, __ATOMIC_RELAXED, __HIP_MEMORY_SCOPE_WORKGROUP);
        if (bb < C.blk) __hip_atomic_fetch_add(before + e, c, __ATOMIC_RELAXED, __HIP_MEMORY_SCOPE_WORKGROUP); }
    __syncthreads();
    if (C.tid == 0) { int ps = 0; int* TILEE = (int*)(C.ws + WS_TILEE);
        for (int e = 0; e < 16; ++e) { base[e] = ps + before[e]; const int pe = (tot[e] + 255) & ~255;
            if (C.blk == 0) for (int tl = ps >> 8; tl < ((ps + pe) >> 8); ++tl) TILEE[tl] = e;
            ps += pe; }
        if (C.blk == 0) *(int*)(C.ws + WS_NTILES) = ps >> 8; }
    __syncthreads();
    const int* EIDX = (const int*)(C.ws + WS_EIDX); const int* LRANK = (const int*)(C.ws + WS_LRANK); int* ROWOF = (int*)(C.ws + WS_ROWOF);
    const bf16* U = (const bf16*)(C.ws + WS_UO); bf16* XS = (bf16*)(C.ws + WS_R1);
    for (int i = 0; i < RPW; ++i) {
        const int row = wave_row(C, i);
        const int d0 = base[EIDX[2 * row]] + LRANK[2 * row], d1 = base[EIDX[2 * row + 1]] + LRANK[2 * row + 1];
        if (C.lane == 0) { ROWOF[2 * row] = d0; ROWOF[2 * row + 1] = d1; }
        const v4u a = *(const v4u*)(U + (size_t)row * DM + 8 * C.lane), bq = *(const v4u*)(U + (size_t)row * DM + 512 + 8 * C.lane);
        *(v4u*)(XS + (size_t)d0 * DM + 8 * C.lane) = a; *(v4u*)(XS + (size_t)d0 * DM + 512 + 8 * C.lane) = bq;
        *(v4u*)(XS + (size_t)d1 * DM + 8 * C.lane) = a; *(v4u*)(XS + (size_t)d1 * DM + 512 + 8 * C.lane) = bq;
    }
    __syncthreads();
}
DI size_t hm(int cb, int b) { return ((size_t)cb * BATCH + b) * SEQ * 64; }
DI void gemm_qkv(Ctx& C, const bf16* A, const bf16* Bt, int Npad, bf16* O, int ldc, int n_main, float* tail, int tail_n) {
    pg8::Gemm g{A, Bt, T, Npad, DM}; pg8::StaticOrder S; S.init(T, Npad, C.G, C.blk);
    pg8::EpiStore E{O, ldc, 1 << 20, n_main, tail, tail_n};
    pg8::gemm_phase<pg8::EpiStore, pg8::StaticOrder, true, true>(C.lds, g, S, E);
}
DI void gemm_qkv_prep(Ctx& C, const bf16* A, const bf16* Bt, int Npad, bf16* O, int ldc, int n_main, float* tail, int tail_n,
                      int k_lo, int k_hi, int k2_lo, int k2_hi, const float* gq, const float* gk, const float* gk2, bool rope, int dilv = 1, int tail_hm = 0) {
    pg8::Gemm g{A, Bt, T, Npad, DM}; pg8::StaticOrder S; S.init(T, Npad, C.G, C.blk);
    pg8::EpiQKVPrep E{O, ldc, n_main, tail, tail_n, k_lo, k_hi, k2_lo, k2_hi, gq, gk, gk2, rope ? (const float*)(C.ws + WS_ROPE) : nullptr, QSC, EPS, SEQ, BATCH, dilv, tail_hm};
    pg8::gemm_phase<pg8::EpiQKVPrep, pg8::StaticOrder, true, true>(C.lds, g, S, E);
}
DI void gemm_moe1(Ctx& C, int L) {
    const int ntiles = *(const int*)(C.ws + WS_NTILES);
    pg8::Gemm g{(const bf16*)(C.ws + WS_R1), (const bf16*)(C.ws + WS_MOEW + (size_t)L * MOEW_LAYER), ntiles * 256, 16 * 1024, DM};
    pg8::MoeOrder S{(const int*)(C.ws + WS_TILEE), ntiles, 4, C.G, C.blk};
    pg8::EpiSwiGLU E{(bf16*)(C.ws + WS_HID), 4};
    pg8::gemm_phase<pg8::EpiSwiGLU, pg8::MoeOrder, true, true>(C.lds, g, S, E);
    if (L < 3) conv_moe_tail(C, L + 1, true);
}
DI void gemm_moe2(Ctx& C, int L) {
    const int ntiles = *(const int*)(C.ws + WS_NTILES);
    pg8::Gemm g{(const bf16*)(C.ws + WS_HID), (const bf16*)(C.ws + WS_MOEW + (size_t)L * MOEW_LAYER + MOEW_D_OFF), ntiles * 256, 16 * 1024, 512};
    pg8::MoeOrder S{(const int*)(C.ws + WS_TILEE), ntiles, 4, C.G, C.blk};
    pg8::EpiStore E{(bf16*)(C.ws + WS_R1), DM, 4, DM, nullptr, 0};
    pg8::gemm_phase<pg8::EpiStore, pg8::MoeOrder, true, true>(C.lds, g, S, E);
    if (L < 3) conv_moe_tail(C, L + 1, false);
}
DI float log_sigmoid_fast(float x) {
    const float ax = fabsf(x), t = __builtin_amdgcn_logf(1.0f + __builtin_amdgcn_exp2f(-ax * LOG2E)) * 0.6931471805599453f;
    return (x < 0.f ? x : 0.f) - t;
}
constexpr int NSA_LDQ = 2560;
DI void nsa_compress(Ctx& C) {
    typedef short bf16x8c __attribute__((ext_vector_type(8)));
    const bf16* QKV = (const bf16*)(C.ws + WS_R1); const f32x2* ROPE = (const f32x2*)(C.ws + WS_ROPE);
    LAS unsigned char* blk = C.lds;
    LAS float* hid = (LAS float*)(C.lds + 133120);
    bf16* KC = (bf16*)(C.ws + WS_KC); bf16* VC = (bf16*)(C.ws + WS_VC);
    const int fr = C.lane & 15, fq = C.lane >> 4;
    for (int task = C.blk; task < 256; task += C.G) {
        const int which = task >> 7, r = task & 127, b = r >> 4, g = (r >> 2) & 3, n0 = (r & 3) * 16;
        const size_t cbase = hm((which == 0 ? 16 : 20) + g, b);
        const float* pos = inp(C, I_NSA_POS) + which * 4096;
        __syncthreads();
        for (int idx = C.tid; idx < 8192; idx += NTHR) { const int rw = idx >> 9, rem = idx & 511, l = rem >> 3, d8 = (rem & 7) * 8;
            const v4u w = *(const v4u*)(QKV + cbase + ((size_t)(n0 + rw) * 64 + l) * 64 + d8);
            const f32x4 p0 = *(const f32x4*)(pos + l * 64 + d8), p1 = *(const f32x4*)(pos + l * 64 + d8 + 4);
            v4u o; o.x = pk2(bflo(w.x) + p0.x, bfhi(w.x) + p0.y); o.y = pk2(bflo(w.y) + p0.z, bfhi(w.y) + p0.w); o.z = pk2(bflo(w.z) + p1.x, bfhi(w.z) + p1.y); o.w = pk2(bflo(w.w) + p1.z, bfhi(w.w) + p1.w);
            *(LAS v4u*)(blk + rw * 8208 + (l * 64 + d8) * 2) = o; }
        __syncthreads();
        { const bf16* wt = (const bf16*)(C.ws + WS_W1T) + ((size_t)which * 128 + 16 * C.wave + fr) * 4096 + 8 * fq;
          LAS const unsigned char* ap = blk + fr * 8208 + 16 * fq;
          f32x4 acc = {0.f, 0.f, 0.f, 0.f};
#pragma unroll 8
          for (int ks = 0; ks < 128; ++ks) { const bf16x8c bv = *(const bf16x8c*)(wt + 32 * ks); const bf16x8c av = *(LAS const bf16x8c*)(ap + 64 * ks);
              acc = __builtin_amdgcn_mfma_f32_16x16x32_bf16(av, bv, acc, 0, 0, 0); }
#pragma unroll
          for (int i = 0; i < 4; ++i) hid[(4 * fq + i) * 128 + 16 * C.wave + fr] = acc[i] / (1.0f + expf(-acc[i])); }
        __syncthreads();
        { const int d = C.lane; const float* w2 = inp(C, I_NSA_W2) + (size_t)which * 128 * 64 + d;
#pragma unroll
          for (int rr = 0; rr < 2; ++rr) { const int rw = 2 * C.wave + rr; float o = 0.f;
#pragma unroll 8
              for (int j = 0; j < 128; ++j) o += hid[rw * 128 + j] * w2[j * 64];
              const size_t oi = (((size_t)b * 4 + g) * 64 + n0 + rw) * 64 + d;
              if (which == 1) VC[oi] = (bf16)f2bf(o);
              else { const float ss = wave_sum(o * o); const float y = o / sqrtf(ss * (1.0f / 64.0f) + EPS) * inp(C, I_NSA_KG)[d];
                  const float pr = __shfl_xor(y, 32); const f32x2 cs = ROPE[((n0 + rw) * 64 + 63) * 32 + (d & 31)];
                  KC[oi] = (bf16)f2bf((d < 32) ? (y * cs.x - pr * cs.y) : (pr * cs.y + y * cs.x)); } } }
    }
    __syncthreads();
}
typedef short bf16x8 __attribute__((ext_vector_type(8)));
typedef short s16x4 __attribute__((ext_vector_type(4)));
typedef float f32x16 __attribute__((ext_vector_type(16)));
typedef __bf16 bf16x2_t __attribute__((ext_vector_type(2)));
namespace fa {
DI int crow(int i, int h) { return (i & 3) + 8 * (i >> 2) + 4 * h; }
DI void glds16(const void* gsrc, unsigned lds_dst) { unsigned keep;
    asm volatile("s_mov_b32 %0, m0\n\ts_mov_b32 m0, %2\n\ts_nop 0\n\tglobal_load_lds_dwordx4 %1, off\n\ts_mov_b32 m0, %0" : "=&s"(keep) : "v"(gsrc), "s"(lds_dst) : "memory"); }
#define FA_WAIT_BAR(N) asm volatile("s_waitcnt vmcnt(" #N ") lgkmcnt(0)\n\ts_barrier" ::: "memory")
DI unsigned cvtpk(float lo, float hi) { f32x2 v = {lo, hi}; bf16x2_t b = __builtin_convertvector(v, bf16x2_t); return __builtin_bit_cast(unsigned, b); }
DI float xmax32(float v) { float a = v, b = v; asm volatile("s_nop 1\n\tv_permlane32_swap_b32 %0, %1\n\ts_nop 1" : "+v"(a), "+v"(b)); return fmaxf(a, b); }
DI float xsum32(float v) { float a = v, b = v; asm volatile("s_nop 1\n\tv_permlane32_swap_b32 %0, %1\n\ts_nop 1" : "+v"(a), "+v"(b)); return a + b; }
typedef short v4i16_t __attribute__((ext_vector_type(4)));
DI s16x4 vtr(LAS const char* p) { return __builtin_bit_cast(s16x4, __builtin_amdgcn_ds_read_tr16_b64_v4i16((LAS v4i16_t*)p)); }
constexpr int KSLOT = 8192, KRING = 3 * KSLOT;
DI void qk(LAS const char* ks, const bf16x8 (&qf)[4], int lane, f32x16& p0, f32x16& p1) {
    const int r = lane & 31, h = lane >> 5;
#pragma unroll
    for (int i = 0; i < 16; ++i) { p0[i] = 0.f; p1[i] = 0.f; }
    LAS const char* kb = ks + r * 128;
#pragma unroll
    for (int d0 = 0; d0 < 4; ++d0) {
        const int ko = ((2 * d0 + h) ^ (r & 7)) * 16;
        const bf16x8 a0 = *(LAS const bf16x8*)(kb + ko), a1 = *(LAS const bf16x8*)(kb + ko + 4096);
        p0 = __builtin_amdgcn_mfma_f32_32x32x16_bf16(a0, qf[d0], p0, 0, 0, 0);
        p1 = __builtin_amdgcn_mfma_f32_32x32x16_bf16(a1, qf[d0], p1, 0, 0, 0);
    }
}
template <int DV>
DI void pv(LAS const char* vs, int lane, const f32x16& p0, const f32x16& p1, f32x16 (&o)[DV / 32]) {
    const int h = lane >> 5;
    bf16x8 pf[4];
#pragma unroll
    for (int s = 0; s < 2; ++s) {
        v4u w0, w1;
        w0.x = cvtpk(p0[8 * s], p0[8 * s + 1]); w0.y = cvtpk(p0[8 * s + 2], p0[8 * s + 3]); w0.z = cvtpk(p0[8 * s + 4], p0[8 * s + 5]); w0.w = cvtpk(p0[8 * s + 6], p0[8 * s + 7]);
        w1.x = cvtpk(p1[8 * s], p1[8 * s + 1]); w1.y = cvtpk(p1[8 * s + 2], p1[8 * s + 3]); w1.z = cvtpk(p1[8 * s + 4], p1[8 * s + 5]); w1.w = cvtpk(p1[8 * s + 6], p1[8 * s + 7]);
        pf[s] = __builtin_bit_cast(bf16x8, w0); pf[2 + s] = __builtin_bit_cast(bf16x8, w1);
    }
    LAS const char* vb = vs + ((lane >> 4) & 1) * 32 + (lane & 3) * 8 + (4 * h + ((lane & 15) >> 2)) * 64;
#pragma unroll
    for (int kq = 0; kq < 4; ++kq)
#pragma unroll
        for (int b = 0; b < DV / 32; ++b) {
            const s16x4 lo = vtr(vb + (b * 4 + kq) * 1024), hi = vtr(vb + (b * 4 + kq) * 1024 + 512);
            const bf16x8 vf = {lo[0], lo[1], lo[2], lo[3], hi[0], hi[1], hi[2], hi[3]};
            o[b] = __builtin_amdgcn_mfma_f32_32x32x16_bf16(vf, pf[kq], o[b], 0, 0, 0);
        }
}
template <int DV>
DI void store_o(bf16* orow, int h, const f32x16 (&o)[DV / 32], float sc) {
#pragma unroll
    for (int b = 0; b < DV / 32; ++b)
#pragma unroll
        for (int g4 = 0; g4 < 4; ++g4) { v2u w; w.x = cvtpk(o[b][4 * g4] * sc, o[b][4 * g4 + 1] * sc); w.y = cvtpk(o[b][4 * g4 + 2] * sc, o[b][4 * g4 + 3] * sc);
            *(v2u*)(orow + 32 * b + 8 * g4 + 4 * h) = w; }
}
}
namespace fa2 {
constexpr int NS = 4;
constexpr float THR = 8.0f;
DI void qk(LAS const char* ks, const bf16x8 (&qf)[4], int lane, const f32x16& negm, f32x16& p0, f32x16& p1) {
    const int r = lane & 31, h = lane >> 5;
    LAS const char* kb = ks + r * 128;
    { const int ko = (h ^ (r & 7)) * 16; const bf16x8 a0 = *(LAS const bf16x8*)(kb + ko), a1 = *(LAS const bf16x8*)(kb + ko + 4096);
      p0 = __builtin_amdgcn_mfma_f32_32x32x16_bf16(a0, qf[0], negm, 0, 0, 0); p1 = __builtin_amdgcn_mfma_f32_32x32x16_bf16(a1, qf[0], negm, 0, 0, 0); }
#pragma unroll
    for (int d0 = 1; d0 < 4; ++d0) {
        const int ko = ((2 * d0 + h) ^ (r & 7)) * 16;
        const bf16x8 a0 = *(LAS const bf16x8*)(kb + ko), a1 = *(LAS const bf16x8*)(kb + ko + 4096);
        p0 = __builtin_amdgcn_mfma_f32_32x32x16_bf16(a0, qf[d0], p0, 0, 0, 0);
        p1 = __builtin_amdgcn_mfma_f32_32x32x16_bf16(a1, qf[d0], p1, 0, 0, 0);
    }
}
template <int DV, bool NOMAX = false>
DI void softmax(f32x16& c0, f32x16& c1, f32x16& n0, f32x16& n1, bool fixn, f32x16 (&o)[DV / 32], float& m, float& l, f32x16& negm, float qbias, bool nomax_rt = false) {
  if constexpr (!NOMAX) { if (!nomax_rt) {
    float mxa = fmaxf(c0[0], c0[1]), mxb = fmaxf(c1[0], c1[1]);
#pragma unroll
    for (int i = 2; i < 16; ++i) { mxa = fmaxf(mxa, c0[i]); mxb = fmaxf(mxb, c1[i]); }
    float mx = fa::xmax32(fmaxf(mxa, mxb));
    if (__any(mx > THR)) {
        const float dl = fmaxf(mx, 0.f), a = __builtin_amdgcn_exp2f(-dl); m += dl; l *= a;
#pragma unroll
        for (int b = 0; b < DV / 32; ++b)
#pragma unroll
            for (int i = 0; i < 16; ++i) o[b][i] *= a;
#pragma unroll
        for (int i = 0; i < 16; ++i) { c0[i] -= dl; c1[i] -= dl; negm[i] = qbias - m; }
        asm volatile("" : "+v"(negm));
        if (fixn) {
#pragma unroll
            for (int i = 0; i < 16; ++i) { n0[i] -= dl; n1[i] -= dl; } }
    }
  } }
#pragma unroll
    for (int i = 0; i < 16; ++i) { c0[i] = __builtin_amdgcn_exp2f(c0[i]); c1[i] = __builtin_amdgcn_exp2f(c1[i]); l += c0[i]; l += c1[i]; }
}
template <int DV, class KP, class VP, class Act, class Pre>
DI void loop(LAS char* shm, int wid, int lane, const bf16x8 (&qf)[4], int ntiles, KP kp, VP vp, Act act, Pre pre, f32x16 (&o)[DV / 32], float& m, float& l, float qbias = 0.f) {
    constexpr int VSLOT = DV * 128, KR = NS * fa::KSLOT;
    const unsigned ldsK = (unsigned)(size_t)shm, ldsV = ldsK + KR;
#define FA2_ISSUE(i, s) do { fa::glds16(kp(i), (unsigned)__builtin_amdgcn_readfirstlane(ldsK + (s) * fa::KSLOT + wid * 1024)); \
        _Pragma("unroll") for (int pc_ = 0; pc_ < DV / 64; ++pc_) fa::glds16(vp((i), wid + 8 * pc_), (unsigned)__builtin_amdgcn_readfirstlane(ldsV + (s) * VSLOT + (wid + 8 * pc_) * 1024)); } while (0)
    if (ntiles > 0) FA2_ISSUE(0, 0);
    if (ntiles > 1) FA2_ISSUE(1, 1);
    if (ntiles > 2) FA2_ISSUE(2, 2);
    if (ntiles > 2) { if (DV == 64) FA_WAIT_BAR(4); else FA_WAIT_BAR(6); } else if (ntiles > 1) { if (DV == 64) FA_WAIT_BAR(2); else FA_WAIT_BAR(3); } else FA_WAIT_BAR(0);
    f32x16 negm, cA0, cA1, cB0, cB1;
#pragma unroll
    for (int i = 0; i < 16; ++i) { negm[i] = qbias - m; cA0[i] = 0.f; cA1[i] = 0.f; cB0[i] = 0.f; cB1[i] = 0.f; }
    asm volatile("" : "+v"(negm));
    bool actc = ntiles > 0 && act(0);
    if (actc) qk((LAS const char*)shm, qf, lane, negm, cA0, cA1);
    int sc = 0, sn = 1, s3 = 3;
#define FA2_STEP(C0, C1, N0, N1, i) do { \
        if ((i) + 1 < ntiles) { if ((i) + 2 < ntiles) { if (DV == 64) FA_WAIT_BAR(2); else FA_WAIT_BAR(3); } else FA_WAIT_BAR(0); } \
        if ((i) + 3 < ntiles) FA2_ISSUE((i) + 3, s3); \
        const bool actn_ = ((i) + 1 < ntiles) && act((i) + 1); \
        if (actn_) qk((LAS const char*)shm + sn * fa::KSLOT, qf, lane, negm, N0, N1); \
        if (actc) { pre((i), C0, C1); softmax<DV>(C0, C1, N0, N1, actn_, o, m, l, negm, qbias); fa::pv<DV>((LAS const char*)shm + KR + sc * VSLOT, lane, C0, C1, o); } \
        actc = actn_; sc = sn; sn = (sn == NS - 1) ? 0 : sn + 1; s3 = (s3 == NS - 1) ? 0 : s3 + 1; } while (0)
    int i = 0;
    for (; i + 1 < ntiles; i += 2) { FA2_STEP(cA0, cA1, cB0, cB1, i); FA2_STEP(cB0, cB1, cA0, cA1, i + 1); }
    if (i < ntiles) FA2_STEP(cA0, cA1, cB0, cB1, i);
    FA_WAIT_BAR(0);
#undef FA2_STEP
#undef FA2_ISSUE
}
}

namespace fa3 {
template <int DV, class KP, class VP>
DI void issue01(LAS char* shm, int wid, int ntiles, KP kp, VP vp) {
    constexpr int VSLOT = DV * 128;
    const unsigned ldsK = (unsigned)(size_t)shm, ldsV = ldsK + fa::KRING;
#pragma unroll
    for (int t = 0; t < 2; ++t) if (t < ntiles) {
        fa::glds16(kp(t), (unsigned)__builtin_amdgcn_readfirstlane(ldsK + t * fa::KSLOT + wid * 1024));
#pragma unroll
        for (int pc_ = 0; pc_ < DV / 64; ++pc_) fa::glds16(vp(t, wid + 8 * pc_), (unsigned)__builtin_amdgcn_readfirstlane(ldsV + t * VSLOT + (wid + 8 * pc_) * 1024)); }
}
struct NoPf { DI void operator()() const {} };
template <int DV, bool NOMAX = false, class KP, class VP, class Act, class Pre, class PF = NoPf>
DI void loop(LAS char* shm, int wid, int lane, const bf16x8 (&qf)[4], int ntiles, KP kp, VP vp, Act act, Pre pre, f32x16 (&o)[DV / 32], float& m, float& l, float qbias = 0.f, bool pre_issued = false, PF pf_next = PF(), bool nomax_rt = false) {
    constexpr int VSLOT = DV * 128;
    const unsigned ldsK = (unsigned)(size_t)shm, ldsV = ldsK + fa::KRING;
#define FA3_ISSUE(i, s) do { fa::glds16(kp(i), (unsigned)__builtin_amdgcn_readfirstlane(ldsK + (s) * fa::KSLOT + wid * 1024)); \
        _Pragma("unroll") for (int pc_ = 0; pc_ < DV / 64; ++pc_) fa::glds16(vp((i), wid + 8 * pc_), (unsigned)__builtin_amdgcn_readfirstlane(ldsV + (s) * VSLOT + (wid + 8 * pc_) * 1024)); } while (0)
    if (!pre_issued) issue01<DV>(shm, wid, ntiles, kp, vp);
    f32x16 negm, dummy0, dummy1;
#pragma unroll
    for (int i = 0; i < 16; ++i) { negm[i] = qbias - m; dummy0[i] = 0.f; dummy1[i] = 0.f; }
    asm volatile("" : "+v"(negm));
    int sc = 0, sn2 = 2;
    for (int i = 0; i < ntiles; ++i) {
        if (i + 1 < ntiles) { if (DV == 64) FA_WAIT_BAR(2); else FA_WAIT_BAR(3); } else FA_WAIT_BAR(0);
        if (i + 2 < ntiles) FA3_ISSUE(i + 2, sn2);
        if (act(i)) {
            f32x16 c0, c1;
            fa2::qk((LAS const char*)shm + sc * fa::KSLOT, qf, lane, negm, c0, c1);
            pre(i, c0, c1);
            fa2::softmax<DV, NOMAX>(c0, c1, dummy0, dummy1, false, o, m, l, negm, qbias, nomax_rt);
            fa::pv<DV>((LAS const char*)shm + fa::KRING + sc * VSLOT, lane, c0, c1, o);
        }
        sc = (sc == 2) ? 0 : sc + 1; sn2 = (sn2 == 2) ? 0 : sn2 + 1;
    }
    FA_WAIT_BAR(0);
    pf_next();
#undef FA3_ISSUE
}
}

namespace fa4 {
constexpr int NSL = 6, KR6 = NSL * fa::KSLOT;
template <class KP, class VP>
DI void issue_all(LAS char* shm, int wid, int ntiles, KP kp, VP vp) {
    const unsigned ldsK = (unsigned)(size_t)shm, ldsV = ldsK + KR6;
#pragma unroll
    for (int t = 0; t < NSL; ++t) if (t < ntiles) {
        fa::glds16(kp(t), (unsigned)__builtin_amdgcn_readfirstlane(ldsK + t * fa::KSLOT + wid * 1024));
        fa::glds16(vp(t, wid), (unsigned)__builtin_amdgcn_readfirstlane(ldsV + t * 8192 + wid * 1024)); }
}
template <bool NOMAX = false, class KP, class VP, class Act, class Pre, class PF>
DI void loop(LAS char* shm, int wid, int lane, const bf16x8 (&qf)[4], int ntiles, KP kp, VP vp, Act act, Pre pre, f32x16 (&o)[2], float& m, float& l, bool pre_issued, PF pf_next) {
    if (!pre_issued) issue_all(shm, wid, ntiles, kp, vp);
    f32x16 negm, dummy0, dummy1;
#pragma unroll
    for (int i = 0; i < 16; ++i) { negm[i] = -m; dummy0[i] = 0.f; dummy1[i] = 0.f; }
    asm volatile("" : "+v"(negm));
    FA_WAIT_BAR(0);
    for (int i = 0; i < ntiles; ++i) {
        if (act(i)) {
            f32x16 c0, c1;
            fa2::qk((LAS const char*)shm + i * fa::KSLOT, qf, lane, negm, c0, c1);
            pre(i, c0, c1);
            fa2::softmax<64, NOMAX>(c0, c1, dummy0, dummy1, false, o, m, l, negm, 0.f);
            fa::pv<64>((LAS const char*)shm + KR6 + i * 8192, lane, c0, c1, o);
        }
    }
    FA_WAIT_BAR(0);
    pf_next();
}
}

namespace fa5 {
template <int DV, int CH, bool NOMAX = false, class KP, class VP, class Act, class Pre>
DI void loop(LAS char* shm, int wid, int lane, const bf16x8 (&qf)[4], int ntiles, KP kp, VP vp, Act act, Pre pre, f32x16 (&o)[DV / 32], float& m, float& l, float qbias = 0.f) {
    constexpr int VSLOT = DV * 128, KR = 2 * CH * fa::KSLOT;
    const unsigned ldsK = (unsigned)(size_t)shm, ldsV = ldsK + KR;
    const int nch = (ntiles + CH - 1) / CH;
#define FA5_ISSUE_CHUNK(c) do { const int bank_ = (c) & 1; _Pragma("unroll") for (int t_ = 0; t_ < CH; ++t_) { const int ti_ = (c) * CH + t_; if (ti_ < ntiles) { const int s_ = bank_ * CH + t_; \
        fa::glds16(kp(ti_), (unsigned)__builtin_amdgcn_readfirstlane(ldsK + s_ * fa::KSLOT + wid * 1024)); \
        _Pragma("unroll") for (int pc_ = 0; pc_ < DV / 64; ++pc_) fa::glds16(vp(ti_, wid + 8 * pc_), (unsigned)__builtin_amdgcn_readfirstlane(ldsV + s_ * VSLOT + (wid + 8 * pc_) * 1024)); } } } while (0)
    if (nch > 0) FA5_ISSUE_CHUNK(0);
    f32x16 negm, dummy0, dummy1;
#pragma unroll
    for (int i = 0; i < 16; ++i) { negm[i] = qbias - m; dummy0[i] = 0.f; dummy1[i] = 0.f; }
    asm volatile("" : "+v"(negm));
    for (int c = 0; c < nch; ++c) {
        FA_WAIT_BAR(0);
        if (c + 1 < nch) FA5_ISSUE_CHUNK(c + 1);
        if (wid >= 4) __builtin_amdgcn_s_sleep(10);
        const int bank = c & 1;
#pragma unroll
        for (int t = 0; t < CH; ++t) { const int i = c * CH + t;
            if (i < ntiles && act(i)) {
                f32x16 c0, c1;
                fa2::qk((LAS const char*)shm + (bank * CH + t) * fa::KSLOT, qf, lane, negm, c0, c1);
                pre(i, c0, c1);
                fa2::softmax<DV, NOMAX>(c0, c1, dummy0, dummy1, false, o, m, l, negm, qbias);
                fa::pv<DV>((LAS const char*)shm + KR + (bank * CH + t) * VSLOT, lane, c0, c1, o);
            } }
    }
    FA_WAIT_BAR(0);
#undef FA5_ISSUE_CHUNK
}
}
constexpr int FA_CUM_OFF = 98304;
template <bool NOMAX> DI void attn_fox_impl(Ctx& C, float B2) {
    if (C.wave >= 4) __builtin_amdgcn_s_setprio(1);
    const int vblk = (C.blk % 8) * (C.G / 8) + C.blk / 8;
    const bf16* QKV = (const bf16*)(C.ws + WS_R1); bf16* O = (bf16*)(C.ws + WS_UO); const float* FLOG = (const float*)(C.ws + WS_FLOG);
    const int lane = C.lane, wid = C.wave, r = lane & 31, h2 = lane >> 5;
    LAS float* cumL = (LAS float*)(C.lds + FA_CUM_OFF);
    const float skip_thr = -(150.0f + 2.0f * B2);
    const int nunits = BATCH * 16 * 16;
    unsigned* qctr = (unsigned*)(C.ws + WS_CTL) + 8192;
    LAS int* qslot = (LAS int*)(C.lds + FA_CUM_OFF + 16384 + 64);
    for (;;) {
        if (C.tid == 0) *qslot = (int)__hip_atomic_fetch_add(qctr, 1u, __ATOMIC_RELAXED, __HIP_MEMORY_SCOPE_AGENT);
        asm volatile("s_waitcnt vmcnt(0) lgkmcnt(0)" ::: "memory"); __builtin_amdgcn_s_barrier();
        const int u = __builtin_amdgcn_readfirstlane(*qslot);
        if (u >= nunits) break;
        const int qblk = 15 - (u >> 7), bh = u & 127;
        const int b = bh / 16, hd = bh % 16;
        TS_SECT_BEGIN(C, 1);
        const int nt = 4 * qblk + 4;
        { const float bfv = inp(C, I_FOX_BF)[hd]; const int t0 = 8 * C.tid; const bool on = t0 < 64 * nt;
          float ls[8]; float run = 0.f; float fl[8];
          { const float* fp = FLOG + ((size_t)b * 16 + hd) * SEQ + (on ? t0 : 0); const f32x4 fa_ = *(const f32x4*)fp, fb_ = *(const f32x4*)(fp + 4);
            fl[0] = fa_.x; fl[1] = fa_.y; fl[2] = fa_.z; fl[3] = fa_.w; fl[4] = fb_.x; fl[5] = fb_.y; fl[6] = fb_.z; fl[7] = fb_.w; }
#pragma unroll
          for (int e = 0; e < 8; ++e) { ls[e] = on ? log_sigmoid_fast(fl[e] + bfv) : 0.f; run += ls[e]; ls[e] = run; }
          float inc = run;
#pragma unroll
          for (int of = 1; of < 64; of <<= 1) { const float v = __shfl_up(inc, of); if (lane >= of) inc += v; }
          LAS float* wtot = cumL + 4096;
          if (lane == 63) wtot[wid] = inc;
          asm volatile("s_waitcnt lgkmcnt(0)" ::: "memory"); __builtin_amdgcn_s_barrier();
          float base = inc - run;
#pragma unroll
          for (int w = 0; w < 8; ++w) base += (w < wid) ? wtot[w] : 0.f;
          if (on) { *(LAS f32x4*)(cumL + t0) = (f32x4){(base + ls[0]) * LOG2E, (base + ls[1]) * LOG2E, (base + ls[2]) * LOG2E, (base + ls[3]) * LOG2E};
                    *(LAS f32x4*)(cumL + t0 + 4) = (f32x4){(base + ls[4]) * LOG2E, (base + ls[5]) * LOG2E, (base + ls[6]) * LOG2E, (base + ls[7]) * LOG2E}; } }
        const int tq = 256 * qblk + 32 * wid + r; const size_t row = (size_t)b * SEQ + tq;
        bf16x8 qf[4];
#pragma unroll
        for (int d0 = 0; d0 < 4; ++d0) qf[d0] = *(const bf16x8*)(QKV + hm(hd, b) + (size_t)tq * 64 + d0 * 16 + h2 * 8);
        const bf16* kbase = QKV + hm(16 + hd, b) + (size_t)(8 * wid + (lane >> 3)) * 64 + (((lane & 7) ^ ((lane >> 3) & 7)) * 8);
        const bf16* vbase = QKV + hm(32 + hd, b) + (size_t)(16 * (wid & 3) + (lane >> 2)) * 64 + (wid >> 2) * 32 + (lane & 3) * 8;
        const int jdiag = 4 * qblk + (wid >> 1), qloc = 32 * (wid & 1) + r;
        f32x16 o[2]; float m = 0.f, l = 0.f;
#pragma unroll
        for (int i = 0; i < 16; ++i) { o[0][i] = 0.f; o[1][i] = 0.f; }
        asm volatile("s_waitcnt lgkmcnt(0)" ::: "memory"); __builtin_amdgcn_s_barrier();
        const float cq = cumL[tq];
        int jlo; { const float c0 = cumL[256 * qblk]; const int jj = lane < nt - 1 ? lane : nt - 1; const unsigned long long keep = __ballot(lane >= nt - 1 || !(c0 - cumL[64 * jj + 63] < skip_thr));
                   jlo = __builtin_amdgcn_readfirstlane(__builtin_ctzll(keep)); }
        TS_SECT_END(C, 1); TS_SECT_BEGIN(C, 2);
        fa5::loop<64, 3, NOMAX>((LAS char*)C.lds, wid, lane, qf, nt - jlo,
            [&](int i) { return kbase + (size_t)(nt - 1 - i) * 4096; },
            [&](int i, int) { return vbase + (size_t)(nt - 1 - i) * 4096; },
            [&](int i) { return (nt - 1 - i) <= jdiag; },
            [&](int i, f32x16& p0, f32x16& p1) { const int j = nt - 1 - i; const LAS float* cl = cumL + 64 * j + 4 * h2;
#pragma unroll
                for (int g4 = 0; g4 < 4; ++g4) { const f32x4 c0 = *(const LAS f32x4*)(cl + 8 * g4), c1 = *(const LAS f32x4*)(cl + 32 + 8 * g4);
                    p0[4 * g4] -= c0.x; p0[4 * g4 + 1] -= c0.y; p0[4 * g4 + 2] -= c0.z; p0[4 * g4 + 3] -= c0.w;
                    p1[4 * g4] -= c1.x; p1[4 * g4 + 1] -= c1.y; p1[4 * g4 + 2] -= c1.z; p1[4 * g4 + 3] -= c1.w; }
                if (j == jdiag) { int ql = qloc; asm volatile("" : "+v"(ql));
#pragma unroll
                    for (int ii = 0; ii < 16; ++ii) { const int kv = fa::crow(ii, h2); if (kv > ql) p0[ii] = -INFINITY; if (kv + 32 > ql) p1[ii] = -INFINITY; } } },
            o, m, l, cq);
        TS_SECT_END(C, 2); TS_SECT_BEGIN(C, 3);
        l = fa::xsum32(l);
        fa::store_o<64>(O + row * DM + hd * 64, h2, o, 1.0f / l);
        TS_SECT_END(C, 3);
    }
}
DI float score_bound(const float* gq, const float* gk, int lane) { return 64.0f * wave_max(fabsf(gq[lane])) * wave_max(fabsf(gk[lane])) * QSC * 1.05f; }
constexpr float NOMAX_BOUND = 60.0f;
DI void attn_fox_fast(Ctx& C) {
    const float B2 = score_bound(inp(C, I_FOX_QG), inp(C, I_FOX_KG), C.lane);
    if (B2 <= NOMAX_BOUND) attn_fox_impl<true>(C, B2); else attn_fox_impl<false>(C, B2);
}
template <bool NOMAX> DI void attn_diff_impl(Ctx& C) {
    if (C.wave >= 4) __builtin_amdgcn_s_setprio(1);
    const int vblk = (C.blk % 8) * (C.G / 8) + C.blk / 8;
    const bf16* QKV = (const bf16*)(C.ws + WS_R1); bf16* O = (bf16*)(C.ws + WS_UO);
    const int lane = C.lane, wid = C.wave, r = lane & 31, h2 = lane >> 5;
    const float lam_init = 0.8f - 0.6f * expf(-0.3f * 3.0f);
    const float* lm = inp(C, I_DIFF_LAM);
    const float lam = expf(wave_sum(lm[lane] * lm[64 + lane])) - expf(wave_sum(lm[128 + lane] * lm[192 + lane])) + lam_init;
    const float* sg = inp(C, I_DIFF_SG);
    const int nunits = BATCH * 8 * 16, per = (nunits + C.G - 1) / C.G;
    for (int ui = 0; ui < per; ++ui) {
        const int u = vblk * per + ui; if (u >= nunits) break;
        const int bh = u / 16, k16 = u % 16, pair = k16 >> 1, qblk = (k16 & 1) ? (15 - pair) : pair;
        const int b = bh / 8, hd = bh % 8;
        const int nt = 4 * qblk + 4;
        const int tq = 256 * qblk + 32 * wid + r; const size_t row = (size_t)b * SEQ + tq;
        const bf16* vbase = QKV + hm(32 + 2 * hd, b) + (size_t)(16 * (wid & 3) + (lane >> 2)) * 64 + (wid >> 2) * 32 + (lane & 3) * 8;
        const int jdiag = 4 * qblk + (wid >> 1), qloc = 32 * (wid & 1) + r;
        bf16* op = O + row * DM + hd * 128;
#pragma unroll
        for (int c = 0; c < 2; ++c) {
            const int hh = 2 * hd + c;
            bf16x8 qf[4];
#pragma unroll
            for (int d0 = 0; d0 < 4; ++d0) qf[d0] = *(const bf16x8*)(QKV + hm(hh, b) + (size_t)tq * 64 + d0 * 16 + h2 * 8);
            const bf16* kbase = QKV + hm(16 + hh, b) + (size_t)(8 * wid + (lane >> 3)) * 64 + (((lane & 7) ^ ((lane >> 3) & 7)) * 8);
            f32x16 o[4]; float m = 0.f, l = 0.f;
#pragma unroll
            for (int bq = 0; bq < 4; ++bq)
#pragma unroll
                for (int i = 0; i < 16; ++i) o[bq][i] = 0.f;
            fa5::loop<128, 2, NOMAX>((LAS char*)C.lds, wid, lane, qf, nt,
                [&](int i) { return kbase + (size_t)(nt - 1 - i) * 4096; },
                [&](int i, int pc) { return vbase + (size_t)(nt - 1 - i) * 4096 + (pc >= 8 ? (size_t)BATCH * SEQ * 64 : (size_t)0); },
                [&](int i) { return (nt - 1 - i) <= jdiag; },
                [&](int i, f32x16& p0, f32x16& p1) { const int j = nt - 1 - i;
                    if (j == jdiag) { int ql = qloc; asm volatile("" : "+v"(ql));
#pragma unroll
                        for (int ii = 0; ii < 16; ++ii) { const int kv = fa::crow(ii, h2); if (kv > ql) p0[ii] = -INFINITY; if (kv + 32 > ql) p1[ii] = -INFINITY; } } },
                o, m, l);
            const float il = 1.0f / fa::xsum32(l);
            if (c == 0) { fa::store_o<128>(op, h2, o, il); asm volatile("s_waitcnt vmcnt(0)" ::: "memory"); }
            else {
                const float sc = -lam * il; float ss = 0.f;
#pragma unroll
                for (int bq = 0; bq < 4; ++bq)
#pragma unroll
                    for (int g4 = 0; g4 < 4; ++g4) { const v2u w = *(const v2u*)(op + 32 * bq + 8 * g4 + 4 * h2);
                        o[bq][4 * g4] = bflo(w.x) + sc * o[bq][4 * g4]; o[bq][4 * g4 + 1] = bfhi(w.x) + sc * o[bq][4 * g4 + 1]; o[bq][4 * g4 + 2] = bflo(w.y) + sc * o[bq][4 * g4 + 2]; o[bq][4 * g4 + 3] = bfhi(w.y) + sc * o[bq][4 * g4 + 3];
                        ss += (o[bq][4 * g4] * o[bq][4 * g4] + o[bq][4 * g4 + 1] * o[bq][4 * g4 + 1]) + (o[bq][4 * g4 + 2] * o[bq][4 * g4 + 2] + o[bq][4 * g4 + 3] * o[bq][4 * g4 + 3]); }
                ss = fa::xsum32(ss);
                const float rn = (1.0f - lam_init) / sqrtf(ss * (1.0f / 128.0f) + EPS);
#pragma unroll
                for (int bq = 0; bq < 4; ++bq)
#pragma unroll
                    for (int g4 = 0; g4 < 4; ++g4) { const f32x4 gn = *(const f32x4*)(sg + 32 * bq + 8 * g4 + 4 * h2);
                        o[bq][4 * g4] *= rn * gn.x; o[bq][4 * g4 + 1] *= rn * gn.y; o[bq][4 * g4 + 2] *= rn * gn.z; o[bq][4 * g4 + 3] *= rn * gn.w; }
                asm volatile("" ::: "memory");
                fa::store_o<128>(op, h2, o, 1.0f);
            }
        }
    }
}
DI void attn_diff_fast(Ctx& C) {
    if (score_bound(inp(C, I_DIFF_QG), inp(C, I_DIFF_KG), C.lane) <= NOMAX_BOUND) attn_diff_impl<true>(C); else attn_diff_impl<false>(C);
}
struct DilUnit { const bf16* kb; const bf16* vb; int jlo, nt; };
DI DilUnit dil_unit(const bf16* QKV, int u, int nub, int dil, int lane, int wid) {
    const int bh = u / 16, k16 = u % 16, b = bh / 16, hd = bh % 16, res = k16 / nub, ublk = k16 % nub;
    const size_t p0 = (size_t)res * (SEQ / dil);
    DilUnit d;
    d.jlo = (4 * ublk - 2) > 0 ? (4 * ublk - 2) : 0; d.nt = 4 * ublk + 4 - d.jlo;
    d.kb = QKV + hm(16 + hd, b) + (p0 + (size_t)d.jlo * 64 + 8 * wid + (lane >> 3)) * 64 + (((lane & 7) ^ ((lane >> 3) & 7)) * 8);
    d.vb = QKV + hm(32 + hd, b) + (p0 + (size_t)d.jlo * 64 + 16 * (wid & 3) + (lane >> 2)) * 64 + (wid >> 2) * 32 + (lane & 3) * 8;
    return d;
}
template <bool NOMAX> DI void attn_dil_impl(Ctx& C, int gi, int dil) {
    if (C.wave >= 4) __builtin_amdgcn_s_setprio(1);
    const int vblk = (C.blk % 8) * (C.G / 8) + C.blk / 8;
    const bf16* QKV = (const bf16*)(C.ws + WS_R1); bf16* O = (bf16*)(C.ws + WS_O2); float* LSE = (float*)(C.ws + WS_LSE);
    const int lane = C.lane, wid = C.wave, r = lane & 31, h2 = lane >> 5;
    const int nub = (SEQ / dil) / 256;
    const int nunits = BATCH * 16 * 16, per = (nunits + C.G - 1) / C.G;
    const size_t ts = 4096;
    bool pre_issued = false;
    for (int ui = 0; ui < per; ++ui) {
        const int u = vblk * per + ui; if (u >= nunits) break;
        TS_SECT_BEGIN(C, 7);
        const int bh = u / 16, k16 = u % 16, b = bh / 16, hd = bh % 16, res = k16 / nub, ublk = k16 % nub;
        const int uq = 256 * ublk + 32 * wid + r; const size_t row = (size_t)b * SEQ + (size_t)uq * dil + res;
        bf16x8 qf[4];
#pragma unroll
        for (int d0 = 0; d0 < 4; ++d0) qf[d0] = *(const bf16x8*)(QKV + hm(hd, b) + ((size_t)res * (SEQ / dil) + uq) * 64 + d0 * 16 + h2 * 8);
        const DilUnit du = dil_unit(QKV, u, nub, dil, lane, wid);
        const bool has_next = (ui + 1 < per) && (u + 1 < nunits);
        const DilUnit dn = dil_unit(QKV, has_next ? u + 1 : u, nub, dil, lane, wid);
        const int jlo = du.jlo, nt = du.nt;
        const int jw_hi = 4 * ublk + (wid >> 1), jw_lo = jw_hi - 2;
        f32x16 o[2]; float m = 0.f, l = 0.f;
#pragma unroll
        for (int i = 0; i < 16; ++i) { o[0][i] = 0.f; o[1][i] = 0.f; }
        TS_SECT_END(C, 7); TS_SECT_BEGIN(C, 8);
        fa4::loop<NOMAX>((LAS char*)C.lds, wid, lane, qf, nt,
            [&](int i) { return du.kb + (size_t)i * ts; },
            [&](int i, int) { return du.vb + (size_t)i * ts; },
            [&](int i) { const int j = jlo + i; return j >= jw_lo && j <= jw_hi; },
            [&](int i, f32x16& p0, f32x16& p1) { const int j = jlo + i;
                if (j == jw_hi) { int dlt = uq - 64 * j; asm volatile("" : "+v"(dlt));
#pragma unroll
                    for (int ii = 0; ii < 16; ++ii) { const int kv = fa::crow(ii, h2); if (kv > dlt) p0[ii] = -INFINITY; if (kv + 32 > dlt) p1[ii] = -INFINITY; } }
                else if (j == jw_lo) { int dlt = uq - 64 * j - 128; asm volatile("" : "+v"(dlt));
#pragma unroll
                    for (int ii = 0; ii < 16; ++ii) { const int kv = fa::crow(ii, h2); if (kv < dlt) p0[ii] = -INFINITY; if (kv + 32 < dlt) p1[ii] = -INFINITY; } } },
            o, m, l, pre_issued,
            [&]() { if (has_next) fa4::issue_all((LAS char*)C.lds, wid, dn.nt, [&](int t) { return dn.kb + (size_t)t * ts; }, [&](int t, int) { return dn.vb + (size_t)t * ts; }); });
        TS_SECT_END(C, 8); TS_SECT_BEGIN(C, 9);
        pre_issued = has_next;
        l = fa::xsum32(l);
        const float inv = 1.0f / l, lse = m + log2f(l);
        bf16* op = O + row * DM + hd * 64;
        if (gi == 0) { fa::store_o<64>(op, h2, o, inv); if (h2 == 0) LSE[row * 16 + hd] = lse; }
        else {
            const float lo = LSE[row * 16 + hd], mx = fmaxf(lo, lse), ea = __builtin_amdgcn_exp2f(lo - mx), eb = __builtin_amdgcn_exp2f(lse - mx), rs2 = 1.0f / (ea + eb), fa_ = ea * rs2, fb = eb * rs2 * inv;
#pragma unroll
            for (int bq = 0; bq < 2; ++bq)
#pragma unroll
                for (int g4 = 0; g4 < 4; ++g4) { const v2u w = *(const v2u*)(op + 32 * bq + 8 * g4 + 4 * h2);
                    o[bq][4 * g4] = bflo(w.x) * fa_ + o[bq][4 * g4] * fb; o[bq][4 * g4 + 1] = bfhi(w.x) * fa_ + o[bq][4 * g4 + 1] * fb;
                    o[bq][4 * g4 + 2] = bflo(w.y) * fa_ + o[bq][4 * g4 + 2] * fb; o[bq][4 * g4 + 3] = bfhi(w.y) * fa_ + o[bq][4 * g4 + 3] * fb; }
            asm volatile("" ::: "memory");
            fa::store_o<64>(op, h2, o, 1.0f);
            if (h2 == 0) LSE[row * 16 + hd] = mx + log2f(ea + eb);
        }
        TS_SECT_END(C, 9);
    }
}
DI void attn_dil_fast(Ctx& C, int gi, int dil) {
    if (score_bound(inp(C, I_DIL_QG), inp(C, I_DIL_KG), C.lane) <= NOMAX_BOUND) attn_dil_impl<true>(C, gi, dil); else attn_dil_impl<false>(C, gi, dil);
}
constexpr size_t WS_USELM_ = 25 * MiB;
constexpr int NSA_P4_OFF = 49152, NSA_SELL_OFF = 114688, NSA_JL_OFF = 115200;
template <bool NOMAX> DI void attn_nsa_impl(Ctx& C, bool nomax_rt) {
    if (C.wave >= 4) __builtin_amdgcn_s_setprio(1);
    const int vblk = (C.blk % 8) * (C.G / 8) + C.blk / 8;
    const bf16* QKV = (const bf16*)(C.ws + WS_R1); bf16* O = (bf16*)(C.ws + WS_UO); const float* GATE = (const float*)(C.ws + WS_GATE);
    const bf16* KC = (const bf16*)(C.ws + WS_KC); const bf16* VC = (const bf16*)(C.ws + WS_VC);
    const int lane = C.lane, wid = C.wave, r = lane & 31, h2 = lane >> 5;
    LAS float* P4 = (LAS float*)(C.lds + NSA_P4_OFF); LAS unsigned long long* SELL = (LAS unsigned long long*)(C.lds + NSA_SELL_OFF); LAS int* jl = (LAS int*)(C.lds + NSA_JL_OFF);
    const int nunits = BATCH * 4 * 64, per = (nunits + C.G - 1) / C.G;
    for (int ui = 0; ui < per; ++ui) {
        const int u = vblk * per + ui; if (u >= nunits) break;
        const int bg = u / 64, k64 = u % 64, sub = k64 >> 3, i8 = k64 & 7, c = (i8 & 1) ? (16 * (i8 >> 1) + 15 - sub) : (16 * (i8 >> 1) + sub);
        const int b = bg / 4, g = bg % 4, hp = wid >> 1, head = 4 * g + hp;
        const int qloc = 32 * (wid & 1) + r, t = 64 * c + qloc; const size_t row = (size_t)b * SEQ + t;
        bf16x8 qf[4];
#pragma unroll
        for (int d0 = 0; d0 < 4; ++d0) qf[d0] = *(const bf16x8*)(QKV + hm(head, b) + (size_t)t * 64 + d0 * 16 + h2 * 8);
        const float g0 = 1.0f / (1.0f + expf(-GATE[row * 48 + head])), g1s = 1.0f / (1.0f + expf(-GATE[row * 48 + 16 + head])), g2s = 1.0f / (1.0f + expf(-GATE[row * 48 + 32 + head]));
        TS_SECT_BEGIN(C, 10);
        f32x16 oa[2];
        { const unsigned ldsK = (unsigned)(size_t)C.lds, ldsV = ldsK + fa::KRING;
          fa::glds16(KC + (size_t)bg * 4096 + (size_t)(8 * wid + (lane >> 3)) * 64 + (((lane & 7) ^ ((lane >> 3) & 7)) * 8), (unsigned)__builtin_amdgcn_readfirstlane(ldsK + wid * 1024));
          fa::glds16(VC + (size_t)bg * 4096 + (16 * (wid & 3) + (lane >> 2)) * 64 + (wid >> 2) * 32 + (lane & 3) * 8, (unsigned)__builtin_amdgcn_readfirstlane(ldsV + wid * 1024));
          FA_WAIT_BAR(0);
          f32x16 p0, p1; fa::qk((LAS const char*)C.lds, qf, lane, p0, p1);
          const int nvalid = c + (qloc == 63 ? 1 : 0);
          float mx = -1e30f;
#pragma unroll
          for (int i = 0; i < 16; ++i) { const int kv = fa::crow(i, h2); if (kv >= nvalid) p0[i] = -INFINITY; if (kv + 32 >= nvalid) p1[i] = -INFINITY; mx = fmaxf(mx, fmaxf(p0[i], p1[i])); }
          mx = fa::xmax32(mx);
          float sum = 0.f;
#pragma unroll
          for (int i = 0; i < 16; ++i) { p0[i] = __builtin_amdgcn_exp2f(p0[i] - mx); p1[i] = __builtin_amdgcn_exp2f(p1[i] - mx); sum += p0[i] + p1[i]; }
          const float rden = 1.0f / fmaxf(fa::xsum32(sum), 1e-30f);
#pragma unroll
          for (int i = 0; i < 16; ++i) { p0[i] *= rden; p1[i] *= rden; }
          LAS float* pw = P4 + ((hp * 2 + (wid & 1)) * 64) * 32 + r;
#pragma unroll
          for (int i = 0; i < 16; ++i) { pw[fa::crow(i, h2) * 32] = p0[i]; pw[(fa::crow(i, h2) + 32) * 32] = p1[i]; }
#pragma unroll
          for (int i = 0; i < 16; ++i) { oa[0][i] = 0.f; oa[1][i] = 0.f; }
          fa::pv<64>((LAS const char*)C.lds + fa::KRING, lane, p0, p1, oa);
#pragma unroll
          for (int i = 0; i < 16; ++i) { oa[0][i] *= g0; oa[1][i] *= g0; }
          FA_WAIT_BAR(0); }
        { const int tt = C.tid >> 3, jseg = C.tid & 7; const LAS float* pb = P4 + ((tt >> 5) * 64) * 32 + (tt & 31);
          LAS unsigned* KEY = (LAS unsigned*)(C.lds + fa::KSLOT);
          unsigned own[8];
#pragma unroll
          for (int e = 0; e < 8; ++e) { const int jo = 8 * jseg + e; const float s = (pb[jo * 32] + pb[(128 + jo) * 32]) + (pb[(256 + jo) * 32] + pb[(384 + jo) * 32]);
              const float val = (jo == 0 || jo == c || jo == c - 1) ? 5.0f : s;
              own[e] = ((jo > c) ? 0u : (__builtin_bit_cast(unsigned, val) & ~63u)) | (unsigned)(63 - jo); }
          *(LAS v4u*)(KEY + tt * 64 + (((2 * jseg) ^ (tt & 15)) << 2)) = (v4u){own[0], own[1], own[2], own[3]};
          *(LAS v4u*)(KEY + tt * 64 + (((2 * jseg + 1) ^ (tt & 15)) << 2)) = (v4u){own[4], own[5], own[6], own[7]};
          asm volatile("s_waitcnt lgkmcnt(0)" ::: "memory"); __builtin_amdgcn_s_barrier();
          int rank[8];
#pragma unroll
          for (int e = 0; e < 8; ++e) rank[e] = 0;
#pragma unroll
          for (int k = 0; k < 16; ++k) { const v4u kv = *(const LAS v4u*)(KEY + tt * 64 + ((k ^ (tt & 15)) << 2));
#pragma unroll
              for (int e = 0; e < 8; ++e) rank[e] += (kv.x > own[e] ? 1 : 0) + (kv.y > own[e] ? 1 : 0) + (kv.z > own[e] ? 1 : 0) + (kv.w > own[e] ? 1 : 0); }
          unsigned bits = 0u;
#pragma unroll
          for (int e = 0; e < 8; ++e) bits |= (rank[e] < 16 && 8 * jseg + e <= c) ? (1u << e) : 0u;
          unsigned lo = (jseg < 4) ? (bits << (8 * jseg)) : 0u, hi = (jseg >= 4) ? (bits << (8 * (jseg - 4))) : 0u;
          lo |= __shfl_xor(lo, 1); hi |= __shfl_xor(hi, 1); lo |= __shfl_xor(lo, 2); hi |= __shfl_xor(hi, 2); lo |= __shfl_xor(lo, 4); hi |= __shfl_xor(hi, 4);
          if (jseg == 0) SELL[tt] = ((unsigned long long)hi << 32) | lo; }
        asm volatile("s_waitcnt lgkmcnt(0)" ::: "memory"); __builtin_amdgcn_s_barrier();
        const unsigned long long mymask = SELL[qloc];
        unsigned long long U;
        { const unsigned long long ml = SELL[lane]; unsigned ulo = (unsigned)ml, uhi = (unsigned)(ml >> 32);
#pragma unroll
          for (int of = 1; of < 64; of <<= 1) { ulo |= __shfl_xor(ulo, of); uhi |= __shfl_xor(uhi, of); }
          U = ((unsigned long long)__builtin_amdgcn_readfirstlane(uhi) << 32) | __builtin_amdgcn_readfirstlane(ulo); }
        const int nsel = __builtin_popcountll(U);
        if (wid == 0) { if ((U >> lane) & 1ull) jl[__builtin_popcountll(U & ((1ull << lane) - 1ull))] = lane; }
        unsigned wlo = (unsigned)mymask, whi = (unsigned)(mymask >> 32);
#pragma unroll
        for (int of = 1; of < 32; of <<= 1) { wlo |= __shfl_xor(wlo, of); whi |= __shfl_xor(whi, of); }
        const unsigned long long Uw = ((unsigned long long)__builtin_amdgcn_readfirstlane(whi) << 32) | __builtin_amdgcn_readfirstlane(wlo);
        asm volatile("s_waitcnt lgkmcnt(0)" ::: "memory"); __builtin_amdgcn_s_barrier();
        const int jlv = jl[lane];
        LAS float* stash = P4 + wid * 2048 + lane;
#pragma unroll
        for (int i = 0; i < 16; ++i) { stash[i * 64] = oa[0][i]; stash[(16 + i) * 64] = oa[1][i]; }
        const size_t koff = (size_t)(8 * wid + (lane >> 3)) * 64 + (((lane & 7) ^ ((lane >> 3) & 7)) * 8), voff = (size_t)(16 * (wid & 3) + (lane >> 2)) * 64 + (wid >> 2) * 32 + (lane & 3) * 8;
        TS_SECT_END(C, 10); TS_SECT_BEGIN(C, 11);
        { f32x16 o1[2]; float m1 = 0.f, l1 = 0.f;
#pragma unroll
          for (int i = 0; i < 16; ++i) { o1[0][i] = 0.f; o1[1][i] = 0.f; }
          const bf16* kbase = QKV + hm(24 + g, b) + koff; const bf16* vbase = QKV + hm(28 + g, b) + voff;
          fa3::loop<64, NOMAX>((LAS char*)C.lds, wid, lane, qf, nsel,
            [&](int i) { return kbase + (size_t)__builtin_amdgcn_readlane(jlv, i) * 4096; },
            [&](int i, int) { return vbase + (size_t)__builtin_amdgcn_readlane(jlv, i) * 4096; },
            [&](int i) { const int j = __builtin_amdgcn_readlane(jlv, i); return ((Uw >> j) & 1ull) != 0ull; },
            [&](int i, f32x16& p0, f32x16& p1) { const int j = __builtin_amdgcn_readlane(jlv, i);
                if (!((mymask >> j) & 1ull)) {
#pragma unroll
                    for (int ii = 0; ii < 16; ++ii) { p0[ii] = -INFINITY; p1[ii] = -INFINITY; } }
                if (j == c) { int ql = qloc; asm volatile("" : "+v"(ql));
#pragma unroll
                    for (int ii = 0; ii < 16; ++ii) { const int kv = fa::crow(ii, h2); if (kv > ql) p0[ii] = -INFINITY; if (kv + 32 > ql) p1[ii] = -INFINITY; } } },
            o1, m1, l1, 0.f, false, fa3::NoPf(), nomax_rt);
          const float sc = g1s / fa::xsum32(l1);
#pragma unroll
          for (int i = 0; i < 16; ++i) { stash[i * 64] += sc * o1[0][i]; stash[(16 + i) * 64] += sc * o1[1][i]; } }
        TS_SECT_END(C, 11); TS_SECT_BEGIN(C, 12);
        { f32x16 o2[2]; float m2 = 0.f, l2 = 0.f;
#pragma unroll
          for (int i = 0; i < 16; ++i) { o2[0][i] = 0.f; o2[1][i] = 0.f; }
          const bf16* kbase = QKV + hm(32 + g, b) + koff; const bf16* vbase = QKV + hm(36 + g, b) + voff;
          const int jlo = (c - 8) > 0 ? (c - 8) : 0, nt = c - jlo + 1;
          fa3::loop<64, NOMAX>((LAS char*)C.lds, wid, lane, qf, nt,
            [&](int i) { return kbase + (size_t)(jlo + i) * 4096; },
            [&](int i, int) { return vbase + (size_t)(jlo + i) * 4096; },
            [&](int) { return true; },
            [&](int i, f32x16& p0, f32x16& p1) { const int j = jlo + i;
                if (j == c) { int ql = qloc; asm volatile("" : "+v"(ql));
#pragma unroll
                    for (int ii = 0; ii < 16; ++ii) { const int kv = fa::crow(ii, h2); if (kv > ql) p0[ii] = -INFINITY; if (kv + 32 > ql) p1[ii] = -INFINITY; } }
                if (j == c - 8) { int ql = qloc; asm volatile("" : "+v"(ql));
#pragma unroll
                    for (int ii = 0; ii < 16; ++ii) { const int kv = fa::crow(ii, h2); if (kv <= ql) p0[ii] = -INFINITY; if (kv + 32 <= ql) p1[ii] = -INFINITY; } } },
            o2, m2, l2, 0.f, false, fa3::NoPf(), nomax_rt);
          const float sc = g2s / fa::xsum32(l2);
#pragma unroll
          for (int i = 0; i < 16; ++i) { o2[0][i] = stash[i * 64] + sc * o2[0][i]; o2[1][i] = stash[(16 + i) * 64] + sc * o2[1][i]; }
          fa::store_o<64>(O + row * DM + head * 64, h2, o2, 1.0f); }
        TS_SECT_END(C, 12);
    }
}
DI void attn_nsa_fused(Ctx& C) {
    const float bs = score_bound(inp(C, I_NSA_QG), inp(C, I_NSA_KG) + 64, C.lane), bw = score_bound(inp(C, I_NSA_QG), inp(C, I_NSA_KG) + 128, C.lane);
    attn_nsa_impl<false>(C, fmaxf(bs, bw) <= NOMAX_BOUND);
}
__global__ void __launch_bounds__(NTHR, 2) hybrid_fwd(Args args) {
    extern __shared__ __attribute__((aligned(16))) unsigned char lds_raw[];
    Ctx C;
    C.hbuf = args.out; C.ws = args.ws; C.lds = (LAS unsigned char*)lds_raw;
    C.tid = threadIdx.x; C.lane = C.tid & 63; C.wave = __builtin_amdgcn_readfirstlane(C.tid >> 6); C.G = gridDim.x; C.blk = blockIdx.x;
    volatile LAS unsigned* MISC = (volatile LAS unsigned*)(C.lds + MISC_OFF);
    if (C.tid < 32) MISC[C.tid] = 0u;
    if (C.tid == 0) {
#pragma unroll
        for (int i = 0; i < N_IN; ++i) ((LAS unsigned long long*)(C.lds + PTR_OFF))[i] = (unsigned long long)args.in[i];
    }
    __syncthreads();
    const int lo = args.ph_lo, hi = args.ph_hi;
    unsigned* barw = (unsigned*)(C.ws + WS_CTL) + CW_BAR;
    XcdBarrier bar; bar.bar = barw; bar.x = 0; bar.st = nullptr;
    if (hi - lo > 1) bar = xcd_barrier_post(barw, MISC + 8);
    int ph = 0;
#ifndef DBG_ONLY
#define DBG_ONLY -1
#endif
#ifndef DBG_REP
#define DBG_REP -1
#endif
#ifndef DBG_TS_Q
#define DBG_TS_Q 4ull
#endif
#ifndef DBG_TS_OFS
#define DBG_TS_OFS 0ull
#endif
#ifndef DBG_TS_BARSEL
#define DBG_TS_BARSEL(p) true
#endif
#ifndef DBG_TS_SEL
#define DBG_TS_SEL(p) false
#define DBG_TS_ON 0
#else
#define DBG_TS_ON 1
#endif
    volatile LAS unsigned long long* TSW = (volatile LAS unsigned long long*)(C.lds + MISC_OFF + 64);
#define PHASE(tag, ...) do { __builtin_amdgcn_s_setprio(0); if ((DBG_ONLY < 0 || DBG_ONLY == (tag)) && lo <= ph && ph < hi) { { int t_ = threadIdx.x; asm volatile("" : "+v"(t_)); C.tid = t_; C.lane = t_ & 63; } \
    if (DBG_TS_ON && DBG_TS_SEL(ph) && C.tid == 0) TSW[1] = __builtin_amdgcn_s_memrealtime(); \
    for (int rep_ = 0; rep_ < ((tag) == DBG_REP ? 2 : 1); ++rep_) { __VA_ARGS__; } if (ph + 1 < hi) { if (DBG_TS_BARSEL(ph)) TS_SECT_BEGIN(C, 20); xcd_barrier(bar); if (DBG_TS_BARSEL(ph)) TS_SECT_END(C, 20); } \
    if (DBG_TS_ON && DBG_TS_SEL(ph) && C.tid == 0) TSW[0] = TSW[0] + (__builtin_amdgcn_s_memrealtime() - TSW[1]); } ++ph; } while (0)
    bf16* const UO = (bf16*)(C.ws + WS_UO); bf16* const O2 = (bf16*)(C.ws + WS_O2); bf16* const R1 = (bf16*)(C.ws + WS_R1); bf16* const YB = (bf16*)(C.ws + WS_Y);
    const float* const WQ_ = nullptr; (void)WQ_;

    PHASE(0, { phase_p0a(C); phase_p0c(C); });
    PHASE(0, phase_p0b(C));
    PHASE(1, phase_n1<0>(C));
    PHASE(2, gemm_qkv_prep(C, UO, (const bf16*)(C.ws + WS_FOXWIN), FOX_NPAD, R1, 3072, 3072, (float*)(C.ws + WS_FLOG), 16, 4, 8, 0, 0, inp(C, I_FOX_QG), inp(C, I_FOX_KG), nullptr, false, 1, 1));
    PHASE(4, attn_fox_fast(C));
    PHASE(2, gemm_qkv(C, UO, (const bf16*)(C.ws + WS_WOUT), DM, YB, DM, DM, nullptr, 0));
    PHASE(5, phase_n2<0>(C, YB));
    PHASE(6, phase_s(C));
    PHASE(7, gemm_moe1(C, 0));
    PHASE(8, gemm_moe2(C, 0));
    PHASE(1, phase_n1<1>(C));
    PHASE(2, gemm_qkv_prep(C, UO, (const bf16*)(C.ws + WS_NSAWIN), NSA_NPAD, R1, NSA_LDQ, NSA_LDQ, (float*)(C.ws + WS_GATE), 48, 6, 7, 8, 9, inp(C, I_NSA_QG), inp(C, I_NSA_KG) + 64, inp(C, I_NSA_KG) + 128, true));
    PHASE(3, nsa_compress(C));
    PHASE(10, attn_nsa_fused(C));
    PHASE(2, gemm_qkv(C, UO, (const bf16*)(C.ws + WS_WOUT + 2 * MiB), DM, YB, DM, DM, nullptr, 0));
    PHASE(5, phase_n2<1>(C, YB));
    PHASE(6, phase_s(C));
    PHASE(7, gemm_moe1(C, 1));
    PHASE(8, gemm_moe2(C, 1));
    PHASE(1, phase_n1<2>(C));
#pragma unroll
    for (int gi = 0; gi < 3; ++gi) {
        const int dil = (gi == 0) ? 1 : (gi == 1) ? 4 : 16;
        PHASE(2, gemm_qkv_prep(C, UO, (const bf16*)(C.ws + WS_DILWIN) + (size_t)gi * 3072 * DM, 3072, R1, 3072, 3072, nullptr, 0, 4, 8, 0, 0, inp(C, I_DIL_QG), inp(C, I_DIL_KG), nullptr, true, dil));
        PHASE(11, attn_dil_fast(C, gi, dil));
    }
    PHASE(2, gemm_qkv(C, O2, (const bf16*)(C.ws + WS_WOUT + 4 * MiB), DM, YB, DM, DM, nullptr, 0));
    PHASE(5, phase_n2<2>(C, YB));
    PHASE(6, phase_s(C));
    PHASE(7, gemm_moe1(C, 2));
    PHASE(8, gemm_moe2(C, 2));
    PHASE(1, phase_n1<3>(C));
    PHASE(2, gemm_qkv_prep(C, UO, (const bf16*)(C.ws + WS_DIFFWIN), 3072, R1, 3072, 3072, nullptr, 0, 4, 8, 0, 0, inp(C, I_DIFF_QG), inp(C, I_DIFF_KG), nullptr, true));
    PHASE(12, attn_diff_fast(C));
    PHASE(2, gemm_qkv(C, UO, (const bf16*)(C.ws + WS_WOUT + 6 * MiB), DM, YB, DM, DM, nullptr, 0));
    PHASE(5, phase_n2<3>(C, YB));
    PHASE(6, phase_s(C));
    PHASE(7, gemm_moe1(C, 3));
    PHASE(8, gemm_moe2(C, 3));
    PHASE(1, phase_final(C));
    if ((DBG_TS_ON || DBG_TS_SECT != 0) && C.blk == 0 && C.tid == 0) { asm volatile("s_waitcnt vmcnt(0)" ::: "memory"); C.hbuf[0] = (float)(((TSW[0] / 100ull + DBG_TS_OFS) / DBG_TS_Q) * DBG_TS_Q) * 0.25f; }
#undef PHASE
}
constexpr int N_PHASES = 2 + 8 + 9 + 12 + 8 + 1;

#ifndef MK_PER_PHASE
#define MK_PER_PHASE 0
#endif
extern "C" void kernel_launch(void* const* d_in, const int* in_sizes, int n_in, void* d_out, int out_size, void* d_ws, size_t ws_size, hipStream_t stream) {
    static int grid = 0;
    if (grid == 0) {
        if (n_in != N_IN || out_size != T * DM || ws_size < WS_END) { fprintf(stderr, "kernel_launch: unexpected shapes (n_in %d out %d ws %zu)\n", n_in, out_size, ws_size); grid = -1; return; }
        int dev = 0, cus = 0, per_cu = 0;
        if (hipGetDevice(&dev) != hipSuccess || hipDeviceGetAttribute(&cus, hipDeviceAttributeMultiprocessorCount, dev) != hipSuccess) { grid = -1; return; }
        if (hipFuncSetAttribute((const void*)hybrid_fwd, hipFuncAttributeMaxDynamicSharedMemorySize, LDS_BYTES) != hipSuccess) { fprintf(stderr, "kernel_launch: hipFuncSetAttribute failed\n"); grid = -1; return; }
        if (hipOccupancyMaxActiveBlocksPerMultiprocessor(&per_cu, (const void*)hybrid_fwd, NTHR, LDS_BYTES) != hipSuccess || per_cu < 1) fprintf(stderr, "kernel_launch: occupancy query reports %d\n", per_cu);
        (void)hipGetLastError();
        grid = (cus >= 256) ? 256 : (cus >= 128) ? 128 : 64;
    }
    if (grid < 0) return;
    (void)hipMemsetAsync((char*)d_ws + WS_CTL, 0, CTL_ZERO_BYTES, stream);
    Args a{};
    for (int i = 0; i < N_IN; ++i) a.in[i] = (const float*)d_in[i];
    a.out = (float*)d_out; a.ws = (unsigned char*)d_ws;
#if MK_PER_PHASE
    for (int p = 0; p < N_PHASES; ++p) { a.ph_lo = p; a.ph_hi = p + 1; hipLaunchKernelGGL(hybrid_fwd, dim3(grid), dim3(NTHR), LDS_BYTES, stream, a); }
#else
    a.ph_lo = 0; a.ph_hi = N_PHASES;
    hipLaunchKernelGGL(hybrid_fwd, dim3(grid), dim3(NTHR), LDS_BYTES, stream, a);
#endif
    const hipError_t le = hipPeekAtLastError();
    if (le != hipSuccess) fprintf(stderr, "kernel_launch: launch failed: %s\n", hipGetErrorName(le));
}
```

```cpp
#include <hip/hip_runtime.h>
#include <cstdio>
#include <cstdint>
#ifndef DBG_TS_SECT
#define DBG_TS_SECT 0
#endif
#ifndef DBG_TS_CLK
#define DBG_TS_CLK() __builtin_amdgcn_s_memrealtime()
#endif
#define PG8_TS_BEGIN(k) do { if (DBG_TS_SECT == (k) && tid == 0 && ((volatile __attribute__((address_space(3))) unsigned*)(lds + 131072 + 320))[24]) ((volatile __attribute__((address_space(3))) unsigned long long*)(lds + 131072 + 320 + 64))[1] = DBG_TS_CLK(); } while (0)
#define PG8_TS_END(k) do { if (DBG_TS_SECT == (k) && tid == 0 && ((volatile __attribute__((address_space(3))) unsigned*)(lds + 131072 + 320))[24]) { volatile __attribute__((address_space(3))) unsigned long long* t_ = (volatile __attribute__((address_space(3))) unsigned long long*)(lds + 131072 + 320 + 64); t_[0] = t_[0] + (DBG_TS_CLK() - t_[1]); } } while (0)
namespace pg8 {
#define PG8_LAS __attribute__((address_space(3)))
typedef unsigned short bf16_t;
typedef short bf16x8 __attribute__((ext_vector_type(8)));
typedef float f32x4 __attribute__((ext_vector_type(4)));
typedef unsigned u32x4 __attribute__((ext_vector_type(4)));
constexpr int BM = 256, BK = 64, HALF = 128, HTB = HALF * BK * 2  , STAGE_BYTES = 8 * HTB, NXCD = 8, WGM = 8;

__host__ __device__ __forceinline__ int lds_byte(int r, int c) { const int st = (r >> 4) * 2 + (c >> 5), rr = r & 15, cc = c & 31, ob = rr * 64 + cc * 2; return st * 1024 + (ob ^ (((ob >> 9) & 1) << 5)); }
__host__ __device__ __forceinline__ void stage_rc(int b, int& R, int& C) { const int st = b / 1024, sb = b % 1024, swz = sb ^ (((sb >> 9) & 1) << 5); R = (st >> 1) * 16 + swz / 64; C = (st & 1) * 32 + (swz % 64) / 2; }
__host__ __device__ __forceinline__ int perm32(int rho) { const int n = rho >> 4, i = rho & 15; return 8 * (i >> 2) + 4 * n + (i & 3); }

struct Unit { int pm, pn; };
struct Gemm { const bf16_t* A; const bf16_t* Bt; int M, N, K; const int* arow = nullptr; int arow_lim = 0; };

struct StaticOrder {
    int nM, nN, nwg, G, c;
    __host__ __device__ void init(int M, int N, int G_, int c_) { nM = M / BM; nN = N / BM; nwg = nM * nN; G = G_; c = c_; }
    __host__ __device__ bool next(int i, Unit& u) const {
        const long L = (long)i * G + c; if (L >= nwg) return false;
        int wgid = (int)L; { const int q = nwg / NXCD, r = nwg % NXCD, xcd = wgid % NXCD, off = wgid / NXCD; wgid = (xcd < r ? xcd * (q + 1) : r * (q + 1) + (xcd - r) * q) + off; }
        const int nig = WGM * nN, gid = wgid / nig, fm = gid * WGM, gsz = (nM - fm) < WGM ? (nM - fm) : WGM;
        u.pm = fm + ((wgid % nig) % gsz); u.pn = (wgid % nig) / gsz; return true;
    }
    __device__ __forceinline__ void a_ready(const Unit&) const {}
    __device__ __forceinline__ void done(const Unit&) const {}
};
__device__ __forceinline__ unsigned cvt_pk_bf16(float lo, float hi) { unsigned r; asm volatile("v_cvt_pk_bf16_f32 %0, %1, %2" : "=v"(r) : "v"(lo), "v"(hi)); return r; }
typedef float f32x2 __attribute__((ext_vector_type(2)));
struct EpiStore {
    static constexpr bool PERM = true, AFTER_DRAIN = false;
    bf16_t* O; int ldc; int ntn; int n_main; float* tail; int tail_n;
    __device__ __forceinline__ void operator()(const f32x4 (&acc)[2][2][4][2], const Unit& u, int wr, int wc, int fr, int fq) const {
        const int row0 = u.pm * BM + wr * 64 + fr; const int ct = u.pn % ntn;
#pragma unroll
        for (int bj = 0; bj < 2; ++bj) {
            const int col = ct * BM + bj * HALF + wc * 32 + 8 * fq;
            if (col < n_main) {
#pragma unroll
                for (int ai = 0; ai < 2; ++ai)
#pragma unroll
                    for (int m = 0; m < 4; ++m) { const f32x4 v0 = acc[ai][bj][m][0], v1 = acc[ai][bj][m][1];
                        u32x4 w; w.x = cvt_pk_bf16(v0[0], v0[1]); w.y = cvt_pk_bf16(v0[2], v0[3]); w.z = cvt_pk_bf16(v1[0], v1[1]); w.w = cvt_pk_bf16(v1[2], v1[3]);
                        *(u32x4*)(O + (size_t)(row0 + ai * HALF + m * 16) * ldc + col) = w; }
            } else if (col - n_main < tail_n) {
#pragma unroll
                for (int ai = 0; ai < 2; ++ai)
#pragma unroll
                    for (int m = 0; m < 4; ++m) { float* p = tail + (size_t)(row0 + ai * HALF + m * 16) * tail_n + (col - n_main);
                        *(f32x4*)p = acc[ai][bj][m][0]; *(f32x4*)(p + 4) = acc[ai][bj][m][1]; }
            }
        }
    }
};
__device__ __forceinline__ float xsum_fq(float v) {
    float a = v, b = v; asm volatile("s_nop 1\n\tv_permlane16_swap_b32 %0, %1\n\ts_nop 1" : "+v"(a), "+v"(b)); float s = a + b;
    float c = s, d = s; asm volatile("s_nop 1\n\tv_permlane32_swap_b32 %0, %1\n\ts_nop 1" : "+v"(c), "+v"(d)); return c + d;
}
struct EpiQKVPrep {
    static constexpr bool PERM = true, AFTER_DRAIN = false;
    bf16_t* O; int ldc; int n_main; float* tail; int tail_n;
    int k_lo, k_hi, k2_lo, k2_hi;
    const PG8_LAS float* gl;
    const float* rope; const float* ropeD;
    float qs; float eps; int lgseq; int nbatch; int lgdil; int tail_hm;
    __device__ __forceinline__ size_t cbase(int b, int col) const { return (((size_t)(col >> 6) * nbatch + b) << lgseq) * 64 + (col & 63); }
    __device__ __forceinline__ int tpos(int t) const { return ((t & ((1 << lgdil) - 1)) << (lgseq - lgdil)) + (t >> lgdil); }
    __device__ __forceinline__ void operator()(const f32x4 (&acc)[2][2][4][2], const Unit& u, int wr, int wc, int fr, int fq) const {
        const int row0 = u.pm * BM + wr * 64 + fr; const int ct = u.pn;
        const int b = row0 >> lgseq, t0 = row0 & ((1 << lgseq) - 1);
        const int gsel = (ct < 4) ? 0 : (ct >= k_lo && ct < k_hi) ? 1 : (ct >= k2_lo && ct < k2_hi) ? 2 : -1;
        if (gsel >= 0) {
            const float sc = (ct < 4) ? qs : 1.0f;
            const PG8_LAS float* gain = gl + 64 * gsel;
            bf16_t* ob = O + cbase(b, ct * BM + 64 * wc + 8 * fq);
            f32x4 rl0 = {}, rl1 = {}, rl2 = {}, rl3 = {};
            if (rope) { const f32x4* rp0 = (const f32x4*)(rope + ((size_t)t0 * 32 + 8 * fq) * 2); rl0 = rp0[0]; rl1 = rp0[1]; rl2 = rp0[2]; rl3 = rp0[3]; }
#pragma unroll
            for (int k = 0; k < 8; ++k) { const int ai = k >> 2, m = k & 3, t = t0 + ai * HALF + m * 16;
                    f32x4 d0 = {}, d1 = {}, d2 = {}, d3 = {};
                    if (rope) { const f32x4* dp = (const f32x4*)(ropeD + ((size_t)k * 32 + 8 * fq) * 2); d0 = dp[0]; d1 = dp[1]; d2 = dp[2]; d3 = dp[3]; }
                    const f32x4 ga = *(const PG8_LAS f32x4*)(gain + 8 * fq), gb = *(const PG8_LAS f32x4*)(gain + 8 * fq + 4), gc = *(const PG8_LAS f32x4*)(gain + 32 + 8 * fq), gd = *(const PG8_LAS f32x4*)(gain + 36 + 8 * fq);
                    f32x4 a = acc[ai][0][m][0], bq = acc[ai][0][m][1], c = acc[ai][1][m][0], d = acc[ai][1][m][1];
                    float ss = ((a[0] * a[0] + a[1] * a[1]) + (a[2] * a[2] + a[3] * a[3])) + ((bq[0] * bq[0] + bq[1] * bq[1]) + (bq[2] * bq[2] + bq[3] * bq[3]))
                             + ((c[0] * c[0] + c[1] * c[1]) + (c[2] * c[2] + c[3] * c[3])) + ((d[0] * d[0] + d[1] * d[1]) + (d[2] * d[2] + d[3] * d[3]));
                    ss = xsum_fq(ss);
                    const float r = sc * __builtin_amdgcn_rsqf(ss * (1.0f / 64.0f) + eps);
                    a = a * ga * r; bq = bq * gb * r; c = c * gc * r; d = d * gd * r;
                    if (rope) {
                        const f32x4 cl0 = {rl0[0], rl0[2], rl1[0], rl1[2]}, sl0 = {rl0[1], rl0[3], rl1[1], rl1[3]}, cl1 = {rl2[0], rl2[2], rl3[0], rl3[2]}, sl1 = {rl2[1], rl2[3], rl3[1], rl3[3]};
                        const f32x4 cd0 = {d0[0], d0[2], d1[0], d1[2]}, sd0 = {d0[1], d0[3], d1[1], d1[3]}, cd1 = {d2[0], d2[2], d3[0], d3[2]}, sd1 = {d2[1], d2[3], d3[1], d3[3]};
                        const f32x4 cs0 = cl0 * cd0 - sl0 * sd0, sn0 = sl0 * cd0 + cl0 * sd0, cs1 = cl1 * cd1 - sl1 * sd1, sn1 = sl1 * cd1 + cl1 * sd1;
                        const f32x4 na = a * cs0 - c * sn0, nc = a * sn0 + c * cs0, nb = bq * cs1 - d * sn1, nd = bq * sn1 + d * cs1; a = na; bq = nb; c = nc; d = nd; }
                    u32x4 w0, w1; w0.x = cvt_pk_bf16(a[0], a[1]); w0.y = cvt_pk_bf16(a[2], a[3]); w0.z = cvt_pk_bf16(bq[0], bq[1]); w0.w = cvt_pk_bf16(bq[2], bq[3]);
                    w1.x = cvt_pk_bf16(c[0], c[1]); w1.y = cvt_pk_bf16(c[2], c[3]); w1.z = cvt_pk_bf16(d[0], d[1]); w1.w = cvt_pk_bf16(d[2], d[3]);
                    bf16_t* op = ob + (size_t)tpos(t) * 64; *(u32x4*)op = w0; *(u32x4*)(op + 32) = w1; }
            return;
        }
#pragma unroll
        for (int bj = 0; bj < 2; ++bj) {
            const int col = ct * BM + bj * HALF + wc * 32 + 8 * fq;
            if (col < n_main) {
                bf16_t* ob = O + cbase(b, col);
#pragma unroll
                for (int ai = 0; ai < 2; ++ai)
#pragma unroll
                    for (int m = 0; m < 4; ++m) { const f32x4 v0 = acc[ai][bj][m][0], v1 = acc[ai][bj][m][1];
                        u32x4 w; w.x = cvt_pk_bf16(v0[0], v0[1]); w.y = cvt_pk_bf16(v0[2], v0[3]); w.z = cvt_pk_bf16(v1[0], v1[1]); w.w = cvt_pk_bf16(v1[2], v1[3]);
                        *(u32x4*)(ob + (size_t)tpos(t0 + ai * HALF + m * 16) * 64) = w; }
            } else if (col - n_main < tail_n) {
#pragma unroll
                for (int ai = 0; ai < 2; ++ai)
#pragma unroll
                    for (int m = 0; m < 4; ++m) { const int t = t0 + ai * HALF + m * 16;
                        if (tail_hm) { float* p = tail + ((((size_t)b * tail_n + (col - n_main)) << lgseq) + t);
#pragma unroll
                            for (int i = 0; i < 4; ++i) { p[(size_t)i << lgseq] = acc[ai][bj][m][0][i]; p[(size_t)(4 + i) << lgseq] = acc[ai][bj][m][1][i]; } }
                        else { float* p = tail + (((size_t)b << lgseq) + t) * tail_n + (col - n_main); *(f32x4*)p = acc[ai][bj][m][0]; *(f32x4*)(p + 4) = acc[ai][bj][m][1]; } }
            }
        }
    }
};
struct EpiSwiGLU {
    static constexpr bool PERM = true, AFTER_DRAIN = false;
    bf16_t* H; int ntn;
    __device__ __forceinline__ void operator()(const f32x4 (&acc)[2][2][4][2], const Unit& u, int wr, int wc, int fr, int fq) const {
        const int row0 = u.pm * BM + wr * 64 + fr; const int ct = u.pn % ntn;
        typedef unsigned u32x2v __attribute__((ext_vector_type(2)));
#pragma unroll
        for (int bj = 0; bj < 2; ++bj) {
            const int hc = ct * 128 + bj * 64 + wc * 16 + 4 * fq;
#pragma unroll
            for (int ai = 0; ai < 2; ++ai)
#pragma unroll
                for (int m = 0; m < 4; ++m) { const f32x4 g = acc[ai][bj][m][0], up = acc[ai][bj][m][1]; float r[4];
#pragma unroll
                    for (int i = 0; i < 4; ++i) { const float e = __builtin_amdgcn_exp2f(-g[i] * 1.4426950408889634f); r[i] = g[i] * __builtin_amdgcn_rcpf(1.0f + e) * up[i]; }
                    u32x2v w; w.x = cvt_pk_bf16(r[0], r[1]); w.y = cvt_pk_bf16(r[2], r[3]);
                    *(u32x2v*)(H + (size_t)(row0 + ai * HALF + m * 16) * 512 + hc) = w; }
        }
    }
};
struct MoeOrder {
    const int* tile_e; int ntiles, NT, G, c;
    __device__ __forceinline__ bool next(int i, Unit& u) const {
        const int L = i * G + c; if (L >= ntiles * NT) return false;
        const int pm = L / NT, j = L % NT; u.pm = pm; u.pn = tile_e[pm] * NT + j; return true;
    }
    __device__ __forceinline__ void a_ready(const Unit&) const {}
    __device__ __forceinline__ void done(const Unit&) const {}
};
template <class Epi, class Sched, bool ALIGN_EPI = false, bool SP2 = false, bool GATHER = false>
__device__ __forceinline__ void gemm_phase(PG8_LAS unsigned char* lds, const Gemm g, const Sched& S, const Epi& E) {
    int tid_ = threadIdx.x; asm volatile("" : "+v"(tid_));
    const int tid = tid_, wid = __builtin_amdgcn_readfirstlane(tid >> 6), lane = tid & 63, wr = wid >> 2, wc = wid & 3, fr = lane & 15, fq = lane >> 4;
    const int K = g.K, nt = K / BK;
    unsigned voffA[2], voffB[2]; int stR[2], stC[2];
#pragma unroll
    for (int i = 0; i < 2; ++i) { int R, C; stage_rc(tid * 16 + i * 8192, R, C); const int Rb = Epi::PERM ? ((R & ~31) + perm32(R & 31)) : R;
        voffA[i] = (unsigned)(R * K + C) * 2u; voffB[i] = (unsigned)(Rb * K + C) * 2u; stR[i] = R; stC[i] = C; }
    const size_t kstep = (size_t)(BK * 2);
    const size_t hstep = (size_t)HALF * K * 2;
    const size_t tstep = 2 * hstep;
    const unsigned ldsw = (unsigned)wid * 1024u;
    const int aoff = lds_byte(wr * 64 + fr, fq * 8), boff = lds_byte(wc * 32 + fr, fq * 8);
    unsigned vgC[2][2] = {{0u, 0u}, {0u, 0u}}, vgN[2][2] = {{0u, 0u}, {0u, 0u}};
#define PG8_GLOAD(dst, PM) do { _Pragma("unroll") for (int h_ = 0; h_ < 2; ++h_) _Pragma("unroll") for (int i_ = 0; i_ < 2; ++i_) { \
        int rw_ = g.arow[(PM) * BM + h_ * HALF + stR[i_]]; rw_ = ((unsigned)rw_ < (unsigned)g.arow_lim) ? rw_ : 0; dst[h_][i_] = (unsigned)(rw_ * K + stC[i_]) * 2u; } } while (0)
#define PG8_STAGE_A(bufoff, base, half, VG) do { if constexpr (GATHER) { PG8_STAGE(bufoff, base, VG[half]); } else { PG8_STAGE(bufoff, (base) + (half) * hstep, voffA); } } while (0)
#define PG8_SA(b, h) (((b) * 2 + (h)) * HTB)
#define PG8_SB(b, h) ((4 + (b) * 2 + (h)) * HTB)
#define PG8_STAGE(bufoff, gbase, voff) do { _Pragma("unroll") for (int _i = 0; _i < 2; ++_i) \
        __builtin_amdgcn_global_load_lds((const unsigned*)((const char*)(gbase) + (voff)[_i]), (PG8_LAS unsigned*)(lds + (bufoff) + ldsw + _i * 8192), 16, 0, 0); } while (0)
#define PG8_LDA(dst, b, h) do { _Pragma("unroll") for (int m = 0; m < 4; ++m) _Pragma("unroll") for (int k = 0; k < 2; ++k) dst[m][k] = *(const PG8_LAS bf16x8*)(lds + PG8_SA(b, h) + aoff + m * 2048 + k * 1024); } while (0)
#define PG8_LDB(dst, b, h) do { _Pragma("unroll") for (int n = 0; n < 2; ++n) _Pragma("unroll") for (int k = 0; k < 2; ++k) dst[n][k] = *(const PG8_LAS bf16x8*)(lds + PG8_SB(b, h) + boff + n * 2048 + k * 1024); } while (0)
#define PG8_MMA(ai, bj, At, Bt) do { __builtin_amdgcn_s_setprio(1); _Pragma("unroll") for (int m = 0; m < 4; ++m) _Pragma("unroll") for (int n = 0; n < 2; ++n) _Pragma("unroll") for (int k = 0; k < 2; ++k) \
        acc[ai][bj][m][n] = __builtin_amdgcn_mfma_f32_16x16x32_bf16(Bt[n][k], At[m][k], acc[ai][bj][m][n], 0, 0, 0); __builtin_amdgcn_s_setprio(0); } while (0)
#define PG8_WAIT_V(n) asm volatile("s_waitcnt vmcnt(" #n ")" ::: "memory")
#define PG8_WAIT_L(n) asm volatile("s_waitcnt lgkmcnt(" #n ")" ::: "memory")
#define PG8_BAR __builtin_amdgcn_s_barrier()
#define PG8_SCHED __builtin_amdgcn_sched_barrier(0)
    Unit cur, nxt; int ui = 0;
    if (!S.next(0, cur)) return;
    f32x4 acc[2][2][4][2];
#pragma unroll
    for (int a = 0; a < 2; ++a)
#pragma unroll
        for (int b = 0; b < 2; ++b)
#pragma unroll
            for (int m = 0; m < 4; ++m)
#pragma unroll
                for (int n = 0; n < 2; ++n) acc[a][b][m][n] = (f32x4){0.f, 0.f, 0.f, 0.f};
    bf16x8 At[4][2], B0[2][2], B1[2][2];
    const char* cA = GATHER ? (const char*)g.A : (const char*)g.A + (size_t)cur.pm * tstep; const char* cB = (const char*)g.Bt + (size_t)cur.pn * tstep;
    if constexpr (GATHER) PG8_GLOAD(vgC, cur.pm);
    S.a_ready(cur);
    if constexpr (SP2) {
        PG8_STAGE(PG8_SB(0, 0), cB, voffB); PG8_STAGE(PG8_SB(0, 1), cB + hstep, voffB); PG8_STAGE_A(PG8_SA(0, 0), cA, 0, vgC); PG8_STAGE_A(PG8_SA(0, 1), cA, 1, vgC);
        if (wr == 1) PG8_BAR;
        PG8_WAIT_V(2); PG8_BAR;
        PG8_STAGE(PG8_SB(1, 0), cB + kstep, voffB); PG8_STAGE_A(PG8_SA(1, 0), cA + kstep, 0, vgC); PG8_STAGE(PG8_SB(1, 1), cB + hstep + kstep, voffB);
        PG8_WAIT_V(6); PG8_BAR;
    } else {
        PG8_STAGE(PG8_SB(0, 0), cB, voffB); PG8_STAGE(PG8_SA(0, 0), cA, voffA); PG8_STAGE(PG8_SB(0, 1), cB + hstep, voffB); PG8_STAGE(PG8_SA(0, 1), cA + hstep, voffA);
        if (wr == 1) PG8_BAR;
        PG8_WAIT_V(4); PG8_BAR;
        PG8_STAGE(PG8_SB(1, 0), cB + kstep, voffB); PG8_STAGE(PG8_SA(1, 0), cA + kstep, voffA); PG8_STAGE(PG8_SB(1, 1), cB + hstep + kstep, voffB);
        PG8_WAIT_V(6); PG8_BAR;
    }
    for (;;) {
        const bool has_next = S.next(ui + 1, nxt);
        const char* nA = GATHER ? (const char*)g.A : (has_next ? (const char*)g.A + (size_t)nxt.pm * tstep : cA); const char* nB = has_next ? (const char*)g.Bt + (size_t)nxt.pn * tstep : cB;
        if constexpr (GATHER) { _Pragma("unroll") for (int h_ = 0; h_ < 2; ++h_) _Pragma("unroll") for (int i_ = 0; i_ < 2; ++i_) vgN[h_][i_] = vgC[h_][i_]; }
        PG8_TS_BEGIN(30);
        for (int t = 0; t < nt; t += 2) {
            const bool last = (t == nt - 2);
            const char* a1 = cA + (size_t)(t + 1) * kstep;
            const char* a2 = last ? nA : cA + (size_t)(t + 2) * kstep; const char* b2 = last ? nB : cB + (size_t)(t + 2) * kstep;
            const char* a3 = a2 + kstep; const char* b3 = b2 + kstep;
            if (last && has_next) S.a_ready(nxt);
            unsigned vg2[2][2];
            if constexpr (GATHER) { _Pragma("unroll") for (int h_ = 0; h_ < 2; ++h_) _Pragma("unroll") for (int i_ = 0; i_ < 2; ++i_) vg2[h_][i_] = last ? vgN[h_][i_] : vgC[h_][i_];
                if (t == nt - 4 && has_next) PG8_GLOAD(vgN, nxt.pm); }
            if constexpr (SP2) {
            PG8_LDB(B0, 0, 0); PG8_LDB(B1, 0, 1); PG8_SCHED; PG8_LDA(At, 0, 0); PG8_STAGE_A(PG8_SA(1, 1), a1, 1, vgC);
            PG8_WAIT_V(8); PG8_WAIT_L(0); PG8_BAR; PG8_MMA(0, 0, At, B0); PG8_MMA(0, 1, At, B1); PG8_BAR; PG8_SCHED;
            PG8_LDA(At, 0, 1); PG8_STAGE(PG8_SB(0, 0), b2, voffB); PG8_STAGE(PG8_SB(0, 1), b2 + hstep, voffB); PG8_STAGE_A(PG8_SA(0, 0), a2, 0, vg2);
            PG8_WAIT_V(8); PG8_WAIT_L(0); PG8_BAR; PG8_MMA(1, 0, At, B0); PG8_MMA(1, 1, At, B1); PG8_BAR; PG8_SCHED;
            PG8_LDB(B0, 1, 0); PG8_LDB(B1, 1, 1); PG8_SCHED; PG8_LDA(At, 1, 0); PG8_STAGE_A(PG8_SA(0, 1), a2, 1, vg2);
            PG8_WAIT_V(8); PG8_WAIT_L(0); PG8_BAR; PG8_MMA(0, 0, At, B0); PG8_MMA(0, 1, At, B1); PG8_BAR; PG8_SCHED;
            PG8_LDA(At, 1, 1); PG8_STAGE(PG8_SB(1, 0), b3, voffB); PG8_STAGE(PG8_SB(1, 1), b3 + hstep, voffB); PG8_STAGE_A(PG8_SA(1, 0), a3, 0, vg2);
            PG8_WAIT_V(8); PG8_WAIT_L(0); PG8_BAR; PG8_MMA(1, 0, At, B0); PG8_MMA(1, 1, At, B1); PG8_BAR; PG8_SCHED;
            } else {
            PG8_LDB(B0, 0, 0); PG8_SCHED; PG8_LDA(At, 0, 0); PG8_STAGE(PG8_SA(1, 1), a1 + hstep, voffA);
            PG8_WAIT_L(8); PG8_BAR; PG8_WAIT_L(0); PG8_MMA(0, 0, At, B0); PG8_BAR; PG8_SCHED;
            PG8_LDB(B1, 0, 1); PG8_STAGE(PG8_SB(0, 0), b2, voffB);
            PG8_BAR; PG8_WAIT_L(0); PG8_MMA(0, 1, At, B1); PG8_BAR;
            PG8_LDA(At, 0, 1); PG8_STAGE(PG8_SA(0, 0), a2, voffA);
            PG8_BAR; PG8_WAIT_L(0); PG8_MMA(1, 0, At, B0); PG8_BAR; PG8_SCHED;
            PG8_STAGE(PG8_SB(0, 1), b2 + hstep, voffB);
            PG8_WAIT_V(6); PG8_BAR; PG8_MMA(1, 1, At, B1); PG8_BAR;
            PG8_LDB(B0, 1, 0); PG8_SCHED; PG8_LDA(At, 1, 0); PG8_STAGE(PG8_SA(0, 1), a2 + hstep, voffA);
            PG8_WAIT_L(8); PG8_BAR; PG8_WAIT_L(0); PG8_MMA(0, 0, At, B0); PG8_BAR; PG8_SCHED;
            PG8_LDB(B1, 1, 1); PG8_STAGE(PG8_SB(1, 0), b3, voffB);
            PG8_BAR; PG8_WAIT_L(0); PG8_MMA(0, 1, At, B1); PG8_BAR;
            PG8_LDA(At, 1, 1); PG8_STAGE(PG8_SA(1, 0), a3, voffA);
            PG8_BAR; PG8_WAIT_L(0); PG8_MMA(1, 0, At, B0); PG8_BAR; PG8_SCHED;
            PG8_STAGE(PG8_SB(1, 1), b3 + hstep, voffB);
            PG8_WAIT_V(6); PG8_BAR; PG8_MMA(1, 1, At, B1); PG8_BAR;
            }
        }
        PG8_TS_END(30); PG8_TS_BEGIN(31);
        if constexpr (ALIGN_EPI) { if (wr == 0) PG8_BAR; }
        if constexpr (!Epi::AFTER_DRAIN) { E(acc, cur, wr, wc, fr, fq); S.done(cur); }   PG8_TS_END(31);
        if (!has_next) break;
#pragma unroll
        for (int a = 0; a < 2; ++a)
#pragma unroll
            for (int b = 0; b < 2; ++b)
#pragma unroll
                for (int m = 0; m < 4; ++m)
#pragma unroll
                    for (int n = 0; n < 2; ++n) acc[a][b][m][n] = (f32x4){0.f, 0.f, 0.f, 0.f};
        cur = nxt; cA = nA; cB = nB; ++ui;
        if constexpr (GATHER) { _Pragma("unroll") for (int h_ = 0; h_ < 2; ++h_) _Pragma("unroll") for (int i_ = 0; i_ < 2; ++i_) vgC[h_][i_] = vgN[h_][i_]; }
        if constexpr (ALIGN_EPI) { if (wr == 1) PG8_BAR; }
    }
    PG8_WAIT_V(0);
    if constexpr (!ALIGN_EPI) { if (wr == 0) PG8_BAR; }
    PG8_BAR;
    if constexpr (Epi::AFTER_DRAIN) { E.fused(acc, cur, wr, wc, fr, fq, lds, wid, lane); S.done(cur); }
#undef PG8_SA
#undef PG8_SB
#undef PG8_STAGE
#undef PG8_LDA
#undef PG8_LDB
#undef PG8_MMA
#undef PG8_WAIT_V
#undef PG8_WAIT_L
#undef PG8_BAR
#undef PG8_SCHED
}
}
#define GAS __attribute__((address_space(1)))
#define LAS __attribute__((address_space(3)))
#define DI __device__ __forceinline__
typedef unsigned short bf16;
typedef unsigned v4u __attribute__((ext_vector_type(4)));
typedef unsigned v2u __attribute__((ext_vector_type(2)));
typedef float f32x4 __attribute__((ext_vector_type(4)));
typedef float f32x2 __attribute__((ext_vector_type(2)));
typedef GAS unsigned gu32;
#define LDS_WAIT() asm volatile("s_waitcnt lgkmcnt(0)" ::: "memory")
#define VM_WAIT() asm volatile("s_waitcnt vmcnt(0)" ::: "memory")
DI unsigned f2bf(float f) { unsigned u = __builtin_bit_cast(unsigned, f); return (u + 0x7fffu + ((u >> 16) & 1u)) >> 16; }
DI unsigned pk2(float lo, float hi) { return f2bf(lo) | (f2bf(hi) << 16); }
DI float bflo(unsigned u) { return __builtin_bit_cast(float, u << 16); }
DI float bfhi(unsigned u) { return __builtin_bit_cast(float, u & 0xffff0000u); }
DI float wave_sum(float v) {
#pragma unroll
    for (int o = 1; o < 64; o <<= 1) v += __shfl_xor(v, o);
    return v;
}
DI float wave_sum_dpp(float v) {
#define WS_DPP(ctrl, rmask) v += __builtin_bit_cast(float, __builtin_amdgcn_update_dpp(0, __builtin_bit_cast(int, v), ctrl, rmask, 0xf, true))
    WS_DPP(0xB1, 0xf); WS_DPP(0x4E, 0xf); WS_DPP(0x141, 0xf); WS_DPP(0x140, 0xf); WS_DPP(0x142, 0xa); WS_DPP(0x143, 0xc);
#undef WS_DPP
    return __builtin_bit_cast(float, __builtin_amdgcn_readlane(__builtin_bit_cast(int, v), 63));
}
DI float wave_max(float v) {
#pragma unroll
    for (int o = 1; o < 64; o <<= 1) v = fmaxf(v, __shfl_xor(v, o));
    return v;
}
#define TS_SECT_BEGIN(C, k) do { if (DBG_TS_SECT == (k) && (C).tid == 0) ((volatile LAS unsigned long long*)((C).lds + 131072 + 320 + 64))[1] = __builtin_amdgcn_s_memrealtime(); } while (0)
#define TS_SECT_END(C, k) do { if (DBG_TS_SECT == (k) && (C).tid == 0) { volatile LAS unsigned long long* t_ = (volatile LAS unsigned long long*)((C).lds + 131072 + 320 + 64); t_[0] = t_[0] + (__builtin_amdgcn_s_memrealtime() - t_[1]); } } while (0)
#define XB_TMO      128
#define XB_XCNT(j)  (256  + 64 * (j))
#define XB_XSUB(j)  (1280 + 64 * (j))
#define XB_XGEN(j)  (2304 + 64 * (j))
#define XB_TOP      3328
#define XB_TOPGEN   3392
#define XCD_BAR_WORDS 3456
#define XB_SPIN_CAP (1u << 18)

__device__ __forceinline__ unsigned xb_ld(unsigned* p)              { return __hip_atomic_load(p, __ATOMIC_RELAXED, __HIP_MEMORY_SCOPE_AGENT); }
__device__ __forceinline__ unsigned xb_add(unsigned* p, unsigned v) { return __hip_atomic_fetch_add(p, v, __ATOMIC_RELAXED, __HIP_MEMORY_SCOPE_AGENT); }
__device__ __forceinline__ unsigned xb_xcc_id() { return (unsigned)__builtin_amdgcn_s_getreg((3 << 11) | 20) & 0xFu; }
#define XB_SPIN(cond, bar) do { unsigned _sp = 0; while (cond) { __builtin_amdgcn_s_sleep(1); \
    if ((++_sp & 255u) == 0u) { if (xb_ld(&(bar)[XB_TMO])) break; if (_sp > XB_SPIN_CAP) { atomicAdd(&(bar)[XB_TMO], 1u); break; } } } } while (0)

struct XcdBarrier {
    unsigned* bar; unsigned x;
    volatile LAS unsigned* st;
};

__device__ __forceinline__ XcdBarrier xcd_barrier_post(unsigned* bar, volatile LAS unsigned* st) {
    XcdBarrier b; b.bar = bar; b.x = xb_xcc_id(); b.st = st;
    if (threadIdx.x == 0) (void)xb_add(&bar[XB_XCNT(b.x)], 1u);
    return b;
}
__device__ __forceinline__ void xcd_barrier_complete(unsigned* bar, unsigned x, unsigned& nloc, unsigned& nx) {
    const unsigned G = gridDim.x * gridDim.y * gridDim.z;
    unsigned sum, cnt, mine, sp = 0u;
    for (;;) {
        sum = 0u; cnt = 0u; mine = 0u;
#pragma unroll
        for (unsigned j = 0; j < 16; ++j) { const unsigned c = xb_ld(&bar[XB_XCNT(j)]); sum += c; cnt += (c > 0u) ? 1u : 0u; mine = (j == x) ? c : mine; }
        if (sum == G) break;
        __builtin_amdgcn_s_sleep(1);
        if ((++sp & 255u) == 0u) { if (xb_ld(&bar[XB_TMO])) break; if (sp > XB_SPIN_CAP) { atomicAdd(&bar[XB_TMO], 1u); break; } }
    }
    nloc = mine > 0u ? mine : 1u; nx = cnt > 0u ? cnt : 1u;
}

__device__ __forceinline__ void xcd_barrier(const XcdBarrier& b) {
    asm volatile("s_waitcnt vmcnt(0)" ::: "memory");
    __syncthreads();
    if (threadIdx.x == 0) {
        unsigned* bar = b.bar;
        __builtin_amdgcn_s_waitcnt(0);
        unsigned nloc = b.st[0], nx = b.st[1];
        if (nloc == 0u) { xcd_barrier_complete(bar, b.x, nloc, nx); b.st[0] = nloc; b.st[1] = nx; }
        const unsigned old = xb_add(&bar[XB_XSUB(b.x)], 1u);
        const unsigned gen = old / nloc;
        if (old + 1u == (gen + 1u) * nloc) {
            __builtin_amdgcn_fence(__ATOMIC_RELEASE, "agent");
            asm volatile("s_waitcnt vmcnt(0)" ::: "memory");
            const unsigned og = xb_add(&bar[XB_TOP], 1u);
            const unsigned tg = og / nx;
            if (og + 1u == (tg + 1u) * nx) xb_add(&bar[XB_TOPGEN], 1u);
            else XB_SPIN(xb_ld(&bar[XB_TOPGEN]) == tg, bar);
            __builtin_amdgcn_fence(__ATOMIC_ACQUIRE, "agent");
            xb_add(&bar[XB_XGEN(b.x)], 1u);
            asm volatile("s_waitcnt vmcnt(0)" ::: "memory");
        } else {
            XB_SPIN(xb_ld(&bar[XB_XGEN(b.x)]) == gen, bar);
            __builtin_amdgcn_fence(__ATOMIC_ACQUIRE, "agent");
            asm volatile("s_waitcnt vmcnt(0)" ::: "memory");
        }
    }
    __syncthreads();
}
constexpr int BATCH = 8, SEQ = 4096, DM = 1024, T = BATCH * SEQ, HD = 64;
constexpr int NWAVES = 8, NTHR = 512;
constexpr float EPS = 1e-6f, LOG2E = 1.4426950408889634f, QSC = 0.125f * LOG2E;
enum { I_X = 0, I_C, I_FOX_WIN, I_FOX_BF, I_FOX_QG, I_FOX_KG, I_FOX_WOUT, I_NSA_WIN, I_NSA_QG, I_NSA_KG, I_NSA_POS, I_NSA_W1, I_NSA_W2, I_NSA_WOUT,
       I_DIL_WIN, I_DIL_QG, I_DIL_KG, I_DIL_WOUT, I_DIFF_WIN, I_DIFF_QG, I_DIFF_KG, I_DIFF_LAM, I_DIFF_SG, I_DIFF_WOUT,
       I_NORM_GAIN, I_ADA_W, I_ADA_B, I_ROUTER_W, I_ROUTER_B, I_MOE_WG, I_MOE_WU, I_MOE_WD, N_IN };
constexpr size_t MiB = 1u << 20;
constexpr size_t WS_CTL = 0, CTL_ZERO_BYTES = 1 * MiB;
constexpr size_t WS_MODP = 1 * MiB, WS_MOD = 7 * MiB, WS_ROPE = 8 * MiB, WS_FLOG = 9 * MiB, WS_CUM = 11 * MiB, WS_GATE = 13 * MiB, WS_LSE = 19 * MiB, WS_SELM = 21 * MiB;
constexpr size_t WS_KC = 22 * MiB, WS_VC = 22 * MiB + 512 * 1024;
constexpr size_t WS_EIDX = 23 * MiB, WS_WTS = WS_EIDX + 256 * 1024, WS_LRANK = WS_WTS + 256 * 1024, WS_ROWOF = WS_LRANK + 256 * 1024;
constexpr size_t WS_ROWTOK = 25 * MiB + 256 * 1024;
constexpr size_t WS_W1T = 26 * MiB;
constexpr size_t WS_HIST = 24 * MiB, WS_TILEE = WS_HIST + 64 * 1024, WS_NTILES = WS_TILEE + 4096;
constexpr size_t WS_FOXWIN = 32 * MiB, WS_NSAWIN = 39 * MiB, WS_DILWIN = 45 * MiB, WS_DIFFWIN = 63 * MiB, WS_WOUT = 69 * MiB;
constexpr size_t WS_MOEW = 80 * MiB, MOEW_LAYER = 48 * MiB, MOEW_D_OFF = 32 * MiB;
constexpr size_t WS_HB = 176 * MiB;
constexpr size_t WS_UO = 272 * MiB, WS_O2 = 336 * MiB, WS_R1 = 400 * MiB, WS_HID = WS_R1 + 136 * MiB, WS_Y = 608 * MiB, WS_END = 672 * MiB;
constexpr int CW_BAR = 4096;
constexpr int LDS_BYTES = 147456, MISC_OFF = 131072 + 320;
constexpr int FOX_NPAD = 3328, NSA_NPAD = 2816;

struct Args { const float* in[N_IN]; float* out; unsigned char* ws; int ph_lo, ph_hi; };
struct Ctx {
    float* hbuf; unsigned char* ws; LAS unsigned char* lds;
    int tid, lane, wave, G, blk;
};
constexpr int PTR_OFF = 131072 + 1024;
DI const float* inp(const Ctx& C, int i) {
    const unsigned long long v = ((const LAS unsigned long long*)(C.lds + PTR_OFF))[i];
    const unsigned lo = __builtin_amdgcn_readfirstlane((unsigned)v), hi = __builtin_amdgcn_readfirstlane((unsigned)(v >> 32));
    return (const float*)(((unsigned long long)hi << 32) | lo);
}

DI void conv_item(const float* W0, const float* W1, int K, int Nsrc, int ldn, bf16* WT, int mode, int nblk, int item, int lane, unsigned long long pmask = 0ull, int pmod = 64) {
    const int kb = item / nblk, nb = item % nblk, k0 = 64 * kb + 16 * (lane >> 4), n = 64 * nb + 4 * (lane & 15);
    const float* src; bool valid;
    if (mode == 0) { int ns = n;
        if ((pmask >> ((n >> 8) % pmod)) & 1ull) { const int pc = n & 255; ns = (n & ~255) + 64 * ((pc >> 5) & 3) + 32 * (pc >> 7) + (pc & 31); }
        valid = ns < Nsrc; src = W0 + ns; }
    else { const int j = n >> 3; valid = true; src = ((n & 4) ? W1 : W0) + 4 * j; }
    f32x4 v[16];
#pragma unroll
    for (int k = 0; k < 16; ++k) v[k] = valid ? *(const f32x4*)(src + (size_t)(k0 + k) * ldn) : (f32x4){0.f, 0.f, 0.f, 0.f};
#pragma unroll
    for (int i = 0; i < 4; ++i) { v4u o0, o1;
        o0.x = pk2(v[0][i], v[1][i]); o0.y = pk2(v[2][i], v[3][i]); o0.z = pk2(v[4][i], v[5][i]); o0.w = pk2(v[6][i], v[7][i]);
        o1.x = pk2(v[8][i], v[9][i]); o1.y = pk2(v[10][i], v[11][i]); o1.z = pk2(v[12][i], v[13][i]); o1.w = pk2(v[14][i], v[15][i]);
        bf16* dst = WT + (size_t)(n + i) * K + k0; *(v4u*)dst = o0; *(v4u*)(dst + 8) = o1; }
}
DI void sincos_d(double x, float& s, float& c) {
    const double k = __builtin_rint(x * 0.6366197723675814);
    double r = __builtin_fma(-k, 1.5707963267948966, x); r = __builtin_fma(-k, 6.123233995736766e-17, r);
    const int q = ((int)k) & 3; const double r2 = r * r;
    double sp = 1.0 / 6227020800.0; sp = sp * r2 - 1.0 / 39916800.0; sp = sp * r2 + 1.0 / 362880.0; sp = sp * r2 - 1.0 / 5040.0; sp = sp * r2 + 1.0 / 120.0; sp = sp * r2 - 1.0 / 6.0; sp = sp * r2 + 1.0; sp *= r;
    double cp = -1.0 / 87178291200.0; cp = cp * r2 + 1.0 / 479001600.0; cp = cp * r2 - 1.0 / 3628800.0; cp = cp * r2 + 1.0 / 40320.0; cp = cp * r2 - 1.0 / 720.0; cp = cp * r2 + 1.0 / 24.0; cp = cp * r2 - 0.5; cp = cp * r2 + 1.0;
    const double ss = (q == 0) ? sp : (q == 1) ? cp : (q == 2) ? -sp : -cp;
    const double cc = (q == 0) ? cp : (q == 1) ? -sp : (q == 2) ? -cp : sp;
    s = (float)ss; c = (float)cc;
}
DI void phase_p0a(Ctx& C) {
    const int gw = C.blk * NWAVES + C.wave, NGW = C.G * NWAVES;
    LAS float* cond = (LAS float*)C.lds;
    for (int i = C.tid; i < BATCH * DM; i += NTHR) { const float v = inp(C, I_C)[i]; cond[i] = v / (1.0f + expf(-v)); }
    __syncthreads();
    for (int it = gw; it < 4 * 96 * 8; it += NGW) {
        const int l = it / 768, rem = it % 768, cg = rem / 8, kc = rem % 8, col = cg * 64 + C.lane;
        float acc[8];
#pragma unroll
        for (int b = 0; b < 8; ++b) acc[b] = 0.f;
        const float* w = inp(C, I_ADA_W) + ((size_t)l * DM + kc * 128) * 6144 + col;
        for (int k0 = 0; k0 < 128; k0 += 16) { float wv[16];
#pragma unroll
            for (int k = 0; k < 16; ++k) wv[k] = w[(size_t)(k0 + k) * 6144];
#pragma unroll
            for (int k = 0; k < 16; ++k)
#pragma unroll
                for (int b = 0; b < 8; ++b) acc[b] += cond[b * DM + kc * 128 + k0 + k] * wv[k]; }
        LAS float* red = (LAS float*)(C.lds + 65536);
#pragma unroll
        for (int b = 0; b < 8; ++b) red[(kc * 8 + b) * 64 + C.lane] = acc[b];
        __syncthreads();
        { const int b = C.tid >> 6, cl = C.tid & 63; float s = inp(C, I_ADA_B)[l * 6144 + cg * 64 + cl];
#pragma unroll
          for (int k8 = 0; k8 < 8; ++k8) s += red[(k8 * 8 + b) * 64 + cl];
          ((float*)(C.ws + WS_MOD))[((size_t)l * 8 + b) * 6144 + cg * 64 + cl] = s; }
        __syncthreads();
    }
    __syncthreads();
    { f32x2* ROPE = (f32x2*)(C.ws + WS_ROPE);
      for (int i = C.blk * NTHR + C.tid; i < SEQ * 32; i += C.G * NTHR) { const int t = i >> 5, f = i & 31;
          const float inv = exp2f(-(float)f * (13.287712379549449f / 32.0f)); const float ang = (float)t * inv; float s, c; sincos_d((double)ang, s, c); ROPE[i] = (f32x2){c, s}; } }
    if (C.blk == 0 && C.tid < 256) { const int k = C.tid >> 5, f = C.tid & 31; const int dlt = 128 * (k >> 2) + 16 * (k & 3);
        const float inv = exp2f(-(float)f * (13.287712379549449f / 32.0f)); const float ang = (float)dlt * inv; float s, c; sincos_d((double)ang, s, c); ((f32x2*)(C.ws + 28 * MiB))[C.tid] = (f32x2){c, s}; }
}
DI void phase_p0c(Ctx& C) {
    const int gw = C.blk * NWAVES + C.wave, NGW = C.G * NWAVES;
    constexpr int I_FOXIN = 16 * (FOX_NPAD / 64), I_NSAIN = 16 * (NSA_NPAD / 64), I_DILIN = 16 * (9216 / 64), I_DIFFIN = 16 * (3072 / 64), I_WO = 16 * 16, I_GU = 16 * 16, I_D = 8 * 16;
    constexpr int I_W1 = 64 * 2;
    constexpr int NITEMS = I_FOXIN + I_NSAIN + I_DILIN + I_DIFFIN + 4 * I_WO + 16 * I_GU + 16 * I_D + 2 * I_W1;
    for (int it = gw; it < NITEMS; it += NGW) {
        int r = it;
        if (r < I_FOXIN) { conv_item(inp(C, I_FOX_WIN), nullptr, DM, 3088, 3088, (bf16*)(C.ws + WS_FOXWIN), 0, FOX_NPAD / 64, r, C.lane, 0xFFull); continue; } r -= I_FOXIN;
        if (r < I_NSAIN) { conv_item(inp(C, I_NSA_WIN), nullptr, DM, 2608, 2608, (bf16*)(C.ws + WS_NSAWIN), 0, NSA_NPAD / 64, r, C.lane, 0x14Full); continue; } r -= I_NSAIN;
        if (r < I_DILIN) { conv_item(inp(C, I_DIL_WIN), nullptr, DM, 9216, 9216, (bf16*)(C.ws + WS_DILWIN), 0, 9216 / 64, r, C.lane, 0xFFull, 12); continue; } r -= I_DILIN;
        if (r < I_DIFFIN) { conv_item(inp(C, I_DIFF_WIN), nullptr, DM, 3072, 3072, (bf16*)(C.ws + WS_DIFFWIN), 0, 3072 / 64, r, C.lane, 0xFFull); continue; } r -= I_DIFFIN;
        if (r < 4 * I_WO) { const int m = r / I_WO; const float* src = (m == 0) ? inp(C, I_FOX_WOUT) : (m == 1) ? inp(C, I_NSA_WOUT) : (m == 2) ? inp(C, I_DIL_WOUT) : inp(C, I_DIFF_WOUT);
            conv_item(src, nullptr, DM, DM, DM, (bf16*)(C.ws + WS_WOUT + (size_t)m * 2 * MiB), 0, 16, r % I_WO, C.lane); continue; } r -= 4 * I_WO;
        if (r < 16 * I_GU) { const int le = r / I_GU, l = le / 16, e = le % 16;
            conv_item(inp(C, I_MOE_WG) + (size_t)le * DM * 512, inp(C, I_MOE_WU) + (size_t)le * DM * 512, DM, 1024, 512, (bf16*)(C.ws + WS_MOEW + (size_t)(l & 1) * MOEW_LAYER + (size_t)e * 2 * MiB), 1, 16, r % I_GU, C.lane); continue; } r -= 16 * I_GU;
        if (r < 16 * I_D) { const int le = r / I_D, l = le / 16, e = le % 16;
            conv_item(inp(C, I_MOE_WD) + (size_t)le * 512 * DM, nullptr, 512, DM, DM, (bf16*)(C.ws + WS_MOEW + (size_t)(l & 1) * MOEW_LAYER + MOEW_D_OFF + (size_t)e * MiB), 0, 16, r % I_D, C.lane); continue; } r -= 16 * I_D;
        { const int which = r / I_W1; conv_item(inp(C, I_NSA_W1) + (size_t)which * 4096 * 128, nullptr, 4096, 128, 128, (bf16*)(C.ws + WS_W1T) + (size_t)which * 128 * 4096, 0, 2, r % I_W1, C.lane); }
    }
}
DI void conv_moe_tail(Ctx& C, int l, bool gu) {
    const int lo = C.G > 64 ? 64 : 0;
    if (C.blk < lo) return;
    const int wv = (C.blk - lo) * NWAVES + C.wave, NW = (C.G - lo) * NWAVES, n = gu ? 4096 : 2048;
    for (int it = wv; it < n; it += NW) {
        if (gu) { const int e = it >> 8, le = l * 16 + e;
            conv_item(inp(C, I_MOE_WG) + (size_t)le * DM * 512, inp(C, I_MOE_WU) + (size_t)le * DM * 512, DM, 1024, 512, (bf16*)(C.ws + WS_MOEW + (size_t)(l & 1) * MOEW_LAYER + (size_t)e * 2 * MiB), 1, 16, it & 255, C.lane); }
        else { const int e = it >> 7, le = l * 16 + e;
            conv_item(inp(C, I_MOE_WD) + (size_t)le * 512 * DM, nullptr, 512, DM, DM, (bf16*)(C.ws + WS_MOEW + (size_t)(l & 1) * MOEW_LAYER + MOEW_D_OFF + (size_t)e * MiB), 0, 16, it & 127, C.lane); }
    }
}
DI void phase_p0b(Ctx& C) {
    const float* MODP = (const float*)(C.ws + WS_MODP); float* MOD = (float*)(C.ws + WS_MOD);
    for (int i = C.blk * NTHR + C.tid; i < 4 * 8 * 6144; i += C.G * NTHR) { const int l = i / (8 * 6144), col = i % 6144;
        float s = inp(C, I_ADA_B)[l * 6144 + col];
#pragma unroll
        for (int kc = 0; kc < 8; ++kc) s += MODP[(size_t)kc * (4 * 8 * 6144) + i];
        MOD[i] = s; }
}
DI void ld_row_f32(const float* p, int lane, f32x4 (&v)[4]) {
#pragma unroll
    for (int j = 0; j < 4; ++j) v[j] = *(const f32x4*)(p + 4 * lane + 256 * j);
}
DI void st_row_f32(float* p, int lane, const f32x4 (&v)[4]) {
#pragma unroll
    for (int j = 0; j < 4; ++j) *(f32x4*)(p + 4 * lane + 256 * j) = v[j];
}
DI void ld_row_bf16(const bf16* p, int lane, f32x4 (&v)[4]) {
#pragma unroll
    for (int j = 0; j < 4; ++j) { const v2u w = *(const v2u*)(p + 4 * lane + 256 * j); v[j] = (f32x4){bflo(w.x), bfhi(w.x), bflo(w.y), bfhi(w.y)}; }
}
DI void st_row_bf16(bf16* p, int lane, const f32x4 (&v)[4]) {
#pragma unroll
    for (int j = 0; j < 4; ++j) { v2u w; w.x = pk2(v[j].x, v[j].y); w.y = pk2(v[j].z, v[j].w); *(v2u*)(p + 4 * lane + 256 * j) = w; }
}
DI void ld_row_raw(const bf16* p, int lane, v2u (&w)[4]) {
#pragma unroll
    for (int j = 0; j < 4; ++j) w[j] = *(const v2u*)(p + 4 * lane + 256 * j);
}
DI void cvt_row(const v2u (&w)[4], f32x4 (&v)[4]) {
#pragma unroll
    for (int j = 0; j < 4; ++j) v[j] = (f32x4){bflo(w[j].x), bfhi(w[j].x), bflo(w[j].y), bfhi(w[j].y)};
}
DI void norm_mod(const f32x4 (&h)[4], const float* gain, const float* sc, const float* sh, int lane, f32x4 (&u)[4]) {
    float ss = 0.f;
#pragma unroll
    for (int j = 0; j < 4; ++j) ss += (h[j].x * h[j].x + h[j].y * h[j].y) + (h[j].z * h[j].z + h[j].w * h[j].w);
    const float r = __builtin_amdgcn_rsqf(wave_sum_dpp(ss) * (1.0f / DM) + EPS);
#pragma unroll
    for (int j = 0; j < 4; ++j) { const f32x4 g = *(const f32x4*)(gain + 4 * lane + 256 * j), s1 = *(const f32x4*)(sc + 4 * lane + 256 * j), s0 = *(const f32x4*)(sh + 4 * lane + 256 * j);
        u[j] = (h[j] * r) * g * (s1 + 1.0f) + s0; }
}
DI int wave_row(const Ctx& C, int i) { return (((i >> 2) * (C.G * NWAVES) + C.blk * NWAVES + C.wave) << 2) + (i & 3); }
DI int rdli(int v, int l) { return __builtin_amdgcn_readlane(v, l); }
template <int L, bool FINAL> DI void rows_combine_norm(Ctx& C) {
    const int RPB = T / C.G, RPW = RPB / NWAVES;
    const float* MOD = (const float*)(C.ws + WS_MOD); bf16* U = (bf16*)(C.ws + WS_UO); bf16* HB = (bf16*)(C.ws + WS_HB);
    constexpr int LP = FINAL ? 3 : (L > 0 ? L - 1 : 0);
    const int* ROWOF = (const int*)(C.ws + WS_ROWOF); const float* WTS = (const float*)(C.ws + WS_WTS); const bf16* YS = (const bf16*)(C.ws + WS_R1); const bf16* Y = (const bf16*)(C.ws + WS_Y);
    int ro = 0; float wt = 0.f;
    if (FINAL || L > 0) { if (C.lane < 2 * RPW) { const int ri = 2 * wave_row(C, (C.lane >> 3) << 2) + (C.lane & 7); ro = ROWOF[ri]; wt = WTS[ri]; } }
    const float* gain = inp(C, I_NORM_GAIN) + (L * 2 + 0) * DM;
    v2u nh[2][4], nm[2][4], n0[2][4], n1[2][4]; f32x4 nx[2][4];
#define N1_ISSUE(ii) do { _Pragma("unroll") for (int k = 0; k < 2; ++k) { const size_t row = wave_row(C, (ii)) + k; \
        if (!FINAL && L == 0) ld_row_f32(inp(C, I_X) + row * DM, C.lane, nx[k]); \
        else { ld_row_raw(HB + row * DM, C.lane, nh[k]); ld_row_raw(Y + row * DM, C.lane, nm[k]);                   \
            const int r0 = rdli(ro, 2 * ((ii) + k)), r1 = rdli(ro, 2 * ((ii) + k) + 1); \
            ld_row_raw(YS + (size_t)r0 * DM, C.lane, n0[k]); ld_row_raw(YS + (size_t)r1 * DM, C.lane, n1[k]); } } } while (0)
    N1_ISSUE(0);
    for (int i = 0; i < RPW; i += 2) {
        const int rowbase2 = wave_row(C, i), b = rowbase2 / SEQ;
        const float* g1 = MOD + ((size_t)(LP * 8 + b) * 6 + 2) * DM; const float* g2 = MOD + ((size_t)(LP * 8 + b) * 6 + 5) * DM;
        const float* sc1 = MOD + ((size_t)(L * 8 + b) * 6 + 1) * DM; const float* sh1 = MOD + ((size_t)(L * 8 + b) * 6 + 0) * DM;
        f32x4 h[2][4], ym[2][4], y0[2][4], y1[2][4]; float w0[2], w1[2];
#pragma unroll
        for (int k = 0; k < 2; ++k) {
            if (!FINAL && L == 0) {
#pragma unroll
                for (int j = 0; j < 4; ++j) h[k][j] = nx[k][j]; }
            else { w0[k] = __builtin_bit_cast(float, rdli(__builtin_bit_cast(int, wt), 2 * (i + k))); w1[k] = __builtin_bit_cast(float, rdli(__builtin_bit_cast(int, wt), 2 * (i + k) + 1));
                cvt_row(nh[k], h[k]); cvt_row(nm[k], ym[k]); cvt_row(n0[k], y0[k]); cvt_row(n1[k], y1[k]); } }
        if (i + 2 < RPW) N1_ISSUE(i + 2);
#pragma unroll
        for (int k = 0; k < 2; ++k) { const size_t row = rowbase2 + k;
            if (FINAL || L > 0) {
#pragma unroll
                for (int j = 0; j < 4; ++j) { const f32x4 ga = *(const f32x4*)(g1 + 4 * C.lane + 256 * j), gb = *(const f32x4*)(g2 + 4 * C.lane + 256 * j);
                    h[k][j] += ga * ym[k][j]; h[k][j] += gb * (y0[k][j] * w0[k] + y1[k][j] * w1[k]); } }
            if (FINAL) st_row_f32(C.hbuf + row * DM, C.lane, h[k]); else st_row_bf16(HB + row * DM, C.lane, h[k]);
            if (!FINAL) { f32x4 u[4]; norm_mod(h[k], gain, sc1, sh1, C.lane, u); st_row_bf16(U + row * DM, C.lane, u); } }
    }
}
#undef N1_ISSUE
template <int L> DI void phase_n1(Ctx& C) { rows_combine_norm<L, false>(C); }
DI void phase_final(Ctx& C) { rows_combine_norm<3, true>(C); }
template <int L> DI void phase_n2(Ctx& C, const bf16* Y) {
    const int RPB = T / C.G, RPW = RPB / NWAVES;
    const float* MOD = (const float*)(C.ws + WS_MOD); bf16* U = (bf16*)(C.ws + WS_UO);
    LAS float* wT = (LAS float*)C.lds; LAS int* hist = (LAS int*)(C.lds + 65536);
    v2u nh[4][4], ny[4][4];
#pragma unroll
    for (int rr = 0; rr < 4; ++rr) { const size_t row = wave_row(C, 0) + rr; ld_row_raw((const bf16*)(C.ws + WS_HB) + row * DM, C.lane, nh[rr]); ld_row_raw(Y + row * DM, C.lane, ny[rr]); }
    for (int idx = C.tid; idx < DM * 16; idx += NTHR) wT[(idx & 15) * DM + (idx >> 4)] = inp(C, I_ROUTER_W)[idx];
    if (C.tid < 16) hist[C.tid] = 0;
    __syncthreads();
    int* EIDX = (int*)(C.ws + WS_EIDX); float* WTS = (float*)(C.ws + WS_WTS); int* LRANK = (int*)(C.ws + WS_LRANK);
    const float* rb = inp(C, I_ROUTER_B); const float* gain = inp(C, I_NORM_GAIN) + (L * 2 + 1) * DM;
    for (int i0 = 0; i0 < RPW; i0 += 4) {
        const int row0 = wave_row(C, i0), b = row0 / SEQ;
        f32x4 hc[4][4], yc[4][4];
#pragma unroll
        for (int rr = 0; rr < 4; ++rr) { cvt_row(nh[rr], hc[rr]); cvt_row(ny[rr], yc[rr]); }
        if (i0 + 4 < RPW) {
#pragma unroll
            for (int rr = 0; rr < 4; ++rr) { const size_t row = wave_row(C, i0 + 4) + rr; ld_row_raw((const bf16*)(C.ws + WS_HB) + row * DM, C.lane, nh[rr]); ld_row_raw(Y + row * DM, C.lane, ny[rr]); } }
        const float* g1 = MOD + ((size_t)(L * 8 + b) * 6 + 2) * DM; const float* sc2 = MOD + ((size_t)(L * 8 + b) * 6 + 4) * DM; const float* sh2 = MOD + ((size_t)(L * 8 + b) * 6 + 3) * DM;
        f32x4 u[4][4];
#pragma unroll
        for (int rr = 0; rr < 4; ++rr) { const size_t row = row0 + rr;
            f32x4 (&h)[4] = hc[rr]; f32x4 (&y)[4] = yc[rr];
            float ss = 0.f;
#pragma unroll
            for (int j = 0; j < 4; ++j) { h[j] += *(const f32x4*)(g1 + 4 * C.lane + 256 * j) * y[j]; ss += (h[j].x * h[j].x + h[j].y * h[j].y) + (h[j].z * h[j].z + h[j].w * h[j].w); }
            const float r = __builtin_amdgcn_rsqf(wave_sum_dpp(ss) * (1.0f / DM) + EPS);
#pragma unroll
            for (int j = 0; j < 4; ++j) { const f32x4 g = *(const f32x4*)(gain + 4 * C.lane + 256 * j), s1 = *(const f32x4*)(sc2 + 4 * C.lane + 256 * j), s0 = *(const f32x4*)(sh2 + 4 * C.lane + 256 * j);
                u[rr][j] = (h[j] * r) * g * (s1 + 1.0f) + s0; }
            st_row_bf16(U + row * DM, C.lane, u[rr]); }
        float pr[4][16];
#pragma unroll
        for (int e = 0; e < 16; ++e) { float a0 = 0.f, a1 = 0.f, a2 = 0.f, a3 = 0.f;
#pragma unroll
            for (int j = 0; j < 4; ++j) { const f32x4 w = *(const LAS f32x4*)(wT + e * DM + 256 * j + 4 * C.lane);
                a0 = fmaf(u[0][j].x, w.x, a0); a0 = fmaf(u[0][j].y, w.y, a0); a0 = fmaf(u[0][j].z, w.z, a0); a0 = fmaf(u[0][j].w, w.w, a0);
                a1 = fmaf(u[1][j].x, w.x, a1); a1 = fmaf(u[1][j].y, w.y, a1); a1 = fmaf(u[1][j].z, w.z, a1); a1 = fmaf(u[1][j].w, w.w, a1);
                a2 = fmaf(u[2][j].x, w.x, a2); a2 = fmaf(u[2][j].y, w.y, a2); a2 = fmaf(u[2][j].z, w.z, a2); a2 = fmaf(u[2][j].w, w.w, a2);
                a3 = fmaf(u[3][j].x, w.x, a3); a3 = fmaf(u[3][j].y, w.y, a3); a3 = fmaf(u[3][j].z, w.z, a3); a3 = fmaf(u[3][j].w, w.w, a3); }
            pr[0][e] = a0; pr[1][e] = a1; pr[2][e] = a2; pr[3][e] = a3; }
        float lgq[16];
#pragma unroll
        for (int e = 0; e < 16; ++e) {
            float x = pr[0][e], y = pr[2][e]; asm volatile("s_nop 1\n\tv_permlane32_swap_b32 %0, %1\n\ts_nop 1" : "+v"(x), "+v"(y)); const float r02 = x + y;
            float z = pr[1][e], w = pr[3][e]; asm volatile("s_nop 1\n\tv_permlane32_swap_b32 %0, %1\n\ts_nop 1" : "+v"(z), "+v"(w)); const float r13 = z + w;
            float a = r02, c = r13; asm volatile("s_nop 1\n\tv_permlane16_swap_b32 %0, %1\n\ts_nop 1" : "+v"(a), "+v"(c)); float v = a + c;
#define N2_DPP(ctrl) v += __builtin_bit_cast(float, __builtin_amdgcn_update_dpp(0, __builtin_bit_cast(int, v), ctrl, 0xf, 0xf, true))
            N2_DPP(0xB1); N2_DPP(0x4E); N2_DPP(0x141); N2_DPP(0x140);
#undef N2_DPP
            lgq[e] = v; }
        { const int row = row0 + (C.lane >> 4);
            float sc[16], sel[16];
#pragma unroll
            for (int e = 0; e < 16; ++e) { sc[e] = __builtin_amdgcn_rcpf(1.0f + __builtin_amdgcn_exp2f(-LOG2E * lgq[e])); sel[e] = sc[e] + rb[e]; }
            float bs = -INFINITY, bw0 = 0.f, bw1 = 0.f; int be0 = 0, be1 = 1;
#pragma unroll
            for (int g = 0; g < 4; ++g) {
                const float a0 = sel[4 * g], a1 = sel[4 * g + 1], a2 = sel[4 * g + 2], a3 = sel[4 * g + 3];
                const float c0 = sc[4 * g], c1 = sc[4 * g + 1], c2 = sc[4 * g + 2], c3 = sc[4 * g + 3];
                int i1 = 0; float v1 = a0, s1 = c0;
                if (a1 > v1) { v1 = a1; s1 = c1; i1 = 1; } if (a2 > v1) { v1 = a2; s1 = c2; i1 = 2; } if (a3 > v1) { v1 = a3; s1 = c3; i1 = 3; }
                int i2 = -1; float v2 = -INFINITY, s2 = 0.f;
                if (i1 != 0 && a0 > v2) { v2 = a0; s2 = c0; i2 = 0; } if (i1 != 1 && a1 > v2) { v2 = a1; s2 = c1; i2 = 1; }
                if (i1 != 2 && a2 > v2) { v2 = a2; s2 = c2; i2 = 2; } if (i1 != 3 && a3 > v2) { v2 = a3; s2 = c3; i2 = 3; }
                const float gs = v1 + v2;
                if (gs > bs) { bs = gs; be0 = 4 * g + i1; be1 = 4 * g + i2; bw0 = s1; bw1 = s2; }
            }
            if ((C.lane & 15) == 0) {
                const float inv = 1.0f / (bw0 + bw1);
                EIDX[2 * row] = be0; EIDX[2 * row + 1] = be1; WTS[2 * row] = bw0 * inv; WTS[2 * row + 1] = bw1 * inv;
                LRANK[2 * row] = __hip_atomic_fetch_add(hist + be0, 1, __ATOMIC_RELAXED, __HIP_MEMORY_SCOPE_WORKGROUP);
                LRANK[2 * row + 1] = __hip_atomic_fetch_add(hist + be1, 1, __ATOMIC_RELAXED, __HIP_MEMORY_SCOPE_WORKGROUP);
            } }
    }
    __syncthreads();
    if (C.tid < 16) ((int*)(C.ws + WS_HIST))[C.blk * 16 + C.tid] = hist[C.tid];
    __syncthreads();
}
DI void phase_s(Ctx& C) {
    const int RPB = T / C.G, RPW = RPB / NWAVES;
    LAS int* tot = (LAS int*)C.lds; LAS int* before = tot + 16; LAS int* base = tot + 32;
    if (C.tid < 48) tot[C.tid] = 0;
    __syncthreads();
    const int* HIST = (const int*)(C.ws + WS_HIST);
    for (int idx = C.tid; idx < C.G * 16; idx += NTHR) { const int bb = idx >> 4, e = idx & 15; const int c = HIST[idx];
        __hip_atomic_fetch_add(tot + e, c, __ATOMIC_RELAXED, __HIP_MEMORY_SCOPE_WORKGROUP);
        if (bb < C.blk) __hip_atomic_fetch_add(before + e, c, __ATOMIC_RELAXED, __HIP_MEMORY_SCOPE_WORKGROUP); }
    __syncthreads();
    if (C.tid == 0) { int ps = 0; int* TILEE = (int*)(C.ws + WS_TILEE);
        for (int e = 0; e < 16; ++e) { base[e] = ps + before[e]; const int pe = (tot[e] + 255) & ~255;
            if (C.blk == 0) for (int tl = ps >> 8; tl < ((ps + pe) >> 8); ++tl) TILEE[tl] = e;
            ps += pe; }
        if (C.blk == 0) *(int*)(C.ws + WS_NTILES) = ps >> 8; }
    __syncthreads();
    const int* EIDX = (const int*)(C.ws + WS_EIDX); const int* LRANK = (const int*)(C.ws + WS_LRANK); int* ROWOF = (int*)(C.ws + WS_ROWOF);
    int* ROWTOK = (int*)(C.ws + WS_ROWTOK);
    if (C.lane < RPW) {
        const int row = wave_row(C, C.lane);
        const int d0 = base[EIDX[2 * row]] + LRANK[2 * row], d1 = base[EIDX[2 * row + 1]] + LRANK[2 * row + 1];
        ROWOF[2 * row] = d0; ROWOF[2 * row + 1] = d1; ROWTOK[d0] = row; ROWTOK[d1] = row;
    }
    __syncthreads();
}
DI size_t hm(int cb, int b) { return ((size_t)cb * BATCH + b) * SEQ * 64; }
DI void gemm_qkv(Ctx& C, const bf16* A, const bf16* Bt, int Npad, bf16* O, int ldc, int n_main, float* tail, int tail_n) {
    pg8::Gemm g{A, Bt, T, Npad, DM}; pg8::StaticOrder S; S.init(T, Npad, C.G, C.blk);
    pg8::EpiStore E{O, ldc, 1 << 20, n_main, tail, tail_n};
    pg8::gemm_phase<pg8::EpiStore, pg8::StaticOrder, true, true>(C.lds, g, S, E);
}
constexpr size_t WS_ROPED = 28 * MiB;
constexpr int GAIN_LDS_OFF = 133120;
DI void gemm_qkv_prep(Ctx& C, const bf16* A, const bf16* Bt, int Npad, bf16* O, int ldc, int n_main, float* tail, int tail_n,
                      int k_lo, int k_hi, int k2_lo, int k2_hi, const float* gq, const float* gk, const float* gk2, bool rope, int dilv = 1, int tail_hm = 0) {
    LAS float* gl = (LAS float*)(C.lds + GAIN_LDS_OFF);
    if (C.tid < 192) { const int s = C.tid >> 6, i = C.tid & 63; const float* gp = (s == 0) ? gq : (s == 1) ? gk : gk2; gl[C.tid] = gp ? gp[i] : 0.f; }
    __syncthreads();
    pg8::Gemm g{A, Bt, T, Npad, DM}; pg8::StaticOrder S; S.init(T, Npad, C.G, C.blk);
    pg8::EpiQKVPrep E{O, ldc, n_main, tail, tail_n, k_lo, k_hi, k2_lo, k2_hi, gl, rope ? (const float*)(C.ws + WS_ROPE) : nullptr, (const float*)(C.ws + WS_ROPED), QSC, EPS, 12  , BATCH, (dilv == 16) ? 4 : (dilv == 4) ? 2 : 0, tail_hm};
    static_assert(SEQ == 4096, "EpiQKVPrep: lgseq");
    pg8::gemm_phase<pg8::EpiQKVPrep, pg8::StaticOrder, true, true>(C.lds, g, S, E);
}
DI void gemm_moe1(Ctx& C, int L) {
    const int ntiles = *(const int*)(C.ws + WS_NTILES);
    pg8::Gemm g{(const bf16*)(C.ws + WS_UO), (const bf16*)(C.ws + WS_MOEW + (size_t)(L & 1) * MOEW_LAYER), ntiles * 256, 16 * 1024, DM, (const int*)(C.ws + WS_ROWTOK), T};
    pg8::MoeOrder S{(const int*)(C.ws + WS_TILEE), ntiles, 4, C.G, C.blk};
    pg8::EpiSwiGLU E{(bf16*)(C.ws + WS_HID), 4};
    pg8::gemm_phase<pg8::EpiSwiGLU, pg8::MoeOrder, true, true, true>(C.lds, g, S, E);
    if (L < 3) conv_moe_tail(C, L + 1, true);
}
DI void gemm_moe2(Ctx& C, int L) {
    const int ntiles = *(const int*)(C.ws + WS_NTILES);
    pg8::Gemm g{(const bf16*)(C.ws + WS_HID), (const bf16*)(C.ws + WS_MOEW + (size_t)(L & 1) * MOEW_LAYER + MOEW_D_OFF), ntiles * 256, 16 * 1024, 512};
    pg8::MoeOrder S{(const int*)(C.ws + WS_TILEE), ntiles, 4, C.G, C.blk};
    pg8::EpiStore E{(bf16*)(C.ws + WS_R1), DM, 4, DM, nullptr, 0};
    pg8::gemm_phase<pg8::EpiStore, pg8::MoeOrder, true, true>(C.lds, g, S, E);
    if (L < 3) conv_moe_tail(C, L + 1, false);
}
DI float log_sigmoid_fast(float x) {
    const float ax = fabsf(x), t = __builtin_amdgcn_logf(1.0f + __builtin_amdgcn_exp2f(-ax * LOG2E)) * 0.6931471805599453f;
    return (x < 0.f ? x : 0.f) - t;
}
constexpr int NSA_LDQ = 2560;
DI void nsa_compress(Ctx& C) {
    typedef short bf16x8c __attribute__((ext_vector_type(8)));
    const bf16* QKV = (const bf16*)(C.ws + WS_R1); const f32x2* ROPE = (const f32x2*)(C.ws + WS_ROPE);
    LAS unsigned char* blk = C.lds;
    LAS float* hid = (LAS float*)(C.lds + 133120);
    bf16* KC = (bf16*)(C.ws + WS_KC); bf16* VC = (bf16*)(C.ws + WS_VC);
    const int fr = C.lane & 15, fq = C.lane >> 4;
    for (int task = C.blk; task < 256; task += C.G) {
        const int which = task >> 7, r = task & 127, b = r >> 4, g = (r >> 2) & 3, n0 = (r & 3) * 16;
        const size_t cbase = hm((which == 0 ? 16 : 20) + g, b);
        const float* pos = inp(C, I_NSA_POS) + which * 4096;
        __syncthreads();
        for (int idx = C.tid; idx < 8192; idx += NTHR) { const int rw = idx >> 9, rem = idx & 511, l = rem >> 3, d8 = (rem & 7) * 8;
            const v4u w = *(const v4u*)(QKV + cbase + ((size_t)(n0 + rw) * 64 + l) * 64 + d8);
            const f32x4 p0 = *(const f32x4*)(pos + l * 64 + d8), p1 = *(const f32x4*)(pos + l * 64 + d8 + 4);
            v4u o; o.x = pk2(bflo(w.x) + p0.x, bfhi(w.x) + p0.y); o.y = pk2(bflo(w.y) + p0.z, bfhi(w.y) + p0.w); o.z = pk2(bflo(w.z) + p1.x, bfhi(w.z) + p1.y); o.w = pk2(bflo(w.w) + p1.z, bfhi(w.w) + p1.w);
            *(LAS v4u*)(blk + rw * 8208 + (l * 64 + d8) * 2) = o; }
        __syncthreads();
        { const bf16* wt = (const bf16*)(C.ws + WS_W1T) + ((size_t)which * 128 + 16 * C.wave + fr) * 4096 + 8 * fq;
          LAS const unsigned char* ap = blk + fr * 8208 + 16 * fq;
          f32x4 acc = {0.f, 0.f, 0.f, 0.f};
#pragma unroll 1
          for (int k0 = 0; k0 < 128; k0 += 16) {
              bf16x8c bv[16];
#pragma unroll
              for (int k = 0; k < 16; ++k) bv[k] = *(const bf16x8c*)(wt + 32 * (k0 + k));
#pragma unroll
              for (int k = 0; k < 16; ++k) { const bf16x8c av = *(LAS const bf16x8c*)(ap + 64 * (k0 + k)); acc = __builtin_amdgcn_mfma_f32_16x16x32_bf16(av, bv[k], acc, 0, 0, 0); } }
#pragma unroll
          for (int i = 0; i < 4; ++i) hid[(4 * fq + i) * 128 + 16 * C.wave + fr] = acc[i] / (1.0f + expf(-acc[i])); }
        __syncthreads();
        { const int d = C.lane; const float* w2 = inp(C, I_NSA_W2) + (size_t)which * 128 * 64 + d;
          float o2[2] = {0.f, 0.f};
#pragma unroll 1
          for (int j0 = 0; j0 < 128; j0 += 32) { float wv[32];
#pragma unroll
              for (int j = 0; j < 32; ++j) wv[j] = w2[(j0 + j) * 64];
#pragma unroll
              for (int j = 0; j < 32; ++j) { o2[0] += hid[(2 * C.wave) * 128 + j0 + j] * wv[j]; o2[1] += hid[(2 * C.wave + 1) * 128 + j0 + j] * wv[j]; } }
#pragma unroll
          for (int rr = 0; rr < 2; ++rr) { const int rw = 2 * C.wave + rr; const float o = o2[rr];
              const size_t oi = (((size_t)b * 4 + g) * 64 + n0 + rw) * 64 + d;
              if (which == 1) VC[oi] = (bf16)f2bf(o);
              else { const float ss = wave_sum(o * o); const float y = o / sqrtf(ss * (1.0f / 64.0f) + EPS) * inp(C, I_NSA_KG)[d];
                  const float pr = __shfl_xor(y, 32); const f32x2 cs = ROPE[((n0 + rw) * 64 + 63) * 32 + (d & 31)];
                  KC[oi] = (bf16)f2bf((d < 32) ? (y * cs.x - pr * cs.y) : (pr * cs.y + y * cs.x)); } } }
    }
    __syncthreads();
}
typedef short bf16x8 __attribute__((ext_vector_type(8)));
typedef short s16x4 __attribute__((ext_vector_type(4)));
typedef float f32x16 __attribute__((ext_vector_type(16)));
typedef __bf16 bf16x2_t __attribute__((ext_vector_type(2)));
namespace fa {
DI int crow(int i, int h) { return (i & 3) + 8 * (i >> 2) + 4 * h; }
DI void glds16(const void* gsrc, unsigned lds_dst) { unsigned keep;
    asm volatile("s_mov_b32 %0, m0\n\ts_mov_b32 m0, %2\n\ts_nop 0\n\tglobal_load_lds_dwordx4 %1, off\n\ts_mov_b32 m0, %0" : "=&s"(keep) : "v"(gsrc), "s"(lds_dst) : "memory"); }
#define FA_WAIT_BAR(N) asm volatile("s_waitcnt vmcnt(" #N ") lgkmcnt(0)\n\ts_barrier" ::: "memory")
DI unsigned cvtpk(float lo, float hi) { f32x2 v = {lo, hi}; bf16x2_t b = __builtin_convertvector(v, bf16x2_t); return __builtin_bit_cast(unsigned, b); }
DI float xmax32(float v) { float a = v, b = v; asm volatile("s_nop 1\n\tv_permlane32_swap_b32 %0, %1\n\ts_nop 1" : "+v"(a), "+v"(b)); return fmaxf(a, b); }
DI float xsum32(float v) { float a = v, b = v; asm volatile("s_nop 1\n\tv_permlane32_swap_b32 %0, %1\n\ts_nop 1" : "+v"(a), "+v"(b)); return a + b; }
typedef short v4i16_t __attribute__((ext_vector_type(4)));
DI s16x4 vtr(LAS const char* p) { return __builtin_bit_cast(s16x4, __builtin_amdgcn_ds_read_tr16_b64_v4i16((LAS v4i16_t*)p)); }
constexpr int KSLOT = 8192, KRING = 3 * KSLOT;
DI void qk(LAS const char* ks, const bf16x8 (&qf)[4], int lane, f32x16& p0, f32x16& p1) {
    const int r = lane & 31, h = lane >> 5;
#pragma unroll
    for (int i = 0; i < 16; ++i) { p0[i] = 0.f; p1[i] = 0.f; }
    LAS const char* kb = ks + r * 128;
#pragma unroll
    for (int d0 = 0; d0 < 4; ++d0) {
        const int ko = ((2 * d0 + h) ^ (r & 7)) * 16;
        const bf16x8 a0 = *(LAS const bf16x8*)(kb + ko), a1 = *(LAS const bf16x8*)(kb + ko + 4096);
        p0 = __builtin_amdgcn_mfma_f32_32x32x16_bf16(a0, qf[d0], p0, 0, 0, 0);
        p1 = __builtin_amdgcn_mfma_f32_32x32x16_bf16(a1, qf[d0], p1, 0, 0, 0);
    }
}
template <int DV>
DI void pv(LAS const char* vs, int lane, const f32x16& p0, const f32x16& p1, f32x16 (&o)[DV / 32]) {
    const int h = lane >> 5;
    bf16x8 pf[4];
#pragma unroll
    for (int s = 0; s < 2; ++s) {
        v4u w0, w1;
        w0.x = cvtpk(p0[8 * s], p0[8 * s + 1]); w0.y = cvtpk(p0[8 * s + 2], p0[8 * s + 3]); w0.z = cvtpk(p0[8 * s + 4], p0[8 * s + 5]); w0.w = cvtpk(p0[8 * s + 6], p0[8 * s + 7]);
        w1.x = cvtpk(p1[8 * s], p1[8 * s + 1]); w1.y = cvtpk(p1[8 * s + 2], p1[8 * s + 3]); w1.z = cvtpk(p1[8 * s + 4], p1[8 * s + 5]); w1.w = cvtpk(p1[8 * s + 6], p1[8 * s + 7]);
        pf[s] = __builtin_bit_cast(bf16x8, w0); pf[2 + s] = __builtin_bit_cast(bf16x8, w1);
    }
    LAS const char* vb = vs + ((lane >> 4) & 1) * 32 + (lane & 3) * 8 + (4 * h + ((lane & 15) >> 2)) * 64;
#pragma unroll
    for (int kq = 0; kq < 4; ++kq)
#pragma unroll
        for (int b = 0; b < DV / 32; ++b) {
            const s16x4 lo = vtr(vb + (b * 4 + kq) * 1024), hi = vtr(vb + (b * 4 + kq) * 1024 + 512);
            const bf16x8 vf = {lo[0], lo[1], lo[2], lo[3], hi[0], hi[1], hi[2], hi[3]};
            o[b] = __builtin_amdgcn_mfma_f32_32x32x16_bf16(vf, pf[kq], o[b], 0, 0, 0);
        }
}
template <int DV>
DI void store_o(bf16* orow, int h, const f32x16 (&o)[DV / 32], float sc) {
#pragma unroll
    for (int b = 0; b < DV / 32; ++b)
#pragma unroll
        for (int g4 = 0; g4 < 4; ++g4) { v2u w; w.x = cvtpk(o[b][4 * g4] * sc, o[b][4 * g4 + 1] * sc); w.y = cvtpk(o[b][4 * g4 + 2] * sc, o[b][4 * g4 + 3] * sc);
            *(v2u*)(orow + 32 * b + 8 * g4 + 4 * h) = w; }
}
DI void store_o64_st(LAS char* stg, bf16* w0, size_t ld, int lane, const f32x16& oa, const f32x16& ob, float sc) {
    const int r = lane & 31, h = lane >> 5;
#pragma unroll
    for (int b = 0; b < 2; ++b)
#pragma unroll
        for (int g4 = 0; g4 < 4; ++g4) { const f32x16& o = b ? ob : oa; v2u w; w.x = cvtpk(o[4 * g4] * sc, o[4 * g4 + 1] * sc); w.y = cvtpk(o[4 * g4 + 2] * sc, o[4 * g4 + 3] * sc);
            *(LAS v2u*)(stg + r * 128 + (((4 * b + g4) ^ (r & 7)) << 4) + h * 8) = w; }
#pragma unroll
    for (int i = 0; i < 4; ++i) { const int row = i * 8 + (lane >> 3), ch = lane & 7;
        const v4u v = *(const LAS v4u*)(stg + row * 128 + ((ch ^ (row & 7)) << 4));
        *(v4u*)(w0 + (size_t)row * ld + ch * 8) = v; }
}
DI void load_o64_st(LAS char* stg, const bf16* w0, size_t ld, int lane, v2u (&w)[8]) {
    const int r = lane & 31, h = lane >> 5;
#pragma unroll
    for (int i = 0; i < 4; ++i) { const int row = i * 8 + (lane >> 3), ch = lane & 7;
        *(LAS v4u*)(stg + row * 128 + ((ch ^ (row & 7)) << 4)) = *(const v4u*)(w0 + (size_t)row * ld + ch * 8); }
#pragma unroll
    for (int c = 0; c < 8; ++c) w[c] = *(const LAS v2u*)(stg + r * 128 + ((c ^ (r & 7)) << 4) + h * 8);
}
DI void ld_o64_rows(const bf16* w0, size_t ld, int lane, v4u (&raw)[4]) {
#pragma unroll
    for (int i = 0; i < 4; ++i) raw[i] = *(const v4u*)(w0 + (size_t)(i * 8 + (lane >> 3)) * ld + (lane & 7) * 8);
}
DI void unstage_o64(LAS char* stg, const v4u (&raw)[4], int lane, v2u (&w)[8]) {
    const int r = lane & 31, h = lane >> 5;
#pragma unroll
    for (int i = 0; i < 4; ++i) { const int row = i * 8 + (lane >> 3), ch = lane & 7; *(LAS v4u*)(stg + row * 128 + ((ch ^ (row & 7)) << 4)) = raw[i]; }
#pragma unroll
    for (int c = 0; c < 8; ++c) w[c] = *(const LAS v2u*)(stg + r * 128 + ((c ^ (r & 7)) << 4) + h * 8);
}
}
namespace fa2 {
constexpr int NS = 4;
constexpr float THR = 8.0f;
DI void qk(LAS const char* ks, const bf16x8 (&qf)[4], int lane, const f32x16& negm, f32x16& p0, f32x16& p1) {
    const int r = lane & 31, h = lane >> 5;
    LAS const char* kb = ks + r * 128;
    { const int ko = (h ^ (r & 7)) * 16; const bf16x8 a0 = *(LAS const bf16x8*)(kb + ko), a1 = *(LAS const bf16x8*)(kb + ko + 4096);
      p0 = __builtin_amdgcn_mfma_f32_32x32x16_bf16(a0, qf[0], negm, 0, 0, 0); p1 = __builtin_amdgcn_mfma_f32_32x32x16_bf16(a1, qf[0], negm, 0, 0, 0); }
#pragma unroll
    for (int d0 = 1; d0 < 4; ++d0) {
        const int ko = ((2 * d0 + h) ^ (r & 7)) * 16;
        const bf16x8 a0 = *(LAS const bf16x8*)(kb + ko), a1 = *(LAS const bf16x8*)(kb + ko + 4096);
        p0 = __builtin_amdgcn_mfma_f32_32x32x16_bf16(a0, qf[d0], p0, 0, 0, 0);
        p1 = __builtin_amdgcn_mfma_f32_32x32x16_bf16(a1, qf[d0], p1, 0, 0, 0);
    }
}
template <int DV, bool NOMAX = false>
DI void softmax(f32x16& c0, f32x16& c1, f32x16& n0, f32x16& n1, bool fixn, f32x16 (&o)[DV / 32], float& m, float& l, f32x16& negm, float qbias, bool nomax_rt = false) {
  if constexpr (!NOMAX) { if (!nomax_rt) {
    float mxa = fmaxf(c0[0], c0[1]), mxb = fmaxf(c1[0], c1[1]);
#pragma unroll
    for (int i = 2; i < 16; ++i) { mxa = fmaxf(mxa, c0[i]); mxb = fmaxf(mxb, c1[i]); }
    float mx = fa::xmax32(fmaxf(mxa, mxb));
    if (__any(mx > THR)) {
        const float dl = fmaxf(mx, 0.f), a = __builtin_amdgcn_exp2f(-dl); m += dl; l *= a;
#pragma unroll
        for (int b = 0; b < DV / 32; ++b)
#pragma unroll
            for (int i = 0; i < 16; ++i) o[b][i] *= a;
#pragma unroll
        for (int i = 0; i < 16; ++i) { c0[i] -= dl; c1[i] -= dl; negm[i] = qbias - m; }
        asm volatile("" : "+v"(negm));
        if (fixn) {
#pragma unroll
            for (int i = 0; i < 16; ++i) { n0[i] -= dl; n1[i] -= dl; } }
    }
  } }
#pragma unroll
    for (int i = 0; i < 16; ++i) { c0[i] = __builtin_amdgcn_exp2f(c0[i]); c1[i] = __builtin_amdgcn_exp2f(c1[i]); l += c0[i]; l += c1[i]; }
}
template <int DV, class KP, class VP, class Act, class Pre>
DI void loop(LAS char* shm, int wid, int lane, const bf16x8 (&qf)[4], int ntiles, KP kp, VP vp, Act act, Pre pre, f32x16 (&o)[DV / 32], float& m, float& l, float qbias = 0.f) {
    constexpr int VSLOT = DV * 128, KR = NS * fa::KSLOT;
    const unsigned ldsK = (unsigned)(size_t)shm, ldsV = ldsK + KR;
#define FA2_ISSUE(i, s) do { fa::glds16(kp(i), (unsigned)__builtin_amdgcn_readfirstlane(ldsK + (s) * fa::KSLOT + wid * 1024)); \
        _Pragma("unroll") for (int pc_ = 0; pc_ < DV / 64; ++pc_) fa::glds16(vp((i), wid + 8 * pc_), (unsigned)__builtin_amdgcn_readfirstlane(ldsV + (s) * VSLOT + (wid + 8 * pc_) * 1024)); } while (0)
    if (ntiles > 0) FA2_ISSUE(0, 0);
    if (ntiles > 1) FA2_ISSUE(1, 1);
    if (ntiles > 2) FA2_ISSUE(2, 2);
    if (ntiles > 2) { if (DV == 64) FA_WAIT_BAR(4); else FA_WAIT_BAR(6); } else if (ntiles > 1) { if (DV == 64) FA_WAIT_BAR(2); else FA_WAIT_BAR(3); } else FA_WAIT_BAR(0);
    f32x16 negm, cA0, cA1, cB0, cB1;
#pragma unroll
    for (int i = 0; i < 16; ++i) { negm[i] = qbias - m; cA0[i] = 0.f; cA1[i] = 0.f; cB0[i] = 0.f; cB1[i] = 0.f; }
    asm volatile("" : "+v"(negm));
    bool actc = ntiles > 0 && act(0);
    if (actc) qk((LAS const char*)shm, qf, lane, negm, cA0, cA1);
    int sc = 0, sn = 1, s3 = 3;
#define FA2_STEP(C0, C1, N0, N1, i) do { \
        if ((i) + 1 < ntiles) { if ((i) + 2 < ntiles) { if (DV == 64) FA_WAIT_BAR(2); else FA_WAIT_BAR(3); } else FA_WAIT_BAR(0); } \
        if ((i) + 3 < ntiles) FA2_ISSUE((i) + 3, s3); \
        const bool actn_ = ((i) + 1 < ntiles) && act((i) + 1); \
        if (actn_) qk((LAS const char*)shm + sn * fa::KSLOT, qf, lane, negm, N0, N1); \
        if (actc) { pre((i), C0, C1); softmax<DV>(C0, C1, N0, N1, actn_, o, m, l, negm, qbias); fa::pv<DV>((LAS const char*)shm + KR + sc * VSLOT, lane, C0, C1, o); } \
        actc = actn_; sc = sn; sn = (sn == NS - 1) ? 0 : sn + 1; s3 = (s3 == NS - 1) ? 0 : s3 + 1; } while (0)
    int i = 0;
    for (; i + 1 < ntiles; i += 2) { FA2_STEP(cA0, cA1, cB0, cB1, i); FA2_STEP(cB0, cB1, cA0, cA1, i + 1); }
    if (i < ntiles) FA2_STEP(cA0, cA1, cB0, cB1, i);
    FA_WAIT_BAR(0);
#undef FA2_STEP
#undef FA2_ISSUE
}
}

namespace fa3 {
template <int DV, class KP, class VP>
DI void issue01(LAS char* shm, int wid, int ntiles, KP kp, VP vp) {
    constexpr int VSLOT = DV * 128;
    const unsigned ldsK = (unsigned)(size_t)shm, ldsV = ldsK + fa::KRING;
#pragma unroll
    for (int t = 0; t < 2; ++t) if (t < ntiles) {
        fa::glds16(kp(t), (unsigned)__builtin_amdgcn_readfirstlane(ldsK + t * fa::KSLOT + wid * 1024));
#pragma unroll
        for (int pc_ = 0; pc_ < DV / 64; ++pc_) fa::glds16(vp(t, wid + 8 * pc_), (unsigned)__builtin_amdgcn_readfirstlane(ldsV + t * VSLOT + (wid + 8 * pc_) * 1024)); }
}
struct NoPf { DI void operator()() const {} };
template <int DV, bool NOMAX = false, class KP, class VP, class Act, class Pre, class PF = NoPf>
DI void loop(LAS char* shm, int wid, int lane, const bf16x8 (&qf)[4], int ntiles, KP kp, VP vp, Act act, Pre pre, f32x16 (&o)[DV / 32], float& m, float& l, float qbias = 0.f, bool pre_issued = false, PF pf_next = PF(), bool nomax_rt = false) {
    constexpr int VSLOT = DV * 128;
    const unsigned ldsK = (unsigned)(size_t)shm, ldsV = ldsK + fa::KRING;
#define FA3_ISSUE(i, s) do { fa::glds16(kp(i), (unsigned)__builtin_amdgcn_readfirstlane(ldsK + (s) * fa::KSLOT + wid * 1024)); \
        _Pragma("unroll") for (int pc_ = 0; pc_ < DV / 64; ++pc_) fa::glds16(vp((i), wid + 8 * pc_), (unsigned)__builtin_amdgcn_readfirstlane(ldsV + (s) * VSLOT + (wid + 8 * pc_) * 1024)); } while (0)
    if (!pre_issued) issue01<DV>(shm, wid, ntiles, kp, vp);
    f32x16 negm, dummy0, dummy1;
#pragma unroll
    for (int i = 0; i < 16; ++i) { negm[i] = qbias - m; dummy0[i] = 0.f; dummy1[i] = 0.f; }
    asm volatile("" : "+v"(negm));
    int sc = 0, sn2 = 2;
    for (int i = 0; i < ntiles; ++i) {
        if (i + 1 < ntiles) { if (DV == 64) FA_WAIT_BAR(2); else FA_WAIT_BAR(3); } else FA_WAIT_BAR(0);
        if (i + 2 < ntiles) FA3_ISSUE(i + 2, sn2);
        if (act(i)) {
            f32x16 c0, c1;
            fa2::qk((LAS const char*)shm + sc * fa::KSLOT, qf, lane, negm, c0, c1);
            pre(i, c0, c1);
            fa2::softmax<DV, NOMAX>(c0, c1, dummy0, dummy1, false, o, m, l, negm, qbias, nomax_rt);
            fa::pv<DV>((LAS const char*)shm + fa::KRING + sc * VSLOT, lane, c0, c1, o);
        }
        sc = (sc == 2) ? 0 : sc + 1; sn2 = (sn2 == 2) ? 0 : sn2 + 1;
    }
    FA_WAIT_BAR(0);
    pf_next();
#undef FA3_ISSUE
}
}

namespace fa4 {
constexpr int NSL = 6, KR6 = NSL * fa::KSLOT;
template <class KP, class VP>
DI void issue_all(LAS char* shm, int wid, int ntiles, KP kp, VP vp) {
    const unsigned ldsK = (unsigned)(size_t)shm, ldsV = ldsK + KR6;
#pragma unroll
    for (int t = 0; t < NSL; ++t) if (t < ntiles) {
        fa::glds16(kp(t), (unsigned)__builtin_amdgcn_readfirstlane(ldsK + t * fa::KSLOT + wid * 1024));
        fa::glds16(vp(t, wid), (unsigned)__builtin_amdgcn_readfirstlane(ldsV + t * 8192 + wid * 1024)); }
}
template <bool NOMAX = false, class KP, class VP, class Act, class Pre, class PF>
DI void loop(LAS char* shm, int wid, int lane, const bf16x8 (&qf)[4], int ntiles, KP kp, VP vp, Act act, Pre pre, f32x16 (&o)[2], float& m, float& l, bool pre_issued, PF pf_next) {
    if (!pre_issued) issue_all(shm, wid, ntiles, kp, vp);
    f32x16 negm, dummy0, dummy1;
#pragma unroll
    for (int i = 0; i < 16; ++i) { negm[i] = -m; dummy0[i] = 0.f; dummy1[i] = 0.f; }
    asm volatile("" : "+v"(negm));
    FA_WAIT_BAR(0);
    for (int i = 0; i < ntiles; ++i) {
        if (act(i)) {
            f32x16 c0, c1;
            fa2::qk((LAS const char*)shm + i * fa::KSLOT, qf, lane, negm, c0, c1);
            pre(i, c0, c1);
            fa2::softmax<64, NOMAX>(c0, c1, dummy0, dummy1, false, o, m, l, negm, 0.f);
            fa::pv<64>((LAS const char*)shm + KR6 + i * 8192, lane, c0, c1, o);
        }
    }
    FA_WAIT_BAR(0);
    pf_next();
}
}

namespace fa5 {
template <int DV, int CH, bool NOMAX = false, class KP, class VP, class Act, class Pre>
DI void loop(LAS char* shm, int wid, int lane, const bf16x8 (&qf)[4], int ntiles, KP kp, VP vp, Act act, Pre pre, f32x16 (&o)[DV / 32], float& m, float& l, float qbias = 0.f, bool pre0 = false) {
    constexpr int VSLOT = DV * 128, KR = 2 * CH * fa::KSLOT;
    const unsigned ldsK = (unsigned)(size_t)shm, ldsV = ldsK + KR;
    const int nch = (ntiles + CH - 1) / CH;
#define FA5_ISSUE_CHUNK(c) do { const int bank_ = (c) & 1; _Pragma("unroll") for (int t_ = 0; t_ < CH; ++t_) { const int ti_ = (c) * CH + t_; if (ti_ < ntiles) { const int s_ = bank_ * CH + t_; \
        fa::glds16(kp(ti_), (unsigned)__builtin_amdgcn_readfirstlane(ldsK + s_ * fa::KSLOT + wid * 1024)); \
        _Pragma("unroll") for (int pc_ = 0; pc_ < DV / 64; ++pc_) fa::glds16(vp(ti_, wid + 8 * pc_), (unsigned)__builtin_amdgcn_readfirstlane(ldsV + s_ * VSLOT + (wid + 8 * pc_) * 1024)); } } } while (0)
    if (nch > 0 && !pre0) FA5_ISSUE_CHUNK(0);
    f32x16 negm, dummy0, dummy1;
#pragma unroll
    for (int i = 0; i < 16; ++i) { negm[i] = qbias - m; dummy0[i] = 0.f; dummy1[i] = 0.f; }
    asm volatile("" : "+v"(negm));
    for (int c = 0; c < nch; ++c) {
        FA_WAIT_BAR(0);
        if (c + 1 < nch) FA5_ISSUE_CHUNK(c + 1);
        if (wid >= 4) __builtin_amdgcn_s_sleep(10);
        const int bank = c & 1;
#pragma unroll
        for (int t = 0; t < CH; ++t) { const int i = c * CH + t;
            if (i < ntiles && act(i)) {
                f32x16 c0, c1;
                fa2::qk((LAS const char*)shm + (bank * CH + t) * fa::KSLOT, qf, lane, negm, c0, c1);
                pre(i, c0, c1);
                fa2::softmax<DV, NOMAX>(c0, c1, dummy0, dummy1, false, o, m, l, negm, qbias);
                fa::pv<DV>((LAS const char*)shm + KR + (bank * CH + t) * VSLOT, lane, c0, c1, o);
            } }
    }
    FA_WAIT_BAR(0);
#undef FA5_ISSUE_CHUNK
}
}
constexpr int FA_CUM_OFF = 98304;
template <bool NOMAX> DI void attn_fox_impl(Ctx& C, float B2) {
    if (C.wave >= 4) __builtin_amdgcn_s_setprio(1);
    const int vblk = (C.blk % 8) * (C.G / 8) + C.blk / 8;
    const bf16* QKV = (const bf16*)(C.ws + WS_R1); bf16* O = (bf16*)(C.ws + WS_UO); const float* FLOG = (const float*)(C.ws + WS_FLOG);
    const int lane = C.lane, wid = C.wave, r = lane & 31, h2 = lane >> 5;
    LAS float* cumL = (LAS float*)(C.lds + FA_CUM_OFF);
    const float skip_thr = -(150.0f + 2.0f * B2);
    const int nunits = BATCH * 16 * 16;
    unsigned* qctr = (unsigned*)(C.ws + WS_CTL) + 8192;
    LAS int* qslot = (LAS int*)(C.lds + FA_CUM_OFF + 16384 + 64);
    int unext = 0;
    if (C.tid == 0) unext = (int)__hip_atomic_fetch_add(qctr, 1u, __ATOMIC_RELAXED, __HIP_MEMORY_SCOPE_AGENT);
    for (;;) {
        if (C.tid == 0) { *qslot = unext; unext = (int)__hip_atomic_fetch_add(qctr, 1u, __ATOMIC_RELAXED, __HIP_MEMORY_SCOPE_AGENT); }
        asm volatile("s_waitcnt lgkmcnt(0)" ::: "memory"); __builtin_amdgcn_s_barrier();
        const int u = __builtin_amdgcn_readfirstlane(*qslot);
        if (u >= nunits) break;
        const int qblk = 15 - (u >> 7), bh = u & 127;
        const int b = bh / 16, hd = bh % 16;
        TS_SECT_BEGIN(C, 1);
        const int nt = 4 * qblk + 4;
        const int tq = 256 * qblk + 32 * wid + r; const size_t row = (size_t)b * SEQ + tq;
        bf16x8 qf[4];
#pragma unroll
        for (int d0 = 0; d0 < 4; ++d0) qf[d0] = *(const bf16x8*)(QKV + hm(hd, b) + (size_t)tq * 64 + d0 * 16 + h2 * 8);
        const bf16* kbase = QKV + hm(16 + hd, b) + (size_t)(8 * wid + (lane >> 3)) * 64 + (((lane & 7) ^ ((lane >> 3) & 7)) * 8);
        const bf16* vbase = QKV + hm(32 + hd, b) + (size_t)(16 * (wid & 3) + (lane >> 2)) * 64 + (wid >> 2) * 32 + (lane & 3) * 8;
        { const unsigned ldsK = (unsigned)(size_t)C.lds, ldsV = ldsK + 2 * 3 * fa::KSLOT;
#pragma unroll
          for (int t_ = 0; t_ < 3; ++t_) { fa::glds16(kbase + (size_t)(nt - 1 - t_) * 4096, (unsigned)__builtin_amdgcn_readfirstlane(ldsK + t_ * fa::KSLOT + wid * 1024));
              fa::glds16(vbase + (size_t)(nt - 1 - t_) * 4096, (unsigned)__builtin_amdgcn_readfirstlane(ldsV + t_ * 8192 + wid * 1024)); } }
        { const float bfv = inp(C, I_FOX_BF)[hd]; const int t0 = 8 * C.tid; const bool on = t0 < 64 * nt;
          float ls[8]; float run = 0.f; float fl[8];
          { const float* fp = FLOG + ((size_t)b * 16 + hd) * SEQ + (on ? t0 : 0); const f32x4 fa_ = *(const f32x4*)fp, fb_ = *(const f32x4*)(fp + 4);
            fl[0] = fa_.x; fl[1] = fa_.y; fl[2] = fa_.z; fl[3] = fa_.w; fl[4] = fb_.x; fl[5] = fb_.y; fl[6] = fb_.z; fl[7] = fb_.w; }
#pragma unroll
          for (int e = 0; e < 8; ++e) { ls[e] = on ? log_sigmoid_fast(fl[e] + bfv) : 0.f; run += ls[e]; ls[e] = run; }
          float inc = run;
#pragma unroll
          for (int of = 1; of < 64; of <<= 1) { const float v = __shfl_up(inc, of); if (lane >= of) inc += v; }
          LAS float* wtot = cumL + 4096;
          if (lane == 63) wtot[wid] = inc;
          asm volatile("s_waitcnt lgkmcnt(0)" ::: "memory"); __builtin_amdgcn_s_barrier();
          float base = inc - run;
#pragma unroll
          for (int w = 0; w < 8; ++w) base += (w < wid) ? wtot[w] : 0.f;
          if (on) { *(LAS f32x4*)(cumL + t0) = (f32x4){(base + ls[0]) * LOG2E, (base + ls[1]) * LOG2E, (base + ls[2]) * LOG2E, (base + ls[3]) * LOG2E};
                    *(LAS f32x4*)(cumL + t0 + 4) = (f32x4){(base + ls[4]) * LOG2E, (base + ls[5]) * LOG2E, (base + ls[6]) * LOG2E, (base + ls[7]) * LOG2E}; } }
        const int jdiag = 4 * qblk + (wid >> 1), qloc = 32 * (wid & 1) + r;
        f32x16 o[2]; float m = 0.f, l = 0.f;
#pragma unroll
        for (int i = 0; i < 16; ++i) { o[0][i] = 0.f; o[1][i] = 0.f; }
        asm volatile("s_waitcnt lgkmcnt(0)" ::: "memory"); __builtin_amdgcn_s_barrier();
        const float cq = cumL[tq];
        int jlo; { const float c0 = cumL[256 * qblk]; const int jj = lane < nt - 1 ? lane : nt - 1; const unsigned long long keep = __ballot(lane >= nt - 1 || !(c0 - cumL[64 * jj + 63] < skip_thr));
                   jlo = __builtin_amdgcn_readfirstlane(__builtin_ctzll(keep)); }
        TS_SECT_END(C, 1); TS_SECT_BEGIN(C, 2);
        fa5::loop<64, 3, NOMAX>((LAS char*)C.lds, wid, lane, qf, nt - jlo,
            [&](int i) { return kbase + (size_t)(nt - 1 - i) * 4096; },
            [&](int i, int) { return vbase + (size_t)(nt - 1 - i) * 4096; },
            [&](int i) { return (nt - 1 - i) <= jdiag; },
            [&](int i, f32x16& p0, f32x16& p1) { const int j = nt - 1 - i; const LAS float* cl = cumL + 64 * j + 4 * h2;
#pragma unroll
                for (int g4 = 0; g4 < 4; ++g4) { const f32x4 c0 = *(const LAS f32x4*)(cl + 8 * g4), c1 = *(const LAS f32x4*)(cl + 32 + 8 * g4);
                    p0[4 * g4] -= c0.x; p0[4 * g4 + 1] -= c0.y; p0[4 * g4 + 2] -= c0.z; p0[4 * g4 + 3] -= c0.w;
                    p1[4 * g4] -= c1.x; p1[4 * g4 + 1] -= c1.y; p1[4 * g4 + 2] -= c1.z; p1[4 * g4 + 3] -= c1.w; }
                if (j == jdiag) { int ql = qloc; asm volatile("" : "+v"(ql));
#pragma unroll
                    for (int ii = 0; ii < 16; ++ii) { const int kv = fa::crow(ii, h2); if (kv > ql) p0[ii] = -INFINITY; if (kv + 32 > ql) p1[ii] = -INFINITY; } } },
            o, m, l, cq, true);
        TS_SECT_END(C, 2); TS_SECT_BEGIN(C, 3);
        l = fa::xsum32(l);
        fa::store_o64_st((LAS char*)C.lds + wid * 4096, O + (row - r) * DM + hd * 64, DM, lane, o[0], o[1], 1.0f / l);
        TS_SECT_END(C, 3);
    }
}
DI float score_bound(const float* gq, const float* gk, int lane) { return 64.0f * wave_max(fabsf(gq[lane])) * wave_max(fabsf(gk[lane])) * QSC * 1.05f; }
constexpr float NOMAX_BOUND = 60.0f;
DI void attn_fox_fast(Ctx& C) {
    const float B2 = score_bound(inp(C, I_FOX_QG), inp(C, I_FOX_KG), C.lane);
    if (B2 <= NOMAX_BOUND) attn_fox_impl<true>(C, B2); else attn_fox_impl<false>(C, B2);
}
namespace fa6 {
#define FA6_SBAR() __builtin_amdgcn_sched_barrier(0)
#define FA6_PIN(x) asm volatile("" : "+v"(x))
#define FA6_MFMA(a, b, c) __builtin_amdgcn_mfma_f32_32x32x16_bf16(a, b, c, 0, 0, 0)
DI void wait_bar(int n) { if (n >= 3) { FA_WAIT_BAR(3); } else if (n == 2) { FA_WAIT_BAR(2); } else if (n == 1) { FA_WAIT_BAR(1); } else { FA_WAIT_BAR(0); } }
DI void kload2(bf16x8* kf, LAS const char* kp, int d0) { kf[2 * d0] = *(LAS const bf16x8*)(kp + d0 * 256); kf[2 * d0 + 1] = *(LAS const bf16x8*)(kp + d0 * 256 + 4096); }
DI size_t koff(int wid, int lane) { return (size_t)(8 * wid + (lane & 7)) * 64 + (size_t)(((lane >> 3) ^ (wid & 1)) * 8); }
DI void mask_causal(f32x16& p0, f32x16& p1, int ql, int h) {
#pragma unroll
    for (int ii = 0; ii < 16; ++ii) { const int kv = fa::crow(ii, h); if (kv > ql) p0[ii] = -INFINITY; if (kv + 32 > ql) p1[ii] = -INFINITY; } }
DI void mask_lower(f32x16& p0, f32x16& p1, int ql, int h) {
#pragma unroll
    for (int ii = 0; ii < 16; ++ii) { const int kv = fa::crow(ii, h); if (kv <= ql) p0[ii] = -INFINITY; if (kv + 32 <= ql) p1[ii] = -INFINITY; } }
template <bool MASKED, class KP, class VP, class KEEP>
DI void run(LAS char* lds, int wid, int lane, const bf16x8 (&qf)[4], int NT, KP kptr, VP vptr, KEEP keep, bool lowfirst, bool causlast, int ql_in, f32x16 (&o)[2], float& l_out, bool pre0 = false) {
    const int r32 = lane & 31, h = lane >> 5; int ql = ql_in; asm volatile("" : "+v"(ql));
    const unsigned lds0 = (unsigned)(size_t)lds; const unsigned kdst = lds0 + wid * 1024, vdst = lds0 + fa::KRING + wid * 1024;
    LAS const char* kp0 = (LAS const char*)lds + (r32 >> 3) * 1024 + ((h ^ ((r32 >> 3) & 1)) * 128) + (r32 & 7) * 16;
    LAS const char* vp0 = (LAS const char*)lds + fa::KRING + ((lane >> 4) & 1) * 32 + (lane & 3) * 8 + (4 * h + ((lane & 15) >> 2)) * 64;
#define FA6_DMA_K(t, slot) fa::glds16(kptr(t), (unsigned)__builtin_amdgcn_readfirstlane(kdst + (slot)))
#define FA6_DMA_V(t, slot) fa::glds16(vptr(t), (unsigned)__builtin_amdgcn_readfirstlane(vdst + (slot)))
    constexpr int SLOTB = fa::KSLOT;
    if (!pre0) { FA6_DMA_K(0, 0); FA6_DMA_V(0, 0); } if (NT > 1) FA6_DMA_K(1, SLOTB); if (NT > 2) FA6_DMA_K(2, 2 * SLOTB);
    float l_reg = 0.f;
    const f32x16 cin = {0.f, 0.f, 0.f, 0.f, 0.f, 0.f, 0.f, 0.f, 0.f, 0.f, 0.f, 0.f, 0.f, 0.f, 0.f, 0.f};
    unsigned mprev = 0xffffffffu;
    f32x16 pA0, pA1, pB0, pB1; bf16x8 kf[8]; s16x4 vlo[8], vhi[8]; v4u pw0, pw1, pw2, pw3;
    int sl_prev = 0, sl_cur = 0, sl_next = SLOTB;
#define FA6_ROT() do { sl_prev = sl_cur; sl_cur = sl_next; sl_next = (sl_next == 2 * SLOTB) ? 0 : sl_next + SLOTB; } while (0)
#define FA6_MK(x) (MASKED ? ((x) & mprev) : (x))
    wait_bar(1 + (NT > 1 ? 1 : 0) + (NT > 2 ? 1 : 0));
    if (MASKED) mprev = keep(0) ? 0xffffffffu : 0u;
#pragma unroll
    for (int d0 = 0; d0 < 4; ++d0) kload2(kf, kp0, d0);
    pA0 = FA6_MFMA(kf[0], qf[0], cin); pA1 = FA6_MFMA(kf[1], qf[0], cin); pA0 = FA6_MFMA(kf[2], qf[1], pA0); pA1 = FA6_MFMA(kf[3], qf[1], pA1);
    pA0 = FA6_MFMA(kf[4], qf[2], pA0); pA1 = FA6_MFMA(kf[5], qf[2], pA1); pA0 = FA6_MFMA(kf[6], qf[3], pA0); pA1 = FA6_MFMA(kf[7], qf[3], pA1);
    if (lowfirst) { int q2 = ql, h2 = h; asm volatile("" : "+v"(q2), "+v"(h2)); mask_lower(pA0, pA1, q2, h2); }
    if (causlast && NT == 1) { int q2 = ql, h2 = h; asm volatile("" : "+v"(q2), "+v"(h2)); mask_causal(pA0, pA1, q2, h2); }
#pragma unroll
    for (int r = 0; r < 16; ++r) { pA0[r] = __builtin_amdgcn_exp2f(pA0[r]); pA1[r] = __builtin_amdgcn_exp2f(pA1[r]); }
    wait_bar(0);
    if (NT > 3) FA6_DMA_K(3, 0);
    if (NT > 1) FA6_DMA_V(1, SLOTB);
    FA6_ROT();
#pragma unroll
    for (int d0 = 0; d0 < 4; ++d0) kload2(kf, kp0 + sl_cur, d0);
    wait_bar((NT > 3 ? 1 : 0) + (NT > 1 ? 1 : 0));
#define FA6_PKW(P, i) FA6_MK(fa::cvtpk(P[i], P[i + 1]))
#define FA6_PAF(k) __builtin_bit_cast(bf16x8, pw##k)
#define FA6_VFR(i) (bf16x8){vlo[i][0], vlo[i][1], vlo[i][2], vlo[i][3], vhi[i][0], vhi[i][1], vhi[i][2], vhi[i][3]}
#define FA6_VRD(i) do { vlo[i] = fa::vtr(vp_ + (((i) >> 2) * 4096 + ((i) & 3) * 1024)); vhi[i] = fa::vtr(vp_ + (((i) >> 2) * 4096 + ((i) & 3) * 1024 + 512)); } while (0)
#define FA6_KRD(d0) do { kload2(kf, kp0 + sl_next, d0); FA6_SBAR(); } while (0)
#define FA6_GAPA(MF, a0, a1, a2, a3, W0, W1, PW) do { MF; sacc += a0; sacc += a1; sacc += a2; sacc += a3; W0; W1; FA6_PIN(PW); FA6_PIN(sacc); FA6_SBAR(); } while (0)
#define FA6_GAPB(MF, X, i) do { MF; X[i] = __builtin_amdgcn_exp2f(X[i]); X[i + 1] = __builtin_amdgcn_exp2f(X[i + 1]); X[i + 2] = __builtin_amdgcn_exp2f(X[i + 2]); X[i + 3] = __builtin_amdgcn_exp2f(X[i + 3]); FA6_PIN(X); FA6_SBAR(); } while (0)
#define FA6_STEP(C0, C1, P0, P1, t) do { const int t_ = (t); const bool gk_ = t_ + 3 < NT, gv_ = t_ + 1 < NT; \
    FA6_SBAR(); \
    LAS const char* vp_ = vp0 + sl_prev; \
    FA6_VRD(0); FA6_SBAR(); float sacc = P0[0] + P0[1]; \
                            FA6_GAPA(C0 = FA6_MFMA(kf[0], qf[0], cin), P0[2], P0[3], P0[4], P0[5],     pw0[0] = FA6_PKW(P0, 0),  pw0[1] = FA6_PKW(P0, 2),  pw0); \
    FA6_VRD(4); FA6_SBAR(); FA6_GAPA(C1 = FA6_MFMA(kf[1], qf[0], cin), P0[6], P0[7], P0[8], P0[9],     pw0[2] = FA6_PKW(P0, 4),  pw0[3] = FA6_PKW(P0, 6),  pw0); \
    FA6_VRD(1); FA6_SBAR(); FA6_GAPA(C0 = FA6_MFMA(kf[2], qf[1], C0),  P0[10], P0[11], P0[12], P0[13], pw1[0] = FA6_PKW(P0, 8),  pw1[1] = FA6_PKW(P0, 10), pw1); \
    FA6_VRD(5); FA6_SBAR(); FA6_GAPA(C1 = FA6_MFMA(kf[3], qf[1], C1),  P0[14], P0[15], P1[0], P1[1],   pw1[2] = FA6_PKW(P0, 12), pw1[3] = FA6_PKW(P0, 14), pw1); \
    FA6_VRD(2); FA6_SBAR(); FA6_GAPA(C0 = FA6_MFMA(kf[4], qf[2], C0),  P1[2], P1[3], P1[4], P1[5],     pw2[0] = FA6_PKW(P1, 0),  pw2[1] = FA6_PKW(P1, 2),  pw2); \
    FA6_VRD(6); FA6_SBAR(); FA6_GAPA(C1 = FA6_MFMA(kf[5], qf[2], C1),  P1[6], P1[7], P1[8], P1[9],     pw2[2] = FA6_PKW(P1, 4),  pw2[3] = FA6_PKW(P1, 6),  pw2); \
    FA6_VRD(3); FA6_SBAR(); FA6_GAPA(C0 = FA6_MFMA(kf[6], qf[3], C0),  P1[10], P1[11], P1[12], P1[13], pw3[0] = FA6_PKW(P1, 8),  pw3[1] = FA6_PKW(P1, 10), pw3); \
    FA6_VRD(7); FA6_SBAR(); FA6_GAPA(C1 = FA6_MFMA(kf[7], qf[3], C1),  P1[14], P1[15], 0.f, 0.f,       pw3[2] = FA6_PKW(P1, 12), pw3[3] = FA6_PKW(P1, 14), pw3); \
    l_reg += MASKED ? __builtin_bit_cast(float, __builtin_bit_cast(unsigned, sacc) & mprev) : sacc; \
    if (MASKED) mprev = keep(t_) ? 0xffffffffu : 0u; \
    if (gk_) FA6_DMA_K(t_ + 3, sl_cur); \
    if (gv_) FA6_DMA_V(t_ + 1, sl_next); \
    if (causlast && t_ == NT - 1) { int q2 = ql, h2 = h; asm volatile("" : "+v"(q2), "+v"(h2)); mask_causal(C0, C1, q2, h2); }     \
    FA6_SBAR(); \
    FA6_GAPB(o[0] = FA6_MFMA(FA6_VFR(0), FA6_PAF(0), o[0]), C0, 0);                FA6_GAPB(o[1] = FA6_MFMA(FA6_VFR(4), FA6_PAF(0), o[1]), C0, 4); \
    FA6_KRD(0); FA6_GAPB(o[0] = FA6_MFMA(FA6_VFR(1), FA6_PAF(1), o[0]), C0, 8);    FA6_KRD(1); FA6_GAPB(o[1] = FA6_MFMA(FA6_VFR(5), FA6_PAF(1), o[1]), C0, 12); \
    FA6_KRD(2); FA6_GAPB(o[0] = FA6_MFMA(FA6_VFR(2), FA6_PAF(2), o[0]), C1, 0);    FA6_KRD(3); FA6_GAPB(o[1] = FA6_MFMA(FA6_VFR(6), FA6_PAF(2), o[1]), C1, 4); \
    FA6_GAPB(o[0] = FA6_MFMA(FA6_VFR(3), FA6_PAF(3), o[0]), C1, 8);                FA6_GAPB(o[1] = FA6_MFMA(FA6_VFR(7), FA6_PAF(3), o[1]), C1, 12); \
    wait_bar((gk_ ? 1 : 0) + (gv_ ? 1 : 0)); FA6_ROT(); } while (0)
#define FA6_DRAIN(P0, P1) do { float sacc = P0[0] + P0[1]; \
    _Pragma("unroll") for (int r = 2; r < 16; ++r) sacc += P0[r]; \
    _Pragma("unroll") for (int r = 0; r < 16; ++r) sacc += P1[r]; \
    l_reg += MASKED ? __builtin_bit_cast(float, __builtin_bit_cast(unsigned, sacc) & mprev) : sacc; \
    pw0 = (v4u){FA6_PKW(P0, 0), FA6_PKW(P0, 2), FA6_PKW(P0, 4), FA6_PKW(P0, 6)}; pw1 = (v4u){FA6_PKW(P0, 8), FA6_PKW(P0, 10), FA6_PKW(P0, 12), FA6_PKW(P0, 14)}; \
    pw2 = (v4u){FA6_PKW(P1, 0), FA6_PKW(P1, 2), FA6_PKW(P1, 4), FA6_PKW(P1, 6)}; pw3 = (v4u){FA6_PKW(P1, 8), FA6_PKW(P1, 10), FA6_PKW(P1, 12), FA6_PKW(P1, 14)}; \
    LAS const char* vp_ = vp0 + sl_prev; _Pragma("unroll") for (int i = 0; i < 8; ++i) FA6_VRD(i); \
    o[0] = FA6_MFMA(FA6_VFR(0), FA6_PAF(0), o[0]); o[1] = FA6_MFMA(FA6_VFR(4), FA6_PAF(0), o[1]); o[0] = FA6_MFMA(FA6_VFR(1), FA6_PAF(1), o[0]); o[1] = FA6_MFMA(FA6_VFR(5), FA6_PAF(1), o[1]); \
    o[0] = FA6_MFMA(FA6_VFR(2), FA6_PAF(2), o[0]); o[1] = FA6_MFMA(FA6_VFR(6), FA6_PAF(2), o[1]); o[0] = FA6_MFMA(FA6_VFR(3), FA6_PAF(3), o[0]); o[1] = FA6_MFMA(FA6_VFR(7), FA6_PAF(3), o[1]); } while (0)
    for (int t = 1; t < NT; t += 2) {
        FA6_STEP(pB0, pB1, pA0, pA1, t);
        if (t + 1 < NT) { FA6_STEP(pA0, pA1, pB0, pB1, t + 1); }
        else { pA0 = pB0; pA1 = pB1; }
    }
    FA6_DRAIN(pA0, pA1);
    l_out = l_reg;
    asm volatile("s_waitcnt lgkmcnt(0)\n\ts_barrier" ::: "memory");
#undef FA6_DMA_K
#undef FA6_DMA_V
#undef FA6_ROT
#undef FA6_MK
#undef FA6_PKW
#undef FA6_PAF
#undef FA6_VFR
#undef FA6_VRD
#undef FA6_KRD
#undef FA6_GAPA
#undef FA6_GAPB
#undef FA6_STEP
#undef FA6_DRAIN
}
}
namespace fa7 {
DI void wait_bar(int n) { if (n >= 4) { FA_WAIT_BAR(4); } else if (n == 3) { FA_WAIT_BAR(3); } else if (n == 2) { FA_WAIT_BAR(2); } else if (n == 1) { FA_WAIT_BAR(1); } else { FA_WAIT_BAR(0); } }
template <class KP, class VP>
DI void run(LAS char* lds, int wid, int lane, const bf16x8 (&qf)[4], int NT, int NTW, KP kptr, VP vptr, int ql_in, f32x16 (&o)[4], float& l_out) {
    const int r32 = lane & 31, h = lane >> 5; int ql = ql_in; asm volatile("" : "+v"(ql));
    const unsigned lds0 = (unsigned)(size_t)lds; const unsigned kdst = lds0 + wid * 1024, vdst = lds0 + fa::KRING + wid * 1024;
    LAS const char* kp0 = (LAS const char*)lds + (r32 >> 3) * 1024 + ((h ^ ((r32 >> 3) & 1)) * 128) + (r32 & 7) * 16;
    LAS const char* vp0 = (LAS const char*)lds + fa::KRING + ((lane >> 4) & 1) * 32 + (lane & 3) * 8 + (4 * h + ((lane & 15) >> 2)) * 64;
#define FA7_DMA_K(t, slot) fa::glds16(kptr(t), (unsigned)__builtin_amdgcn_readfirstlane(kdst + (slot)))
#define FA7_DMA_V(t, slot) do { fa::glds16(vptr(t, 0), (unsigned)__builtin_amdgcn_readfirstlane(vdst + 2 * (slot))); fa::glds16(vptr(t, 1), (unsigned)__builtin_amdgcn_readfirstlane(vdst + 2 * (slot) + 8192)); } while (0)
    constexpr int SLOTB = fa::KSLOT;
    FA7_DMA_K(0, 0); FA7_DMA_V(0, 0); if (NT > 1) FA7_DMA_K(1, SLOTB); if (NT > 2) FA7_DMA_K(2, 2 * SLOTB);
    float l_reg = 0.f;
    const f32x16 cin = {0.f, 0.f, 0.f, 0.f, 0.f, 0.f, 0.f, 0.f, 0.f, 0.f, 0.f, 0.f, 0.f, 0.f, 0.f, 0.f};
    f32x16 pA0, pA1, pB0, pB1; bf16x8 kf[8]; s16x4 vlo[4], vhi[4]; v4u pw[4];
    int sl_prev = 0, sl_cur = 0, sl_next = SLOTB;
#define FA7_ROT() do { sl_prev = sl_cur; sl_cur = sl_next; sl_next = (sl_next == 2 * SLOTB) ? 0 : sl_next + SLOTB; } while (0)
    wait_bar(2 + (NT > 1 ? 1 : 0) + (NT > 2 ? 1 : 0));
#pragma unroll
    for (int d0 = 0; d0 < 4; ++d0) fa6::kload2(kf, kp0, d0);
    pA0 = FA6_MFMA(kf[0], qf[0], cin); pA1 = FA6_MFMA(kf[1], qf[0], cin); pA0 = FA6_MFMA(kf[2], qf[1], pA0); pA1 = FA6_MFMA(kf[3], qf[1], pA1);
    pA0 = FA6_MFMA(kf[4], qf[2], pA0); pA1 = FA6_MFMA(kf[5], qf[2], pA1); pA0 = FA6_MFMA(kf[6], qf[3], pA0); pA1 = FA6_MFMA(kf[7], qf[3], pA1);
    if (NTW == 1) { int q2 = ql, h2 = h; asm volatile("" : "+v"(q2), "+v"(h2)); fa6::mask_causal(pA0, pA1, q2, h2); }
#pragma unroll
    for (int r = 0; r < 16; ++r) { pA0[r] = __builtin_amdgcn_exp2f(pA0[r]); pA1[r] = __builtin_amdgcn_exp2f(pA1[r]); }
    wait_bar(0);
    if (NT > 3) FA7_DMA_K(3, 0);
    if (NT > 1) FA7_DMA_V(1, SLOTB);
    FA7_ROT();
#pragma unroll
    for (int d0 = 0; d0 < 4; ++d0) fa6::kload2(kf, kp0 + sl_cur, d0);
    wait_bar((NT > 3 ? 1 : 0) + (NT > 1 ? 2 : 0));
#define FA7_PKW(P, i) fa::cvtpk(P[i], P[i + 1])
#define FA7_PAF(k) __builtin_bit_cast(bf16x8, pw[k])
#define FA7_VFR(s) (bf16x8){vlo[s][0], vlo[s][1], vlo[s][2], vlo[s][3], vhi[s][0], vhi[s][1], vhi[s][2], vhi[s][3]}
#define FA7_VRD(s, i) do { vlo[s] = fa::vtr(vp_ + (i) * 1024); vhi[s] = fa::vtr(vp_ + (i) * 1024 + 512); } while (0)
#define FA7_GAPA(MF, a0, a1, a2, a3, W0, W1, PW) do { MF; sacc += a0; sacc += a1; sacc += a2; sacc += a3; W0; W1; FA6_PIN(PW); FA6_PIN(sacc); FA6_SBAR(); } while (0)
#define FA7_STEP(C0, C1, P0, P1, t) do { const int t_ = (t); const bool gk_ = t_ + 3 < NT, gv_ = t_ + 1 < NT; \
    FA6_SBAR(); \
    LAS const char* vp_ = vp0 + 2 * sl_prev; \
    float sacc = P0[0] + P0[1]; \
                                FA7_GAPA(C0 = FA6_MFMA(kf[0], qf[0], cin), P0[2], P0[3], P0[4], P0[5],     pw[0][0] = FA7_PKW(P0, 0),  pw[0][1] = FA7_PKW(P0, 2),  pw[0]); \
                                FA7_GAPA(C1 = FA6_MFMA(kf[1], qf[0], cin), P0[6], P0[7], P0[8], P0[9],     pw[0][2] = FA7_PKW(P0, 4),  pw[0][3] = FA7_PKW(P0, 6),  pw[0]); \
                                FA7_GAPA(C0 = FA6_MFMA(kf[2], qf[1], C0),  P0[10], P0[11], P0[12], P0[13], pw[1][0] = FA7_PKW(P0, 8),  pw[1][1] = FA7_PKW(P0, 10), pw[1]); \
                                FA7_GAPA(C1 = FA6_MFMA(kf[3], qf[1], C1),  P0[14], P0[15], P1[0], P1[1],   pw[1][2] = FA7_PKW(P0, 12), pw[1][3] = FA7_PKW(P0, 14), pw[1]); \
    FA7_VRD(0, 0);  FA6_SBAR(); FA7_GAPA(C0 = FA6_MFMA(kf[4], qf[2], C0),  P1[2], P1[3], P1[4], P1[5],     pw[2][0] = FA7_PKW(P1, 0),  pw[2][1] = FA7_PKW(P1, 2),  pw[2]); \
    FA7_VRD(1, 4);  FA6_SBAR(); FA7_GAPA(C1 = FA6_MFMA(kf[5], qf[2], C1),  P1[6], P1[7], P1[8], P1[9],     pw[2][2] = FA7_PKW(P1, 4),  pw[2][3] = FA7_PKW(P1, 6),  pw[2]); \
    FA7_VRD(2, 8);  FA6_SBAR(); FA7_GAPA(C0 = FA6_MFMA(kf[6], qf[3], C0),  P1[10], P1[11], P1[12], P1[13], pw[3][0] = FA7_PKW(P1, 8),  pw[3][1] = FA7_PKW(P1, 10), pw[3]); \
    FA7_VRD(3, 12); FA6_SBAR(); FA7_GAPA(C1 = FA6_MFMA(kf[7], qf[3], C1),  P1[14], P1[15], 0.f, 0.f,       pw[3][2] = FA7_PKW(P1, 12), pw[3][3] = FA7_PKW(P1, 14), pw[3]); \
    l_reg += sacc; \
    if (gk_) FA7_DMA_K(t_ + 3, sl_cur); \
    if (gv_) FA7_DMA_V(t_ + 1, sl_next); \
    if (t_ == NTW - 1) { int q2 = ql, h2 = h; asm volatile("" : "+v"(q2), "+v"(h2)); fa6::mask_causal(C0, C1, q2, h2); } \
    FA6_SBAR(); \
    _Pragma("unroll") for (int g_ = 0; g_ < 16; ++g_) { \
        if (g_ == 4 || g_ == 6 || g_ == 8 || g_ == 10) { fa6::kload2(kf, kp0 + sl_next, (g_ - 4) >> 1); FA6_SBAR(); } \
        o[g_ & 3] = FA6_MFMA(FA7_VFR(g_ & 3), FA7_PAF(g_ >> 2), o[g_ & 3]); \
        if (g_ < 8) { C0[2 * g_] = __builtin_amdgcn_exp2f(C0[2 * g_]); C0[2 * g_ + 1] = __builtin_amdgcn_exp2f(C0[2 * g_ + 1]); FA6_PIN(C0); } \
        else { C1[2 * g_ - 16] = __builtin_amdgcn_exp2f(C1[2 * g_ - 16]); C1[2 * g_ - 15] = __builtin_amdgcn_exp2f(C1[2 * g_ - 15]); FA6_PIN(C1); } \
        if (g_ + 4 < 16) FA7_VRD(g_ & 3, ((g_ + 4) & 3) * 4 + ((g_ + 4) >> 2)); \
        FA6_SBAR(); } \
    wait_bar((gk_ ? 1 : 0) + (gv_ ? 2 : 0)); FA7_ROT(); } while (0)
#define FA7_DRAIN(P0, P1) do { float sacc = P0[0] + P0[1]; \
    _Pragma("unroll") for (int r = 2; r < 16; ++r) sacc += P0[r]; \
    _Pragma("unroll") for (int r = 0; r < 16; ++r) sacc += P1[r]; \
    l_reg += sacc; \
    pw[0] = (v4u){FA7_PKW(P0, 0), FA7_PKW(P0, 2), FA7_PKW(P0, 4), FA7_PKW(P0, 6)}; pw[1] = (v4u){FA7_PKW(P0, 8), FA7_PKW(P0, 10), FA7_PKW(P0, 12), FA7_PKW(P0, 14)}; \
    pw[2] = (v4u){FA7_PKW(P1, 0), FA7_PKW(P1, 2), FA7_PKW(P1, 4), FA7_PKW(P1, 6)}; pw[3] = (v4u){FA7_PKW(P1, 8), FA7_PKW(P1, 10), FA7_PKW(P1, 12), FA7_PKW(P1, 14)}; \
    LAS const char* vp_ = vp0 + 2 * sl_prev; \
    _Pragma("unroll") for (int kq_ = 0; kq_ < 4; ++kq_) { _Pragma("unroll") for (int b_ = 0; b_ < 4; ++b_) FA7_VRD(b_, b_ * 4 + kq_); \
        _Pragma("unroll") for (int b_ = 0; b_ < 4; ++b_) o[b_] = FA6_MFMA(FA7_VFR(b_), FA7_PAF(kq_), o[b_]); } } while (0)
#define FA7_IDLE(t) do { const int t_ = (t); const bool gk_ = t_ + 3 < NT, gv_ = t_ + 1 < NT; \
    if (gk_) FA7_DMA_K(t_ + 3, sl_cur); \
    if (gv_) FA7_DMA_V(t_ + 1, sl_next); \
    wait_bar((gk_ ? 1 : 0) + (gv_ ? 2 : 0)); FA7_ROT(); } while (0)
    int t = 1;
    for (; t < NTW; t += 2) {
        FA7_STEP(pB0, pB1, pA0, pA1, t);
        if (t + 1 < NTW) { FA7_STEP(pA0, pA1, pB0, pB1, t + 1); }
        else { pA0 = pB0; pA1 = pB1; }
    }
    FA7_DRAIN(pA0, pA1);
    for (t = NTW; t < NT; ++t) FA7_IDLE(t);
    l_out = l_reg;
    asm volatile("s_waitcnt lgkmcnt(0)\n\ts_barrier" ::: "memory");
#undef FA7_DMA_K
#undef FA7_DMA_V
#undef FA7_ROT
#undef FA7_PKW
#undef FA7_PAF
#undef FA7_VFR
#undef FA7_VRD
#undef FA7_GAPA
#undef FA7_STEP
#undef FA7_DRAIN
#undef FA7_IDLE
}
}
template <bool NOMAX> DI void attn_diff_impl(Ctx& C) {
    if (C.wave >= 4) __builtin_amdgcn_s_setprio(1);
    const int vblk = (C.blk % 8) * (C.G / 8) + C.blk / 8;
    const bf16* QKV = (const bf16*)(C.ws + WS_R1); bf16* O = (bf16*)(C.ws + WS_UO);
    const int wid = C.wave;
    const float lam_init = 0.8f - 0.6f * expf(-0.3f * 3.0f);
    const float* lm = inp(C, I_DIFF_LAM);
    const float lam = expf(wave_sum(lm[C.lane] * lm[64 + C.lane])) - expf(wave_sum(lm[128 + C.lane] * lm[192 + C.lane])) + lam_init;
    const float* sg = inp(C, I_DIFF_SG);
    const int nunits = BATCH * 8 * 16, per = (nunits + C.G - 1) / C.G;
    for (int ui = 0; ui < per; ++ui) {
        const int u = vblk * per + ui; if (u >= nunits) break;
        int lane = C.lane; asm volatile("" : "+v"(lane)); const int r = lane & 31, h2 = lane >> 5;
        const int bh = u / 16, k16 = u % 16, pair = k16 >> 1, qblk = (k16 & 1) ? (15 - pair) : pair;
        const int b = bh / 8, hd = bh % 8;
        const int nt = 4 * qblk + 4;
        const int tq = 256 * qblk + 32 * wid + r; const size_t row = (size_t)b * SEQ + tq;
        const bf16* vbase = QKV + hm(32 + 2 * hd, b) + (size_t)(16 * (wid & 3) + (lane >> 2)) * 64 + (wid >> 2) * 32 + (lane & 3) * 8;
        const int jdiag = 4 * qblk + (wid >> 1), qloc = 32 * (wid & 1) + r;
        bf16* op = O + row * DM + hd * 128;
        bf16* op0 = O + (row - r) * DM + hd * 128; LAS char* stg = (LAS char*)C.lds + 98304 + wid * 4096;
#pragma unroll
        for (int c = 0; c < 2; ++c) {
            const int hh = 2 * hd + c;
            bf16x8 qf[4];
#pragma unroll
            for (int d0 = 0; d0 < 4; ++d0) qf[d0] = *(const bf16x8*)(QKV + hm(hh, b) + (size_t)tq * 64 + d0 * 16 + h2 * 8);
            const bf16* kbase = QKV + hm(16 + hh, b) + (size_t)(8 * wid + (lane >> 3)) * 64 + (((lane & 7) ^ ((lane >> 3) & 7)) * 8);
            f32x16 o[4]; float m = 0.f, l = 0.f;
#pragma unroll
            for (int bq = 0; bq < 4; ++bq)
#pragma unroll
                for (int i = 0; i < 16; ++i) o[bq][i] = 0.f;
            if (NOMAX) {
                const bf16* kb6 = QKV + hm(16 + hh, b) + fa6::koff(wid, lane);
                fa7::run((LAS char*)C.lds, wid, lane, qf, nt, jdiag + 1,
                    [&](int i) { return kb6 + (size_t)i * 4096; },
                    [&](int i, int half) { return vbase + (size_t)i * 4096 + (half ? (size_t)BATCH * SEQ * 64 : (size_t)0); },
                    qloc, o, l);
            } else {
            fa5::loop<128, 2, NOMAX>((LAS char*)C.lds, wid, lane, qf, nt,
                [&](int i) { return kbase + (size_t)(nt - 1 - i) * 4096; },
                [&](int i, int pc) { return vbase + (size_t)(nt - 1 - i) * 4096 + (pc >= 8 ? (size_t)BATCH * SEQ * 64 : (size_t)0); },
                [&](int i) { return (nt - 1 - i) <= jdiag; },
                [&](int i, f32x16& p0, f32x16& p1) { const int j = nt - 1 - i;
                    if (j == jdiag) { int ql = qloc; asm volatile("" : "+v"(ql));
#pragma unroll
                        for (int ii = 0; ii < 16; ++ii) { const int kv = fa::crow(ii, h2); if (kv > ql) p0[ii] = -INFINITY; if (kv + 32 > ql) p1[ii] = -INFINITY; } } },
                o, m, l);
            }
            const float il = 1.0f / fa::xsum32(l);
            if (c == 0) { fa::store_o64_st(stg, op0, DM, lane, o[0], o[1], il); fa::store_o64_st(stg, op0 + 64, DM, lane, o[2], o[3], il); asm volatile("s_waitcnt vmcnt(0)" ::: "memory"); }
            else {
                const float sc = -lam * il; float ss = 0.f;
                v2u wp0[8], wp1[8]; fa::load_o64_st(stg, op0, DM, lane, wp0); fa::load_o64_st(stg, op0 + 64, DM, lane, wp1);
#pragma unroll
                for (int bq = 0; bq < 4; ++bq)
#pragma unroll
                    for (int g4 = 0; g4 < 4; ++g4) { const v2u w = (bq < 2) ? wp0[4 * (bq & 1) + g4] : wp1[4 * (bq & 1) + g4];
                        o[bq][4 * g4] = bflo(w.x) + sc * o[bq][4 * g4]; o[bq][4 * g4 + 1] = bfhi(w.x) + sc * o[bq][4 * g4 + 1]; o[bq][4 * g4 + 2] = bflo(w.y) + sc * o[bq][4 * g4 + 2]; o[bq][4 * g4 + 3] = bfhi(w.y) + sc * o[bq][4 * g4 + 3];
                        ss += (o[bq][4 * g4] * o[bq][4 * g4] + o[bq][4 * g4 + 1] * o[bq][4 * g4 + 1]) + (o[bq][4 * g4 + 2] * o[bq][4 * g4 + 2] + o[bq][4 * g4 + 3] * o[bq][4 * g4 + 3]); }
                ss = fa::xsum32(ss);
                const float rn = (1.0f - lam_init) / sqrtf(ss * (1.0f / 128.0f) + EPS);
#pragma unroll
                for (int bq = 0; bq < 4; ++bq)
#pragma unroll
                    for (int g4 = 0; g4 < 4; ++g4) { const f32x4 gn = *(const f32x4*)(sg + 32 * bq + 8 * g4 + 4 * h2);
                        o[bq][4 * g4] *= rn * gn.x; o[bq][4 * g4 + 1] *= rn * gn.y; o[bq][4 * g4 + 2] *= rn * gn.z; o[bq][4 * g4 + 3] *= rn * gn.w; }
                asm volatile("" ::: "memory");
                fa::store_o64_st(stg, op0, DM, lane, o[0], o[1], 1.0f); fa::store_o64_st(stg, op0 + 64, DM, lane, o[2], o[3], 1.0f);
            }
        }
    }
}
DI void attn_diff_fast(Ctx& C) {
    if (score_bound(inp(C, I_DIFF_QG), inp(C, I_DIFF_KG), C.lane) <= NOMAX_BOUND) attn_diff_impl<true>(C); else attn_diff_impl<false>(C);
}
struct DilUnit { const bf16* kb; const bf16* vb; int jlo, nt; };
DI DilUnit dil_unit(const bf16* QKV, int u, int nub, int dil, int lane, int wid) {
    const int bh = u / 16, k16 = u % 16, b = bh / 16, hd = bh % 16, res = k16 / nub, ublk = k16 % nub;
    const size_t p0 = (size_t)res * (SEQ / dil);
    DilUnit d;
    d.jlo = (4 * ublk - 2) > 0 ? (4 * ublk - 2) : 0; d.nt = 4 * ublk + 4 - d.jlo;
    d.kb = QKV + hm(16 + hd, b) + (p0 + (size_t)d.jlo * 64 + 8 * wid + (lane >> 3)) * 64 + (((lane & 7) ^ ((lane >> 3) & 7)) * 8);
    d.vb = QKV + hm(32 + hd, b) + (p0 + (size_t)d.jlo * 64 + 16 * (wid & 3) + (lane >> 2)) * 64 + (wid >> 2) * 32 + (lane & 3) * 8;
    return d;
}
template <bool NOMAX> DI void attn_dil_impl(Ctx& C, int gi, int dil) {
    if (C.wave >= 4) __builtin_amdgcn_s_setprio(1);
    const int vblk = (C.blk % 8) * (C.G / 8) + C.blk / 8;
    const bf16* QKV = (const bf16*)(C.ws + WS_R1); bf16* O = (bf16*)(C.ws + WS_O2); float* LSE = (float*)(C.ws + WS_LSE);
    const int wid = C.wave;
    const int nub = (SEQ / dil) / 256;
    const int nunits = BATCH * 16 * 16, per = (nunits + C.G - 1) / C.G;
    const size_t ts = 4096;
    bool pre_issued = false;
    bf16x8 qn[4] = {};
    for (int ui = 0; ui < per; ++ui) {
        const int u = vblk * per + ui; if (u >= nunits) break;
        int lane = C.lane; asm volatile("" : "+v"(lane)); const int r = lane & 31, h2 = lane >> 5;
        TS_SECT_BEGIN(C, 7);
        const int bh = u / 16, k16 = u % 16, b = bh / 16, hd = bh % 16, res = k16 / nub, ublk = k16 % nub;
        const int uq = 256 * ublk + 32 * wid + r; const size_t row = (size_t)b * SEQ + (size_t)uq * dil + res;
        bf16x8 qf[4];
        if (pre_issued) {
#pragma unroll
            for (int d0 = 0; d0 < 4; ++d0) qf[d0] = qn[d0]; }
        else {
#pragma unroll
            for (int d0 = 0; d0 < 4; ++d0) qf[d0] = *(const bf16x8*)(QKV + hm(hd, b) + ((size_t)res * (SEQ / dil) + uq) * 64 + d0 * 16 + h2 * 8); }
        bf16* op0 = O + (row - (size_t)r * dil) * DM + hd * 64; const size_t old_ld = (size_t)dil * DM; LAS char* stg = (LAS char*)C.lds + 98304 + wid * 4096;
        v4u oldraw[4] = {}; float lo_pre = 0.f;
        if (gi > 0) { fa::ld_o64_rows(op0, old_ld, lane, oldraw); lo_pre = LSE[row * 16 + hd]; }
        const DilUnit du = dil_unit(QKV, u, nub, dil, lane, wid);
        const bool has_next = (ui + 1 < per) && (u + 1 < nunits);
        const DilUnit dn = dil_unit(QKV, has_next ? u + 1 : u, nub, dil, lane, wid);
        const int jlo = du.jlo, nt = du.nt;
        const int jw_hi = 4 * ublk + (wid >> 1), jw_lo = jw_hi - 2;
        f32x16 o[2]; float m = 0.f, l = 0.f;
#pragma unroll
        for (int i = 0; i < 16; ++i) { o[0][i] = 0.f; o[1][i] = 0.f; }
        TS_SECT_END(C, 7); TS_SECT_BEGIN(C, 8);
        fa4::loop<NOMAX>((LAS char*)C.lds, wid, lane, qf, nt,
            [&](int i) { return du.kb + (size_t)i * ts; },
            [&](int i, int) { return du.vb + (size_t)i * ts; },
            [&](int i) { const int j = jlo + i; return j >= jw_lo && j <= jw_hi; },
            [&](int i, f32x16& p0, f32x16& p1) { const int j = jlo + i;
                if (j == jw_hi) { int dlt = uq - 64 * j; asm volatile("" : "+v"(dlt));
#pragma unroll
                    for (int ii = 0; ii < 16; ++ii) { const int kv = fa::crow(ii, h2); if (kv > dlt) p0[ii] = -INFINITY; if (kv + 32 > dlt) p1[ii] = -INFINITY; } }
                else if (j == jw_lo) { int dlt = uq - 64 * j - 128; asm volatile("" : "+v"(dlt));
#pragma unroll
                    for (int ii = 0; ii < 16; ++ii) { const int kv = fa::crow(ii, h2); if (kv < dlt) p0[ii] = -INFINITY; if (kv + 32 < dlt) p1[ii] = -INFINITY; } } },
            o, m, l, pre_issued,
            [&]() { if (has_next) fa4::issue_all((LAS char*)C.lds, wid, dn.nt, [&](int t) { return dn.kb + (size_t)t * ts; }, [&](int t, int) { return dn.vb + (size_t)t * ts; }); });
        TS_SECT_END(C, 8); TS_SECT_BEGIN(C, 9);
        pre_issued = has_next;
        if (has_next) { const int u2 = u + 1, bh2 = u2 / 16, k2 = u2 % 16, b2 = bh2 / 16, hd2 = bh2 % 16, res2 = k2 / nub, ub2 = k2 % nub; const int uq2 = 256 * ub2 + 32 * wid + r;
#pragma unroll
            for (int d0 = 0; d0 < 4; ++d0) qn[d0] = *(const bf16x8*)(QKV + hm(hd2, b2) + ((size_t)res2 * (SEQ / dil) + uq2) * 64 + d0 * 16 + h2 * 8); }
        l = fa::xsum32(l);
        const float inv = 1.0f / l, lse = m + log2f(l);
        if (gi == 0) { fa::store_o64_st(stg, op0, old_ld, lane, o[0], o[1], inv); if (h2 == 0) LSE[row * 16 + hd] = lse; }
        else {
            v2u wold[8]; fa::unstage_o64(stg, oldraw, lane, wold);
            const float lo = lo_pre, mx = fmaxf(lo, lse), ea = __builtin_amdgcn_exp2f(lo - mx), eb = __builtin_amdgcn_exp2f(lse - mx), rs2 = 1.0f / (ea + eb), fa_ = ea * rs2, fb = eb * rs2 * inv;
#pragma unroll
            for (int bq = 0; bq < 2; ++bq)
#pragma unroll
                for (int g4 = 0; g4 < 4; ++g4) { const v2u w = wold[4 * bq + g4];
                    o[bq][4 * g4] = bflo(w.x) * fa_ + o[bq][4 * g4] * fb; o[bq][4 * g4 + 1] = bfhi(w.x) * fa_ + o[bq][4 * g4 + 1] * fb;
                    o[bq][4 * g4 + 2] = bflo(w.y) * fa_ + o[bq][4 * g4 + 2] * fb; o[bq][4 * g4 + 3] = bfhi(w.y) * fa_ + o[bq][4 * g4 + 3] * fb; }
            asm volatile("" ::: "memory");
            fa::store_o64_st(stg, op0, old_ld, lane, o[0], o[1], 1.0f);
            if (h2 == 0) LSE[row * 16 + hd] = mx + log2f(ea + eb);
        }
        TS_SECT_END(C, 9);
    }
}
DI void attn_dil_fast(Ctx& C, int gi, int dil) {
    if (score_bound(inp(C, I_DIL_QG), inp(C, I_DIL_KG), C.lane) <= NOMAX_BOUND) attn_dil_impl<true>(C, gi, dil); else attn_dil_impl<false>(C, gi, dil);
}
constexpr size_t WS_USELM_ = 25 * MiB;
constexpr int NSA_P4_OFF = 49152, NSA_SELL_OFF = 114688, NSA_JL_OFF = 115200;
constexpr int NSA_KCBUF = 115712, NSA_VCBUF = 135168;
template <bool NOMAX> DI void attn_nsa_impl(Ctx& C, bool nomax_rt) {
    if (C.wave >= 4) __builtin_amdgcn_s_setprio(1);
    const int vblk = (C.blk % 8) * (C.G / 8) + C.blk / 8;
    const bf16* QKV = (const bf16*)(C.ws + WS_R1); bf16* O = (bf16*)(C.ws + WS_UO); const float* GATE = (const float*)(C.ws + WS_GATE);
    const bf16* KC = (const bf16*)(C.ws + WS_KC); const bf16* VC = (const bf16*)(C.ws + WS_VC);
    const int wid = C.wave;
    LAS float* P4 = (LAS float*)(C.lds + NSA_P4_OFF); LAS unsigned long long* SELL = (LAS unsigned long long*)(C.lds + NSA_SELL_OFF); LAS int* jl = (LAS int*)(C.lds + NSA_JL_OFF);
    const int nunits = BATCH * 4 * 64, per = (nunits + C.G - 1) / C.G;
    bf16x8 qn[4]; float gn0 = 0.f, gn1 = 0.f, gn2 = 0.f;
    auto ucoord = [&](int u, int& b, int& g, int& c) { const int bg = u / 64, k64 = u % 64, sub = k64 >> 3, i8 = k64 & 7; c = (i8 & 1) ? (16 * (i8 >> 1) + 15 - sub) : (16 * (i8 >> 1) + sub); b = bg / 4; g = bg % 4; };
    auto prefetch = [&](int u, int lane) { int b, g, c; ucoord(u, b, g, c); const int head = 4 * g + (wid >> 1), t = 64 * c + 32 * (wid & 1) + (lane & 31); const size_t row = (size_t)b * SEQ + t;
#pragma unroll
        for (int d0 = 0; d0 < 4; ++d0) qn[d0] = *(const bf16x8*)(QKV + hm(head, b) + (size_t)t * 64 + d0 * 16 + (lane >> 5) * 8);
        gn0 = GATE[row * 48 + head]; gn1 = GATE[row * 48 + 16 + head]; gn2 = GATE[row * 48 + 32 + head];
        const unsigned l0 = (unsigned)(size_t)C.lds; const int bg = u / 64;
        fa::glds16(KC + (size_t)bg * 4096 + (size_t)(8 * wid + (lane >> 3)) * 64 + (((lane & 7) ^ ((lane >> 3) & 7)) * 8), (unsigned)__builtin_amdgcn_readfirstlane(l0 + NSA_KCBUF + wid * 1024));
        fa::glds16(VC + (size_t)bg * 4096 + (16 * (wid & 3) + (lane >> 2)) * 64 + (wid >> 2) * 32 + (lane & 3) * 8, (unsigned)__builtin_amdgcn_readfirstlane(l0 + NSA_VCBUF + wid * 1024)); };
    if (vblk * per < nunits) prefetch(vblk * per, C.lane);
    for (int ui = 0; ui < per; ++ui) {
        const int u = vblk * per + ui; if (u >= nunits) break;
        int lane = C.lane; asm volatile("" : "+v"(lane));
        const int r = lane & 31, h2 = lane >> 5;
        int b, g, c; ucoord(u, b, g, c); const int bg = u / 64, hp = wid >> 1, head = 4 * g + hp;
        const int qloc = 32 * (wid & 1) + r, t = 64 * c + qloc; const size_t row = (size_t)b * SEQ + t;
        bf16x8 qf[4];
#pragma unroll
        for (int d0 = 0; d0 < 4; ++d0) qf[d0] = qn[d0];
        const float g0 = 1.0f / (1.0f + expf(-gn0)), g1s = 1.0f / (1.0f + expf(-gn1)), g2s = 1.0f / (1.0f + expf(-gn2));
        TS_SECT_BEGIN(C, 10);
        f32x16 oa[2];
        {
          if (ui == 0) { FA_WAIT_BAR(0); } else { FA_WAIT_BAR(4); }
          f32x16 p0, p1; fa::qk((LAS const char*)C.lds + NSA_KCBUF, qf, lane, p0, p1);
          const int nvalid = c + (qloc == 63 ? 1 : 0);
          float mx = -1e30f;
#pragma unroll
          for (int i = 0; i < 16; ++i) { const int kv = fa::crow(i, h2); if (kv >= nvalid) p0[i] = -INFINITY; if (kv + 32 >= nvalid) p1[i] = -INFINITY; mx = fmaxf(mx, fmaxf(p0[i], p1[i])); }
          mx = fa::xmax32(mx);
          float sum = 0.f;
#pragma unroll
          for (int i = 0; i < 16; ++i) { p0[i] = __builtin_amdgcn_exp2f(p0[i] - mx); p1[i] = __builtin_amdgcn_exp2f(p1[i] - mx); sum += p0[i] + p1[i]; }
          const float rden = 1.0f / fmaxf(fa::xsum32(sum), 1e-30f);
#pragma unroll
          for (int i = 0; i < 16; ++i) { p0[i] *= rden; p1[i] *= rden; }
          LAS float* pw = P4 + ((hp * 2 + (wid & 1)) * 64) * 32 + r;
#pragma unroll
          for (int i = 0; i < 16; ++i) { pw[fa::crow(i, h2) * 32] = p0[i]; pw[(fa::crow(i, h2) + 32) * 32] = p1[i]; }
#pragma unroll
          for (int i = 0; i < 16; ++i) { oa[0][i] = 0.f; oa[1][i] = 0.f; }
          fa::pv<64>((LAS const char*)C.lds + NSA_VCBUF, lane, p0, p1, oa);
#pragma unroll
          for (int i = 0; i < 16; ++i) { oa[0][i] *= g0; oa[1][i] *= g0; }
          FA_WAIT_BAR(0); }
        if (nomax_rt) { const unsigned l0 = (unsigned)(size_t)C.lds;
            fa::glds16(QKV + hm(24 + g, b) + fa6::koff(wid, lane), (unsigned)__builtin_amdgcn_readfirstlane(l0 + wid * 1024));
            fa::glds16(QKV + hm(28 + g, b) + (size_t)(16 * (wid & 3) + (lane >> 2)) * 64 + (wid >> 2) * 32 + (lane & 3) * 8, (unsigned)__builtin_amdgcn_readfirstlane(l0 + fa::KRING + wid * 1024)); }
        { int tid_ = C.tid; asm volatile("" : "+v"(tid_)); const int tt = tid_ >> 3, jseg = tid_ & 7; const LAS float* pb = P4 + ((tt >> 5) * 64) * 32 + (tt & 31);
          LAS unsigned* KEY = (LAS unsigned*)(C.lds + fa::KSLOT);
          unsigned own[8];
#pragma unroll
          for (int e = 0; e < 8; ++e) { const int jo = 8 * jseg + e; const float s = (pb[jo * 32] + pb[(128 + jo) * 32]) + (pb[(256 + jo) * 32] + pb[(384 + jo) * 32]);
              const float val = (jo == 0 || jo == c || jo == c - 1) ? 5.0f : s;
              own[e] = ((jo > c) ? 0u : (__builtin_bit_cast(unsigned, val) & ~63u)) | (unsigned)(63 - jo); }
          *(LAS v4u*)(KEY + tt * 64 + (((2 * jseg) ^ (tt & 15)) << 2)) = (v4u){own[0], own[1], own[2], own[3]};
          *(LAS v4u*)(KEY + tt * 64 + (((2 * jseg + 1) ^ (tt & 15)) << 2)) = (v4u){own[4], own[5], own[6], own[7]};
          asm volatile("s_waitcnt lgkmcnt(0)" ::: "memory"); __builtin_amdgcn_s_barrier();
          int rank[8];
#pragma unroll
          for (int e = 0; e < 8; ++e) rank[e] = 0;
#pragma unroll
          for (int k = 0; k < 16; ++k) { const v4u kv = *(const LAS v4u*)(KEY + tt * 64 + ((k ^ (tt & 15)) << 2));
#pragma unroll
              for (int e = 0; e < 8; ++e) rank[e] += (kv.x > own[e] ? 1 : 0) + (kv.y > own[e] ? 1 : 0) + (kv.z > own[e] ? 1 : 0) + (kv.w > own[e] ? 1 : 0); }
          unsigned bits = 0u;
#pragma unroll
          for (int e = 0; e < 8; ++e) bits |= (rank[e] < 16 && 8 * jseg + e <= c) ? (1u << e) : 0u;
          unsigned lo = (jseg < 4) ? (bits << (8 * jseg)) : 0u, hi = (jseg >= 4) ? (bits << (8 * (jseg - 4))) : 0u;
          lo |= __shfl_xor(lo, 1); hi |= __shfl_xor(hi, 1); lo |= __shfl_xor(lo, 2); hi |= __shfl_xor(hi, 2); lo |= __shfl_xor(lo, 4); hi |= __shfl_xor(hi, 4);
          if (jseg == 0) SELL[tt] = ((unsigned long long)hi << 32) | lo; }
        asm volatile("s_waitcnt lgkmcnt(0)" ::: "memory"); __builtin_amdgcn_s_barrier();
        const unsigned long long mymask = SELL[qloc];
        unsigned long long U;
        { const unsigned long long ml = SELL[lane]; unsigned ulo = (unsigned)ml, uhi = (unsigned)(ml >> 32);
#pragma unroll
          for (int of = 1; of < 64; of <<= 1) { ulo |= __shfl_xor(ulo, of); uhi |= __shfl_xor(uhi, of); }
          U = ((unsigned long long)__builtin_amdgcn_readfirstlane(uhi) << 32) | __builtin_amdgcn_readfirstlane(ulo); }
        const int nsel = __builtin_popcountll(U);
        if (wid == 0) { if ((U >> lane) & 1ull) jl[__builtin_popcountll(U & ((1ull << lane) - 1ull))] = lane; }
        unsigned wlo = (unsigned)mymask, whi = (unsigned)(mymask >> 32);
#pragma unroll
        for (int of = 1; of < 32; of <<= 1) { wlo |= __shfl_xor(wlo, of); whi |= __shfl_xor(whi, of); }
        const unsigned long long Uw = ((unsigned long long)__builtin_amdgcn_readfirstlane(whi) << 32) | __builtin_amdgcn_readfirstlane(wlo);
        asm volatile("s_waitcnt lgkmcnt(0)" ::: "memory"); __builtin_amdgcn_s_barrier();
        const int jlv = jl[lane];
        LAS float* stash = P4 + wid * 2048 + lane;
#pragma unroll
        for (int i = 0; i < 16; ++i) { stash[i * 64] = oa[0][i]; stash[(16 + i) * 64] = oa[1][i]; }
        const size_t koff = (size_t)(8 * wid + (lane >> 3)) * 64 + (((lane & 7) ^ ((lane >> 3) & 7)) * 8), voff = (size_t)(16 * (wid & 3) + (lane >> 2)) * 64 + (wid >> 2) * 32 + (lane & 3) * 8;
        TS_SECT_END(C, 10); TS_SECT_BEGIN(C, 11);
        if (nomax_rt) {
        const size_t koff6 = fa6::koff(wid, lane);
        { f32x16 o1[2]; float l1 = 0.f;
#pragma unroll
          for (int i = 0; i < 16; ++i) { o1[0][i] = 0.f; o1[1][i] = 0.f; }
          const bf16* kbase = QKV + hm(24 + g, b) + koff6; const bf16* vbase = QKV + hm(28 + g, b) + voff;
          const unsigned mlo = (unsigned)mymask, mhi = (unsigned)(mymask >> 32);
          fa6::run<true>((LAS char*)C.lds, wid, lane, qf, nsel,
            [&](int i) { return kbase + (size_t)__builtin_amdgcn_readlane(jlv, i) * 4096; },
            [&](int i) { return vbase + (size_t)__builtin_amdgcn_readlane(jlv, i) * 4096; },
            [&](int i) { const int j = __builtin_amdgcn_readlane(jlv, i); const unsigned w = (j & 32) ? mhi : mlo; return ((w >> (j & 31)) & 1u) != 0u; },
            false, true, qloc, o1, l1, true);
          const float sc = g1s / fa::xsum32(l1);
#pragma unroll
          for (int i = 0; i < 16; ++i) { stash[i * 64] += sc * o1[0][i]; stash[(16 + i) * 64] += sc * o1[1][i]; } }
        TS_SECT_END(C, 11); TS_SECT_BEGIN(C, 12);
        if (ui + 1 < per && u + 1 < nunits) prefetch(u + 1, lane);
        { f32x16 o2[2]; float l2 = 0.f;
#pragma unroll
          for (int i = 0; i < 16; ++i) { o2[0][i] = 0.f; o2[1][i] = 0.f; }
          const bf16* kbase = QKV + hm(32 + g, b) + koff6; const bf16* vbase = QKV + hm(36 + g, b) + voff;
          const int jlo = (c - 8) > 0 ? (c - 8) : 0, nt = c - jlo + 1;
          fa6::run<false>((LAS char*)C.lds, wid, lane, qf, nt,
            [&](int i) { return kbase + (size_t)(jlo + i) * 4096; },
            [&](int i) { return vbase + (size_t)(jlo + i) * 4096; },
            [&](int) { return true; },
            c >= 8, true, qloc, o2, l2);
          const float sc = g2s / fa::xsum32(l2);
#pragma unroll
          for (int i = 0; i < 16; ++i) { o2[0][i] = stash[i * 64] + sc * o2[0][i]; o2[1][i] = stash[(16 + i) * 64] + sc * o2[1][i]; }
          fa::store_o64_st((LAS char*)(P4 + wid * 2048), O + (row - r) * DM + head * 64, DM, lane, o2[0], o2[1], 1.0f); }
        } else {
        { f32x16 o1[2]; float m1 = 0.f, l1 = 0.f;
#pragma unroll
          for (int i = 0; i < 16; ++i) { o1[0][i] = 0.f; o1[1][i] = 0.f; }
          const bf16* kbase = QKV + hm(24 + g, b) + koff; const bf16* vbase = QKV + hm(28 + g, b) + voff;
          fa3::loop<64, NOMAX>((LAS char*)C.lds, wid, lane, qf, nsel,
            [&](int i) { return kbase + (size_t)__builtin_amdgcn_readlane(jlv, i) * 4096; },
            [&](int i, int) { return vbase + (size_t)__builtin_amdgcn_readlane(jlv, i) * 4096; },
            [&](int i) { const int j = __builtin_amdgcn_readlane(jlv, i); return ((Uw >> j) & 1ull) != 0ull; },
            [&](int i, f32x16& p0, f32x16& p1) { const int j = __builtin_amdgcn_readlane(jlv, i);
                if (!((mymask >> j) & 1ull)) {
#pragma unroll
                    for (int ii = 0; ii < 16; ++ii) { p0[ii] = -INFINITY; p1[ii] = -INFINITY; } }
                if (j == c) { int ql = qloc; asm volatile("" : "+v"(ql));
#pragma unroll
                    for (int ii = 0; ii < 16; ++ii) { const int kv = fa::crow(ii, h2); if (kv > ql) p0[ii] = -INFINITY; if (kv + 32 > ql) p1[ii] = -INFINITY; } } },
            o1, m1, l1, 0.f, false, fa3::NoPf(), nomax_rt);
          const float sc = g1s / fa::xsum32(l1);
#pragma unroll
          for (int i = 0; i < 16; ++i) { stash[i * 64] += sc * o1[0][i]; stash[(16 + i) * 64] += sc * o1[1][i]; } }
        TS_SECT_END(C, 11); TS_SECT_BEGIN(C, 12);
        { f32x16 o2[2]; float m2 = 0.f, l2 = 0.f;
#pragma unroll
          for (int i = 0; i < 16; ++i) { o2[0][i] = 0.f; o2[1][i] = 0.f; }
          const bf16* kbase = QKV + hm(32 + g, b) + koff; const bf16* vbase = QKV + hm(36 + g, b) + voff;
          const int jlo = (c - 8) > 0 ? (c - 8) : 0, nt = c - jlo + 1;
          fa3::loop<64, NOMAX>((LAS char*)C.lds, wid, lane, qf, nt,
            [&](int i) { return kbase + (size_t)(jlo + i) * 4096; },
            [&](int i, int) { return vbase + (size_t)(jlo + i) * 4096; },
            [&](int) { return true; },
            [&](int i, f32x16& p0, f32x16& p1) { const int j = jlo + i;
                if (j == c) { int ql = qloc; asm volatile("" : "+v"(ql));
#pragma unroll
                    for (int ii = 0; ii < 16; ++ii) { const int kv = fa::crow(ii, h2); if (kv > ql) p0[ii] = -INFINITY; if (kv + 32 > ql) p1[ii] = -INFINITY; } }
                if (j == c - 8) { int ql = qloc; asm volatile("" : "+v"(ql));
#pragma unroll
                    for (int ii = 0; ii < 16; ++ii) { const int kv = fa::crow(ii, h2); if (kv <= ql) p0[ii] = -INFINITY; if (kv + 32 <= ql) p1[ii] = -INFINITY; } } },
            o2, m2, l2, 0.f, false, fa3::NoPf(), nomax_rt);
          if (ui + 1 < per && u + 1 < nunits) prefetch(u + 1, lane);
          const float sc = g2s / fa::xsum32(l2);
#pragma unroll
          for (int i = 0; i < 16; ++i) { o2[0][i] = stash[i * 64] + sc * o2[0][i]; o2[1][i] = stash[(16 + i) * 64] + sc * o2[1][i]; }
          fa::store_o64_st((LAS char*)(P4 + wid * 2048), O + (row - r) * DM + head * 64, DM, lane, o2[0], o2[1], 1.0f); }
        }
        TS_SECT_END(C, 12);
    }
}
DI void attn_nsa_fused(Ctx& C) {
    const float bs = score_bound(inp(C, I_NSA_QG), inp(C, I_NSA_KG) + 64, C.lane), bw = score_bound(inp(C, I_NSA_QG), inp(C, I_NSA_KG) + 128, C.lane);
    attn_nsa_impl<false>(C, fmaxf(bs, bw) <= NOMAX_BOUND);
}
__global__ void __launch_bounds__(NTHR, 2) hybrid_fwd(Args args) {
    extern __shared__ __attribute__((aligned(16))) unsigned char lds_raw[];
    Ctx C;
    C.hbuf = args.out; C.ws = args.ws; C.lds = (LAS unsigned char*)lds_raw;
    C.tid = threadIdx.x; C.lane = C.tid & 63; C.wave = __builtin_amdgcn_readfirstlane(C.tid >> 6); C.G = gridDim.x; C.blk = blockIdx.x;
    volatile LAS unsigned* MISC = (volatile LAS unsigned*)(C.lds + MISC_OFF);
    if (C.tid < 32) MISC[C.tid] = 0u;
    if (C.tid == 0) {
#pragma unroll
        for (int i = 0; i < N_IN; ++i) ((LAS unsigned long long*)(C.lds + PTR_OFF))[i] = (unsigned long long)args.in[i];
    }
    __syncthreads();
    const int lo = args.ph_lo, hi = args.ph_hi;
    unsigned* barw = (unsigned*)(C.ws + WS_CTL) + CW_BAR;
    XcdBarrier bar; bar.bar = barw; bar.x = 0; bar.st = nullptr;
    if (hi - lo > 1) bar = xcd_barrier_post(barw, MISC + 8);
    int ph = 0;
#ifndef DBG_ONLY
#define DBG_ONLY -1
#endif
#ifndef DBG_REP
#define DBG_REP -1
#endif
#ifndef DBG_TS_Q
#define DBG_TS_Q 4ull
#endif
#ifndef DBG_TS_OFS
#define DBG_TS_OFS 0ull
#endif
#ifndef DBG_TS_PHSEL
#define DBG_TS_PHSEL(p) true
#endif
#ifndef DBG_TS_BARSEL
#define DBG_TS_BARSEL(p) true
#endif
#ifndef DBG_TS_SEL
#define DBG_TS_SEL(p) false
#define DBG_TS_ON 0
#else
#define DBG_TS_ON 1
#endif
    volatile LAS unsigned long long* TSW = (volatile LAS unsigned long long*)(C.lds + MISC_OFF + 64);
#define PHASE(tag, ...) do { __builtin_amdgcn_s_setprio(0); if ((DBG_ONLY < 0 || DBG_ONLY == (tag)) && lo <= ph && ph < hi) { { int t_ = threadIdx.x; asm volatile("" : "+v"(t_)); C.tid = t_; C.lane = t_ & 63; if (DBG_TS_SECT != 0 && t_ == 0) MISC[24] = DBG_TS_PHSEL(ph) ? 1u : 0u; } \
    if (DBG_TS_ON && DBG_TS_SEL(ph) && C.tid == 0) TSW[1] = __builtin_amdgcn_s_memrealtime(); \
    for (int rep_ = 0; rep_ < ((tag) == DBG_REP ? 2 : 1); ++rep_) { __VA_ARGS__; } if (ph + 1 < hi) { if (DBG_TS_BARSEL(ph)) TS_SECT_BEGIN(C, 20); xcd_barrier(bar); if (DBG_TS_BARSEL(ph)) TS_SECT_END(C, 20); } \
    if (DBG_TS_ON && DBG_TS_SEL(ph) && C.tid == 0) TSW[0] = TSW[0] + (__builtin_amdgcn_s_memrealtime() - TSW[1]); } ++ph; } while (0)
    bf16* const UO = (bf16*)(C.ws + WS_UO); bf16* const O2 = (bf16*)(C.ws + WS_O2); bf16* const R1 = (bf16*)(C.ws + WS_R1); bf16* const YB = (bf16*)(C.ws + WS_Y);
    const float* const WQ_ = nullptr; (void)WQ_;

    PHASE(0, { phase_p0a(C); phase_p0c(C); });
    PHASE(1, phase_n1<0>(C));
    PHASE(2, gemm_qkv_prep(C, UO, (const bf16*)(C.ws + WS_FOXWIN), FOX_NPAD, R1, 3072, 3072, (float*)(C.ws + WS_FLOG), 16, 4, 8, 0, 0, inp(C, I_FOX_QG), inp(C, I_FOX_KG), nullptr, false, 1, 1));
    PHASE(4, attn_fox_fast(C));
    PHASE(2, gemm_qkv(C, UO, (const bf16*)(C.ws + WS_WOUT), DM, YB, DM, DM, nullptr, 0));
    PHASE(5, phase_n2<0>(C, YB));
    PHASE(6, phase_s(C));
    PHASE(7, gemm_moe1(C, 0));
    PHASE(8, gemm_moe2(C, 0));
    PHASE(1, phase_n1<1>(C));
    PHASE(2, gemm_qkv_prep(C, UO, (const bf16*)(C.ws + WS_NSAWIN), NSA_NPAD, R1, NSA_LDQ, NSA_LDQ, (float*)(C.ws + WS_GATE), 48, 6, 7, 8, 9, inp(C, I_NSA_QG), inp(C, I_NSA_KG) + 64, inp(C, I_NSA_KG) + 128, true));
    PHASE(3, nsa_compress(C));
    PHASE(10, attn_nsa_fused(C));
    PHASE(2, gemm_qkv(C, UO, (const bf16*)(C.ws + WS_WOUT + 2 * MiB), DM, YB, DM, DM, nullptr, 0));
    PHASE(5, phase_n2<1>(C, YB));
    PHASE(6, phase_s(C));
    PHASE(7, gemm_moe1(C, 1));
    PHASE(8, gemm_moe2(C, 1));
    PHASE(1, phase_n1<2>(C));
#pragma unroll
    for (int gi = 0; gi < 3; ++gi) {
        const int dil = (gi == 0) ? 1 : (gi == 1) ? 4 : 16;
        PHASE(2, gemm_qkv_prep(C, UO, (const bf16*)(C.ws + WS_DILWIN) + (size_t)gi * 3072 * DM, 3072, R1, 3072, 3072, nullptr, 0, 4, 8, 0, 0, inp(C, I_DIL_QG), inp(C, I_DIL_KG), nullptr, true, dil));
        PHASE(11, attn_dil_fast(C, gi, dil));
    }
    PHASE(2, gemm_qkv(C, O2, (const bf16*)(C.ws + WS_WOUT + 4 * MiB), DM, YB, DM, DM, nullptr, 0));
    PHASE(5, phase_n2<2>(C, YB));
    PHASE(6, phase_s(C));
    PHASE(7, gemm_moe1(C, 2));
    PHASE(8, gemm_moe2(C, 2));
    PHASE(1, phase_n1<3>(C));
    PHASE(2, gemm_qkv_prep(C, UO, (const bf16*)(C.ws + WS_DIFFWIN), 3072, R1, 3072, 3072, nullptr, 0, 4, 8, 0, 0, inp(C, I_DIFF_QG), inp(C, I_DIFF_KG), nullptr, true));
    PHASE(12, attn_diff_fast(C));
    PHASE(2, gemm_qkv(C, UO, (const bf16*)(C.ws + WS_WOUT + 6 * MiB), DM, YB, DM, DM, nullptr, 0));
    PHASE(5, phase_n2<3>(C, YB));
    PHASE(6, phase_s(C));
    PHASE(7, gemm_moe1(C, 3));
    PHASE(8, gemm_moe2(C, 3));
    PHASE(1, phase_final(C));
    if ((DBG_TS_ON || DBG_TS_SECT != 0) && C.blk == 0 && C.tid == 0) { asm volatile("s_waitcnt vmcnt(0)" ::: "memory"); C.hbuf[0] = (float)(((TSW[0] / 100ull + DBG_TS_OFS) / DBG_TS_Q) * DBG_TS_Q) * 0.25f; }
#undef PHASE
}
constexpr int N_PHASES = 1 + 8 + 9 + 12 + 8 + 1;

#ifndef MK_PER_PHASE
#define MK_PER_PHASE 0
#endif
extern "C" void kernel_launch(void* const* d_in, const int* in_sizes, int n_in, void* d_out, int out_size, void* d_ws, size_t ws_size, hipStream_t stream) {
    static int grid = 0;
    if (grid == 0) {
        if (n_in != N_IN || out_size != T * DM || ws_size < WS_END) { fprintf(stderr, "kernel_launch: unexpected shapes (n_in %d out %d ws %zu)\n", n_in, out_size, ws_size); grid = -1; return; }
        int dev = 0, cus = 0, per_cu = 0;
        if (hipGetDevice(&dev) != hipSuccess || hipDeviceGetAttribute(&cus, hipDeviceAttributeMultiprocessorCount, dev) != hipSuccess) { grid = -1; return; }
        if (hipFuncSetAttribute((const void*)hybrid_fwd, hipFuncAttributeMaxDynamicSharedMemorySize, LDS_BYTES) != hipSuccess) { fprintf(stderr, "kernel_launch: hipFuncSetAttribute failed\n"); grid = -1; return; }
        if (hipOccupancyMaxActiveBlocksPerMultiprocessor(&per_cu, (const void*)hybrid_fwd, NTHR, LDS_BYTES) != hipSuccess || per_cu < 1) fprintf(stderr, "kernel_launch: occupancy query reports %d\n", per_cu);
        (void)hipGetLastError();
        grid = (cus >= 256) ? 256 : (cus >= 128) ? 128 : 64;
    }
    if (grid < 0) return;
    (void)hipMemsetAsync((char*)d_ws + WS_CTL, 0, CTL_ZERO_BYTES, stream);
    Args a{};
    for (int i = 0; i < N_IN; ++i) a.in[i] = (const float*)d_in[i];
    a.out = (float*)d_out; a.ws = (unsigned char*)d_ws;
#if MK_PER_PHASE
    for (int p = 0; p < N_PHASES; ++p) { a.ph_lo = p; a.ph_hi = p + 1; hipLaunchKernelGGL(hybrid_fwd, dim3(grid), dim3(NTHR), LDS_BYTES, stream, a); }
#else
    a.ph_lo = 0; a.ph_hi = N_PHASES;
    hipLaunchKernelGGL(hybrid_fwd, dim3(grid), dim3(NTHR), LDS_BYTES, stream, a);
#endif
    const hipError_t le = hipPeekAtLastError();
    if (le != hipSuccess) fprintf(stderr, "kernel_launch: launch failed: %s\n", hipGetErrorName(le));
}
```
